# Optimizing an MI355X kernel written in HIP

```python
import jax, jax.numpy as jnp
from jax import lax
import numpy as np

D_MODEL = 1024
BATCH = 16
SEQ = 4096
DEPTH = 4

GLA_HEADS = 4
GLA_DK = 64
GLA_DV = 128
GLA_RANK = 16
GLA_TAU = 16.0
GLA_CHUNK = 64
SGU_GROUPS = 4
SGU_DC = 128
SGU_CHUNK = 128
D_FF = 4 * D_MODEL
EPS = 1e-6

GLA_QK = GLA_HEADS * GLA_DK
GLA_V = GLA_HEADS * GLA_DV
SGU_W = SGU_GROUPS * SGU_DC
D_MIX = GLA_V + SGU_W
IN_SIZES = (GLA_QK, GLA_QK, GLA_V, GLA_V, GLA_RANK, GLA_RANK, SGU_W, SGU_W)
D_IN = GLA_QK * 2 + GLA_V * 2 + GLA_RANK * 2 + SGU_W * 2
SPLIT_POINTS = (GLA_QK, 2 * GLA_QK, 2 * GLA_QK + GLA_V, 2 * GLA_QK + 2 * GLA_V,
                2 * GLA_QK + 2 * GLA_V + GLA_RANK, 2 * GLA_QK + 2 * GLA_V + 2 * GLA_RANK,
                2 * GLA_QK + 2 * GLA_V + 2 * GLA_RANK + SGU_W)

kernel_name = "hybrid_gla_sgu_encoder"


def rmsnorm(x, g):
    xf = x.astype(jnp.float32)
    y = xf * lax.rsqrt(jnp.mean(xf * xf, axis=-1, keepdims=True) + EPS)
    return (y * g.astype(jnp.float32)).astype(x.dtype)


def gla_one_direction(q, k, v, log_a, strict):
    B, S, H, K = q.shape
    V = v.shape[-1]
    C = GLA_CHUNK
    N = S // C
    q = q.reshape(B, N, C, H, K)
    k = k.reshape(B, N, C, H, K)
    v = v.reshape(B, N, C, H, V)
    b = jnp.cumsum(log_a.reshape(B, N, C, H, K), axis=2)
    b_mid = b[:, :, C // 2:C // 2 + 1]
    q_in = q * jnp.exp(b - b_mid)
    k_in = k * jnp.exp(b_mid - b)
    scores = jnp.einsum('bnchk,bnjhk->bnhcj', q_in, k_in)
    idx = jnp.arange(C)
    mask = (idx[:, None] > idx[None, :]) if strict else (idx[:, None] >= idx[None, :])
    scores = jnp.where(mask, scores, 0.0)
    o_intra = jnp.einsum('bnhcj,bnjhv->bnchv', scores, v)
    b_last = b[:, :, -1]
    kv = jnp.einsum('bnchk,bnchv->bnhkv', k * jnp.exp(b_last[:, :, None] - b), v)

    def step(state, inp):
        dec, kv_n = inp
        return dec[..., None] * state + kv_n, state

    init = jnp.zeros((B, H, K, V), q.dtype)
    _, s_in = lax.scan(step, init, (jnp.moveaxis(jnp.exp(b_last), 1, 0), jnp.moveaxis(kv, 1, 0)))
    s_in = jnp.moveaxis(s_in, 0, 1)
    o_inter = jnp.einsum('bnchk,bnhkv->bnchv', q * jnp.exp(b), s_in)
    return (o_intra + o_inter).reshape(B, S, H, V)


def gla_mixer(q, k, v, g, a_f, a_b, w_a2_f, b_a_f, w_a2_b, b_a_b, norm_g):
    B, S, _ = q.shape
    f32 = jnp.float32
    q = q.astype(f32).reshape(B, S, GLA_HEADS, GLA_DK) * (GLA_DK ** -0.5)
    k = k.astype(f32).reshape(B, S, GLA_HEADS, GLA_DK)
    v = v.astype(f32).reshape(B, S, GLA_HEADS, GLA_DV)
    log_a_f = (jax.nn.log_sigmoid(a_f.astype(f32) @ w_a2_f.astype(f32) + b_a_f.astype(f32)) / GLA_TAU
               ).reshape(B, S, GLA_HEADS, GLA_DK)
    log_a_b = (jax.nn.log_sigmoid(a_b.astype(f32) @ w_a2_b.astype(f32) + b_a_b.astype(f32)) / GLA_TAU
               ).reshape(B, S, GLA_HEADS, GLA_DK)
    o_f = gla_one_direction(q, k, v, log_a_f, False)
    flip = lambda t: jnp.flip(t, axis=1)
    o_b = flip(gla_one_direction(flip(q), flip(k), flip(v), flip(log_a_b), True))
    o = o_f + o_b
    o = o * lax.rsqrt(jnp.mean(o * o, axis=-1, keepdims=True) + EPS) * norm_g.astype(f32)
    return o.reshape(B, S, GLA_V) * jax.nn.silu(g.astype(f32))


def sgu_mixer(u, v, norm_g, w_s, b_s):
    B, S, _ = u.shape
    f32 = jnp.float32
    N = S // SGU_CHUNK
    v = v.astype(f32).reshape(B, N, SGU_CHUNK, SGU_GROUPS, SGU_DC)
    v = v * lax.rsqrt(jnp.mean(v * v, axis=-1, keepdims=True) + EPS) * norm_g.astype(f32)
    mixed = jnp.einsum('gpq,bnqgc->bnpgc', w_s.astype(f32), v) + b_s.astype(f32).T[:, :, None]
    return u.astype(f32) * mixed.reshape(B, S, SGU_W)


def setup_inputs(seed: int = 0) -> dict:
    key = jax.random.key(seed)
    ks = jax.random.split(key, 20)
    nrm = lambda k, shape, s: jax.random.normal(k, shape, jnp.float32) * s
    L = DEPTH
    return {
        "x": nrm(ks[0], (BATCH, SEQ, D_MODEL), 1.0),
        "norm_mix_g": 1.0 + nrm(ks[1], (L, D_MODEL), 0.02),
        "w_in": nrm(ks[2], (L, D_MODEL, D_IN), D_MODEL ** -0.5),
        "w_a2_fwd": nrm(ks[3], (L, GLA_RANK, GLA_QK), GLA_RANK ** -0.5),
        "b_a_fwd": 1.5 + nrm(ks[4], (L, GLA_QK), 1.0),
        "w_a2_bwd": nrm(ks[5], (L, GLA_RANK, GLA_QK), GLA_RANK ** -0.5),
        "b_a_bwd": 1.5 + nrm(ks[6], (L, GLA_QK), 1.0),
        "gla_norm_g": 1.0 + nrm(ks[7], (L, GLA_HEADS, GLA_DV), 0.02),
        "sgu_norm_g": 1.0 + nrm(ks[8], (L, SGU_GROUPS, SGU_DC), 0.02),
        "w_s": nrm(ks[9], (L, SGU_GROUPS, SGU_CHUNK, SGU_CHUNK), SGU_CHUNK ** -0.5),
        "b_s": 1.0 + nrm(ks[10], (L, SGU_GROUPS, SGU_CHUNK), 0.1),
        "w_out": nrm(ks[11], (L, D_MIX, D_MODEL), D_MIX ** -0.5),
        "norm_mlp_g": 1.0 + nrm(ks[12], (L, D_MODEL), 0.02),
        "w_mlp1": nrm(ks[13], (L, D_MODEL, D_FF), D_MODEL ** -0.5),
        "w_mlp2": nrm(ks[14], (L, D_FF, D_MODEL), D_FF ** -0.5),
        "final_norm_g": 1.0 + nrm(ks[15], (D_MODEL,), 0.02),
    }


def reference(x, norm_mix_g, w_in, w_a2_fwd, b_a_fwd, w_a2_bwd, b_a_bwd, gla_norm_g,
              sgu_norm_g, w_s, b_s, w_out, norm_mlp_g, w_mlp1, w_mlp2, final_norm_g):
    for l in range(DEPTH):
        h = rmsnorm(x, norm_mix_g[l])
        z = h @ w_in[l]
        q, k, v, g, a_f, a_b, su, sv = jnp.split(z, SPLIT_POINTS, axis=-1)
        o_gla = gla_mixer(q, k, v, g, a_f, a_b, w_a2_fwd[l], b_a_fwd[l],
                          w_a2_bwd[l], b_a_bwd[l], gla_norm_g[l]).astype(x.dtype)
        o_sgu = sgu_mixer(jax.nn.gelu(su, approximate=False), jax.nn.gelu(sv, approximate=False),
                          sgu_norm_g[l], w_s[l], b_s[l]).astype(x.dtype)
        x = x + jnp.concatenate([o_gla, o_sgu], axis=-1) @ w_out[l]
        h = rmsnorm(x, norm_mlp_g[l])
        x = x + jnp.square(jax.nn.relu(h @ w_mlp1[l])) @ w_mlp2[l]
    return rmsnorm(x, final_norm_g)
```

```cpp
#include <hip/hip_runtime.h>
#include <hip/hip_cooperative_groups.h>
#include <cstdio>
namespace cg = cooperative_groups;

#define LAS __attribute__((address_space(3)))
#ifndef PHASE_FN
#define PHASE_FN __device__ __forceinline__
#endif
typedef unsigned short bf16_t;
typedef short bf16x8 __attribute__((ext_vector_type(8)));
typedef short bf16x4 __attribute__((ext_vector_type(4)));
typedef float f32x4 __attribute__((ext_vector_type(4)));
typedef float f32x2 __attribute__((ext_vector_type(2)));
typedef unsigned u32x4 __attribute__((ext_vector_type(4)));
typedef unsigned u32x2 __attribute__((ext_vector_type(2)));

constexpr int T = 65536, D = 1024, FF = 4096, SEQ = 4096, DEPTH = 4;
constexpr int ZW = 2816;
constexpr int D_IN = 2592;
constexpr float EPS = 1e-6f;
constexpr int ZQ = 0, ZK = 256, ZV = 512, ZG = 1024, ZSU = 1536, ZSV = 2304;
constexpr int ZN_A = 2304;

constexpr size_t MiB = 1u << 20;
constexpr size_t WS_CTL = 0, CTL_BYTES = 1 * MiB;
constexpr size_t WS_WIN = 1 * MiB;
constexpr size_t WS_WOUT = 23 * MiB;
constexpr size_t WS_W1 = 31 * MiB;
constexpr size_t WS_W2 = 63 * MiB;
constexpr size_t WS_WSB = 95 * MiB;
constexpr size_t WS_SSQ = 96 * MiB;
constexpr size_t WS_DEC = 100 * MiB;
constexpr size_t WS_XB = 108 * MiB;
constexpr size_t WS_Z = 236 * MiB;
constexpr size_t WS_MIX = 588 * MiB;
constexpr size_t WS_OX = 716 * MiB;
constexpr size_t WS_HID = 236 * MiB;
constexpr size_t WS_END = 844 * MiB;
constexpr int LDS_BYTES = 147456;

struct Params {
    const float* x; const float* norm_mix_g; const float* w_in; const float* w_a2_fwd; const float* b_a_fwd; const float* w_a2_bwd; const float* b_a_bwd;
    const float* gla_norm_g; const float* sgu_norm_g; const float* w_s; const float* b_s; const float* w_out; const float* norm_mlp_g; const float* w_mlp1;
    const float* w_mlp2; const float* final_norm_g; float* out; unsigned char* ws;
};

__device__ __forceinline__ unsigned cvt_pk_bf16(float lo, float hi) { unsigned r; asm volatile("v_cvt_pk_bf16_f32 %0, %1, %2" : "=v"(r) : "v"(lo), "v"(hi)); return r; }
__device__ __forceinline__ float bf2f(unsigned short b) { return __uint_as_float(((unsigned)b) << 16); }
__device__ __forceinline__ float bflo(unsigned w) { return __uint_as_float(w << 16); }
__device__ __forceinline__ float bfhi(unsigned w) { return __uint_as_float(w & 0xffff0000u); }

__device__ __forceinline__ f32x2 gelu_pk(f32x2 v) {
    const f32x2 av = __builtin_elementwise_abs(v), d = av * 0.2316418882f + 1.0f;
    f32x2 t; t.x = __builtin_amdgcn_rcpf(d.x); t.y = __builtin_amdgcn_rcpf(d.y);
    f32x2 q = t * 0.5307027145f + (-0.7265760135f); q = q * t + 0.7107068705f; q = q * t + (-0.142248368f); q = q * t + 0.127414796f; q = q * t;
    const f32x2 s = (v * v) * (-0.72134752044f);
    f32x2 e; e.x = __builtin_amdgcn_exp2f(s.x); e.y = __builtin_amdgcn_exp2f(s.y);
    const f32x2 m = v * (q * e), r = v - m;
    f32x2 o; o.x = v.x < 0.f ? m.x : r.x; o.y = v.y < 0.f ? m.y : r.y; return o;
}
__device__ __forceinline__ float silu_f(float v) { return v * __builtin_amdgcn_rcpf(1.0f + __expf(-v)); }

namespace pg8 {
constexpr int BM = 256, BK = 64, HALF = 128, HTB = HALF * BK * 2, STAGE_BYTES = 8 * HTB, NXCD = 8, WGM = 8;
__host__ __device__ __forceinline__ int lds_byte(int r, int c) { const int st = (r >> 4) * 2 + (c >> 5), rr = r & 15, cc = c & 31, ob = rr * 64 + cc * 2; return st * 1024 + (ob ^ (((ob >> 9) & 1) << 5)); }
__host__ __device__ __forceinline__ void stage_rc(int b, int& R, int& C) { const int st = b / 1024, sb = b % 1024, swz = sb ^ (((sb >> 9) & 1) << 5); R = (st >> 1) * 16 + swz / 64; C = (st & 1) * 32 + (swz % 64) / 2; }
__host__ __device__ __forceinline__ int perm32(int rho) { const int n = rho >> 4, i = rho & 15; return 8 * (i >> 2) + 4 * n + (i & 3); }
struct Unit { int pm, pn; };
struct Gemm { const bf16_t* A; const bf16_t* Bt; int M, N, K; };
struct StaticOrder {
    int nM, nN, nwg, G, c, mode, base;
    __device__ void init(int M, int N, int G_, int c_) { nM = M / BM; nN = N / BM; nwg = nM * nN; G = G_; c = c_; mode = 0; base = 0; }
    __device__ bool next(int i, Unit& u) const {
        if (mode == 1) { if (i >= 4) return false; u.pm = base + (i >> 1); u.pn = 9 + (i & 1); return true; }
        const long L = (long)i * G + c; if (L >= nwg) return false;
        int wgid = (int)L; { const int q = nwg / NXCD, r = nwg % NXCD, xcd = wgid % NXCD, off = wgid / NXCD; wgid = (xcd < r ? xcd * (q + 1) : r * (q + 1) + (xcd - r) * q) + off; }
        const int nig = WGM * nN, gid = wgid / nig, fm = gid * WGM, gsz = (nM - fm) < WGM ? (nM - fm) : WGM;
        u.pm = fm + ((wgid % nig) % gsz); u.pn = (wgid % nig) / gsz; return true;
    }
    __device__ __forceinline__ void a_ready(const Unit&) const {}
    __device__ __forceinline__ void done(const Unit&) const {}
};

template <class Epi, class Sched, bool ALIGN_EPI = false, bool SP2 = false>
__device__ __forceinline__ void gemm_phase(LAS unsigned char* lds, const Gemm g, const Sched& S, const Epi& E) {
    int tid = threadIdx.x; asm volatile("" : "+v"(tid));
    const int wid = __builtin_amdgcn_readfirstlane(tid >> 6), lane = tid & 63, wr = wid >> 2, wc = wid & 3, fr = lane & 15, fq = lane >> 4;
    const int K = g.K, nt = K / BK;
    unsigned voffA[2], voffB[2];
#pragma unroll
    for (int i = 0; i < 2; ++i) { int R, C; stage_rc(tid * 16 + i * 8192, R, C); const int Rb = Epi::PERM ? ((R & ~31) + perm32(R & 31)) : R;
        voffA[i] = (unsigned)(R * K + C) * 2u; voffB[i] = (unsigned)(Rb * K + C) * 2u; }
    const size_t kstep = (size_t)(BK * 2);
    const size_t hstep = (size_t)HALF * K * 2;
    const size_t tstep = 2 * hstep;
    const unsigned ldsw = (unsigned)wid * 1024u;
    const int aoff = lds_byte(wr * 64 + fr, fq * 8), boff = lds_byte(wc * 32 + fr, fq * 8);
#define PG8_SA(b, h) (((b) * 2 + (h)) * HTB)
#define PG8_SB(b, h) ((4 + (b) * 2 + (h)) * HTB)
#define PG8_STAGE(bufoff, gbase, voff) do { _Pragma("unroll") for (int _i = 0; _i < 2; ++_i) \
        __builtin_amdgcn_global_load_lds((const unsigned*)((const char*)(gbase) + (voff)[_i]), (LAS unsigned*)(lds + (bufoff) + ldsw + _i * 8192), 16, 0, 0); } while (0)
#define PG8_LDA(dst, b, h) do { _Pragma("unroll") for (int m = 0; m < 4; ++m) _Pragma("unroll") for (int k = 0; k < 2; ++k) dst[m][k] = *(const LAS bf16x8*)(lds + PG8_SA(b, h) + aoff + m * 2048 + k * 1024); } while (0)
#define PG8_LDB(dst, b, h) do { _Pragma("unroll") for (int n = 0; n < 2; ++n) _Pragma("unroll") for (int k = 0; k < 2; ++k) dst[n][k] = *(const LAS bf16x8*)(lds + PG8_SB(b, h) + boff + n * 2048 + k * 1024); } while (0)
#define PG8_MMA(ai, bj, At, Bt) do { __builtin_amdgcn_s_setprio(1); _Pragma("unroll") for (int m = 0; m < 4; ++m) _Pragma("unroll") for (int n = 0; n < 2; ++n) _Pragma("unroll") for (int k = 0; k < 2; ++k) \
        acc[ai][bj][m][n] = __builtin_amdgcn_mfma_f32_16x16x32_bf16(Bt[n][k], At[m][k], acc[ai][bj][m][n], 0, 0, 0); __builtin_amdgcn_s_setprio(0); } while (0)
#define PG8_WAIT_V(n) asm volatile("s_waitcnt vmcnt(" #n ")" ::: "memory")
#define PG8_WAIT_L(n) asm volatile("s_waitcnt lgkmcnt(" #n ")" ::: "memory")
#define PG8_BAR __builtin_amdgcn_s_barrier()
#define PG8_SCHED __builtin_amdgcn_sched_barrier(0)
    Unit cur, nxt; int ui = 0;
    if (!S.next(0, cur)) return;
    f32x4 acc[2][2][4][2];
#pragma unroll
    for (int a = 0; a < 2; ++a)
#pragma unroll
        for (int b = 0; b < 2; ++b)
#pragma unroll
            for (int m = 0; m < 4; ++m)
#pragma unroll
                for (int n = 0; n < 2; ++n) acc[a][b][m][n] = (f32x4){0.f, 0.f, 0.f, 0.f};
    bf16x8 At[4][2], B0[2][2], B1[2][2];
    const char* cA = (const char*)g.A + (size_t)cur.pm * tstep; const char* cB = (const char*)g.Bt + (size_t)cur.pn * tstep;
    S.a_ready(cur);
    if constexpr (SP2) {
        PG8_STAGE(PG8_SB(0, 0), cB, voffB); PG8_STAGE(PG8_SB(0, 1), cB + hstep, voffB); PG8_STAGE(PG8_SA(0, 0), cA, voffA); PG8_STAGE(PG8_SA(0, 1), cA + hstep, voffA);
        if (wr == 1) PG8_BAR;
        PG8_WAIT_V(2); PG8_BAR;
        PG8_STAGE(PG8_SB(1, 0), cB + kstep, voffB); PG8_STAGE(PG8_SA(1, 0), cA + kstep, voffA); PG8_STAGE(PG8_SB(1, 1), cB + hstep + kstep, voffB);
        PG8_WAIT_V(6); PG8_BAR;
    } else {
        PG8_STAGE(PG8_SB(0, 0), cB, voffB); PG8_STAGE(PG8_SA(0, 0), cA, voffA); PG8_STAGE(PG8_SB(0, 1), cB + hstep, voffB); PG8_STAGE(PG8_SA(0, 1), cA + hstep, voffA);
        if (wr == 1) PG8_BAR;
        PG8_WAIT_V(4); PG8_BAR;
        PG8_STAGE(PG8_SB(1, 0), cB + kstep, voffB); PG8_STAGE(PG8_SA(1, 0), cA + kstep, voffA); PG8_STAGE(PG8_SB(1, 1), cB + hstep + kstep, voffB);
        PG8_WAIT_V(6); PG8_BAR;
    }
    for (;;) {
        const bool has_next = S.next(ui + 1, nxt);
        const char* nA = has_next ? (const char*)g.A + (size_t)nxt.pm * tstep : cA; const char* nB = has_next ? (const char*)g.Bt + (size_t)nxt.pn * tstep : cB;
        for (int t = 0; t < nt; t += 2) {
            const bool last = (t == nt - 2);
            const char* a1 = cA + (size_t)(t + 1) * kstep;
            const char* a2 = last ? nA : cA + (size_t)(t + 2) * kstep; const char* b2 = last ? nB : cB + (size_t)(t + 2) * kstep;
            const char* a3 = a2 + kstep; const char* b3 = b2 + kstep;
            if (last && has_next) S.a_ready(nxt);
            if constexpr (SP2) {
            PG8_LDB(B0, 0, 0); PG8_LDB(B1, 0, 1); PG8_SCHED; PG8_LDA(At, 0, 0); PG8_STAGE(PG8_SA(1, 1), a1 + hstep, voffA);
            PG8_WAIT_V(8); PG8_WAIT_L(0); PG8_BAR; PG8_MMA(0, 0, At, B0); PG8_MMA(0, 1, At, B1); PG8_BAR; PG8_SCHED;
            PG8_LDA(At, 0, 1); PG8_STAGE(PG8_SB(0, 0), b2, voffB); PG8_STAGE(PG8_SB(0, 1), b2 + hstep, voffB); PG8_STAGE(PG8_SA(0, 0), a2, voffA);
            PG8_WAIT_V(8); PG8_WAIT_L(0); PG8_BAR; PG8_MMA(1, 0, At, B0); PG8_MMA(1, 1, At, B1); PG8_BAR; PG8_SCHED;
            PG8_LDB(B0, 1, 0); PG8_LDB(B1, 1, 1); PG8_SCHED; PG8_LDA(At, 1, 0); PG8_STAGE(PG8_SA(0, 1), a2 + hstep, voffA);
            PG8_WAIT_V(8); PG8_WAIT_L(0); PG8_BAR; PG8_MMA(0, 0, At, B0); PG8_MMA(0, 1, At, B1); PG8_BAR; PG8_SCHED;
            PG8_LDA(At, 1, 1); PG8_STAGE(PG8_SB(1, 0), b3, voffB); PG8_STAGE(PG8_SB(1, 1), b3 + hstep, voffB); PG8_STAGE(PG8_SA(1, 0), a3, voffA);
            PG8_WAIT_V(8); PG8_WAIT_L(0); PG8_BAR; PG8_MMA(1, 0, At, B0); PG8_MMA(1, 1, At, B1); PG8_BAR; PG8_SCHED;
            } else {
            PG8_LDB(B0, 0, 0); PG8_SCHED; PG8_LDA(At, 0, 0); PG8_STAGE(PG8_SA(1, 1), a1 + hstep, voffA);
            PG8_WAIT_L(8); PG8_BAR; PG8_WAIT_L(0); PG8_MMA(0, 0, At, B0); PG8_BAR; PG8_SCHED;
            PG8_LDB(B1, 0, 1); PG8_STAGE(PG8_SB(0, 0), b2, voffB);
            PG8_BAR; PG8_WAIT_L(0); PG8_MMA(0, 1, At, B1); PG8_BAR;
            PG8_LDA(At, 0, 1); PG8_STAGE(PG8_SA(0, 0), a2, voffA);
            PG8_BAR; PG8_WAIT_L(0); PG8_MMA(1, 0, At, B0); PG8_BAR; PG8_SCHED;
            PG8_STAGE(PG8_SB(0, 1), b2 + hstep, voffB);
            PG8_WAIT_V(6); PG8_BAR; PG8_MMA(1, 1, At, B1); PG8_BAR;
            PG8_LDB(B0, 1, 0); PG8_SCHED; PG8_LDA(At, 1, 0); PG8_STAGE(PG8_SA(0, 1), a2 + hstep, voffA);
            PG8_WAIT_L(8); PG8_BAR; PG8_WAIT_L(0); PG8_MMA(0, 0, At, B0); PG8_BAR; PG8_SCHED;
            PG8_LDB(B1, 1, 1); PG8_STAGE(PG8_SB(1, 0), b3, voffB);
            PG8_BAR; PG8_WAIT_L(0); PG8_MMA(0, 1, At, B1); PG8_BAR;
            PG8_LDA(At, 1, 1); PG8_STAGE(PG8_SA(1, 0), a3, voffA);
            PG8_BAR; PG8_WAIT_L(0); PG8_MMA(1, 0, At, B0); PG8_BAR; PG8_SCHED;
            PG8_STAGE(PG8_SB(1, 1), b3 + hstep, voffB);
            PG8_WAIT_V(6); PG8_BAR; PG8_MMA(1, 1, At, B1); PG8_BAR;
            }
        }
        if constexpr (ALIGN_EPI) { if (wr == 0) PG8_BAR; }
        E(acc, cur, wr, wc, fr, fq); S.done(cur);
        if (!has_next) break;
#pragma unroll
        for (int a = 0; a < 2; ++a)
#pragma unroll
            for (int b = 0; b < 2; ++b)
#pragma unroll
                for (int m = 0; m < 4; ++m)
#pragma unroll
                    for (int n = 0; n < 2; ++n) acc[a][b][m][n] = (f32x4){0.f, 0.f, 0.f, 0.f};
        cur = nxt; cA = nA; cB = nB; ++ui;
        if constexpr (ALIGN_EPI) { if (wr == 1) PG8_BAR; }
    }
    PG8_WAIT_V(0);
    if constexpr (!ALIGN_EPI) { if (wr == 0) PG8_BAR; }
    PG8_BAR;
#undef PG8_SA
#undef PG8_SB
#undef PG8_STAGE
#undef PG8_LDA
#undef PG8_LDB
#undef PG8_MMA
#undef PG8_WAIT_V
#undef PG8_WAIT_L
#undef PG8_BAR
#undef PG8_SCHED
}

__device__ __forceinline__ void rows_rstd(const float* __restrict__ ssq, int row0, int fq, float (&rs)[2][4]) {
    f32x4 pp[2][4];
#pragma unroll
    for (int ai = 0; ai < 2; ++ai)
#pragma unroll
        for (int m = 0; m < 4; ++m) pp[ai][m] = *(const f32x4*)(ssq + (size_t)(row0 + ai * HALF + m * 16) * 16 + 4 * fq);
#pragma unroll
    for (int ai = 0; ai < 2; ++ai)
#pragma unroll
        for (int m = 0; m < 4; ++m) { float s = (pp[ai][m][0] + pp[ai][m][1]) + (pp[ai][m][2] + pp[ai][m][3]); s += __shfl_xor(s, 16); s += __shfl_xor(s, 32); rs[ai][m] = rsqrtf(s * (1.0f / 1024.0f) + EPS); }
}
struct EpiZ {
    static constexpr bool PERM = true;
    bf16_t* Z; bf16_t* DEC; const float* ssq;
    __device__ __forceinline__ void operator()(const f32x4 (&acc)[2][2][4][2], const Unit& u, int wr, int wc, int fr, int fq) const {
        const int row0 = u.pm * BM + wr * 64 + fr; const int pn = u.pn;
        float rsv[2][4]; rows_rstd(ssq, row0, fq, rsv);
#pragma unroll
        for (int ai = 0; ai < 2; ++ai)
#pragma unroll
            for (int m = 0; m < 4; ++m) {
                const int r = row0 + ai * HALF + m * 16; const float rs = rsv[ai][m];
                if (pn == 8) {
                    if (wc == 0) { const f32x4 v0 = acc[ai][0][m][0] * rs, v1 = acc[ai][0][m][1] * rs; u32x4 w; w.x = cvt_pk_bf16(v0[0], v0[1]); w.y = cvt_pk_bf16(v0[2], v0[3]); w.z = cvt_pk_bf16(v1[0], v1[1]); w.w = cvt_pk_bf16(v1[2], v1[3]); *(u32x4*)(DEC + (size_t)r * 32 + 8 * fq) = w; }
                } else {
                    bf16_t* rowp = Z + (size_t)r * ZW + pn * BM + wc * 32 + 8 * fq;
#pragma unroll
                    for (int bj = 0; bj < 2; ++bj) { f32x4 v0 = acc[ai][bj][m][0] * rs, v1 = acc[ai][bj][m][1] * rs;
                        if (pn >= 4 && pn < 6) {
#pragma unroll
                            for (int j = 0; j < 4; ++j) { v0[j] = silu_f(v0[j]); v1[j] = silu_f(v1[j]); } }
                        u32x4 w; w.x = cvt_pk_bf16(v0[0], v0[1]); w.y = cvt_pk_bf16(v0[2], v0[3]); w.z = cvt_pk_bf16(v1[0], v1[1]); w.w = cvt_pk_bf16(v1[2], v1[3]);
                        *(u32x4*)(rowp + bj * HALF) = w; }
                }
            }
    }
};
struct EpiH {
    static constexpr bool PERM = true;
    bf16_t* H; const float* ssq;
    __device__ __forceinline__ void operator()(const f32x4 (&acc)[2][2][4][2], const Unit& u, int wr, int wc, int fr, int fq) const {
        const int row0 = u.pm * BM + wr * 64 + fr;
        float rsv[2][4]; rows_rstd(ssq, row0, fq, rsv);
#pragma unroll
        for (int ai = 0; ai < 2; ++ai)
#pragma unroll
            for (int m = 0; m < 4; ++m) {
                const int r = row0 + ai * HALF + m * 16; const float rs = rsv[ai][m];
                bf16_t* rowp = H + (size_t)r * FF + u.pn * BM + wc * 32 + 8 * fq;
#pragma unroll
                for (int bj = 0; bj < 2; ++bj) { f32x4 v0 = acc[ai][bj][m][0] * rs, v1 = acc[ai][bj][m][1] * rs;
#pragma unroll
                    for (int j = 0; j < 4; ++j) { const float a = fmaxf(v0[j], 0.f), b = fmaxf(v1[j], 0.f); v0[j] = a * a; v1[j] = b * b; }
                    u32x4 w; w.x = cvt_pk_bf16(v0[0], v0[1]); w.y = cvt_pk_bf16(v0[2], v0[3]); w.z = cvt_pk_bf16(v1[0], v1[1]); w.w = cvt_pk_bf16(v1[2], v1[3]);
                    *(u32x4*)(rowp + bj * HALF) = w; }
            }
    }
};
template <bool RD32>
__device__ __forceinline__ void res_rows(const float* __restrict__ xold32, const bf16_t* __restrict__ xoldb, bf16_t* __restrict__ xb, float* __restrict__ ssq, const f32x4 (&acc)[2][2][4][2], int row0, int col0, int slot) {
    f32x4 xo[2][2][2];
    float ssv[8];
    auto ld = [&](size_t o, f32x4& a, f32x4& b) { if (RD32) { a = *(const f32x4*)(xold32 + o); b = *(const f32x4*)(xold32 + o + 4); }
        else { const u32x4 w = *(const u32x4*)(xoldb + o); a = (f32x4){bflo(w.x), bfhi(w.x), bflo(w.y), bfhi(w.y)}; b = (f32x4){bflo(w.z), bfhi(w.z), bflo(w.w), bfhi(w.w)}; } };
#pragma unroll
    for (int bj = 0; bj < 2; ++bj) ld((size_t)row0 * D + col0 + bj * HALF, xo[0][bj][0], xo[0][bj][1]);
#pragma unroll
    for (int idx = 0; idx < 8; ++idx) {
        const int ai = idx >> 2, m = idx & 3; const int r = row0 + ai * HALF + m * 16; const size_t off = (size_t)r * D + col0;
        if (idx < 7) { const int ai2 = (idx + 1) >> 2, m2 = (idx + 1) & 3; const size_t off2 = (size_t)(row0 + ai2 * HALF + m2 * 16) * D + col0;
#pragma unroll
            for (int bj = 0; bj < 2; ++bj) ld(off2 + bj * HALF, xo[(idx + 1) & 1][bj][0], xo[(idx + 1) & 1][bj][1]); }
        float ss = 0.f;
#pragma unroll
        for (int bj = 0; bj < 2; ++bj) { const f32x4 x0 = xo[idx & 1][bj][0] + acc[ai][bj][m][0], x1 = xo[idx & 1][bj][1] + acc[ai][bj][m][1];
            u32x4 w; w.x = cvt_pk_bf16(x0[0], x0[1]); w.y = cvt_pk_bf16(x0[2], x0[3]); w.z = cvt_pk_bf16(x1[0], x1[1]); w.w = cvt_pk_bf16(x1[2], x1[3]);
            *(u32x4*)(xb + off + bj * HALF) = w;
            ss += ((x0[0] * x0[0] + x0[1] * x0[1]) + (x0[2] * x0[2] + x0[3] * x0[3])) + ((x1[0] * x1[0] + x1[1] * x1[1]) + (x1[2] * x1[2] + x1[3] * x1[3])); }
        ss += __shfl_xor(ss, 16); ss += __shfl_xor(ss, 32);
        ssv[idx] = ss;
    }
    const int fq = slot >> 6;
#pragma unroll
    for (int j = 0; j < 2; ++j) { const float v = fq == 0 ? ssv[j] : fq == 1 ? ssv[2 + j] : fq == 2 ? ssv[4 + j] : ssv[6 + j]; const int idx = 2 * fq + j;
        ssq[(size_t)(row0 + (idx >> 2) * HALF + (idx & 3) * 16) * 16 + (slot & 15)] = v; }
}
struct EpiRes {
    static constexpr bool PERM = true;
    const float* xold32; float* xout; bf16_t* xb; float* ssq; int mode;
    __device__ __forceinline__ void operator()(const f32x4 (&acc)[2][2][4][2], const Unit& u, int wr, int wc, int fr, int fq) const {
        const int row0 = u.pm * BM + wr * 64 + fr, col0 = u.pn * BM + wc * 32 + 8 * fq, slot = (u.pn * 4 + wc) | (fq << 6);
        if (mode == 0) res_rows<false>(xold32, xb, xb, ssq, acc, row0, col0, slot);
        else res_rows<true>(xold32, xb, xb, ssq, acc, row0, col0, slot);
    }
};
}

struct WTile { const float* src; bf16_t* dst; const float* g; int ldsrc, K, n0, k0, mode; };
__device__ __forceinline__ WTile wtile_desc(const Params& p, int it) {
    unsigned char* ws = p.ws; WTile t; const int l = it / 3008; int r = it % 3008;
    if (r < 704) { t.src = p.w_in + (size_t)l * D * D_IN; t.ldsrc = D_IN; t.dst = (bf16_t*)(ws + WS_WIN) + (size_t)l * ZW * D; t.K = D; t.n0 = (r / 16) * 64; t.k0 = (r % 16) * 64; t.g = p.norm_mix_g + l * D; t.mode = 0; }
    else if (r < 960) { r -= 704; t.src = p.w_out + (size_t)l * D * D; t.ldsrc = D; t.dst = (bf16_t*)(ws + WS_WOUT) + (size_t)l * D * D; t.K = D; t.n0 = (r / 16) * 64; t.k0 = (r % 16) * 64; t.g = nullptr; t.mode = 1; }
    else if (r < 1984) { r -= 960; t.src = p.w_mlp1 + (size_t)l * D * FF; t.ldsrc = FF; t.dst = (bf16_t*)(ws + WS_W1) + (size_t)l * FF * D; t.K = D; t.n0 = (r / 16) * 64; t.k0 = (r % 16) * 64; t.g = p.norm_mlp_g + l * D; t.mode = 1; }
    else { r -= 1984; t.src = p.w_mlp2 + (size_t)l * FF * D; t.ldsrc = D; t.dst = (bf16_t*)(ws + WS_W2) + (size_t)l * D * FF; t.K = FF; t.n0 = (r / 64) * 64; t.k0 = (r % 64) * 64; t.g = nullptr; t.mode = 1; }
    return t;
}
__device__ __forceinline__ void wtile_load(const WTile& w, int t, f32x4& a, f32x4& b, float& rsc) {
    const int kk = t >> 3, ns = (t & 7) * 8; const int nd = w.n0 + ns; int nsrc = nd; bool valid = true; float cs = 1.0f;
    if (w.mode == 0) { if (nd < 1536) nsrc = nd; else if (nd < 2048) nsrc = nd + 32; else if (nd < 2080) nsrc = nd - 512; else if (nd < 2304) valid = false; else nsrc = nd - 224; if (nd < 256) cs = 0.125f; }
    a = (f32x4){0.f, 0.f, 0.f, 0.f}; b = a;
    if (valid) { const float* sp = w.src + (size_t)(w.k0 + kk) * w.ldsrc + nsrc; a = *(const f32x4*)sp; b = *(const f32x4*)(sp + 4); }
    rsc = (w.g ? w.g[w.k0 + kk] : 1.0f) * cs;
}

PHASE_FN void phase_prep(const Params& p, float* ldsf) {
    unsigned char* ws = p.ws;
    const int G = gridDim.x, bx = blockIdx.x; int tid = threadIdx.x; asm volatile("" : "+v"(tid));
    { const int NT = DEPTH * 3008; int it = bx, buf = 0; f32x4 a, b; float rsc;
      WTile cur = wtile_desc(p, it < NT ? it : 0);
      if (it < NT) wtile_load(cur, tid, a, b, rsc);
      for (; it < NT; it += G, buf ^= 1) {
          float* tile = ldsf + buf * (64 * 65);
          { const int kk = tid >> 3, ns = (tid & 7) * 8; float* tp = tile + kk * 65 + ns;
#pragma unroll
            for (int j = 0; j < 4; ++j) { tp[j] = a[j] * rsc; tp[4 + j] = b[j] * rsc; } }
          const WTile w = cur;
          if (it + G < NT) { cur = wtile_desc(p, it + G); wtile_load(cur, tid, a, b, rsc); }
          asm volatile("s_waitcnt lgkmcnt(0)" ::: "memory"); __builtin_amdgcn_s_barrier(); asm volatile("" ::: "memory");
          { const int nn = tid >> 3, ks = (tid & 7) * 8; float v[8];
#pragma unroll
            for (int i = 0; i < 8; ++i) v[i] = tile[(ks + i) * 65 + nn];
            u32x4 o; o.x = cvt_pk_bf16(v[0], v[1]); o.y = cvt_pk_bf16(v[2], v[3]); o.z = cvt_pk_bf16(v[4], v[5]); o.w = cvt_pk_bf16(v[6], v[7]);
            *(u32x4*)(w.dst + (size_t)(w.n0 + nn) * w.K + w.k0 + ks) = o; }
      }
      __syncthreads(); }
    { bf16_t* wsb = (bf16_t*)(ws + WS_WSB);
      for (int i = (bx * 512 + tid) * 4; i < DEPTH * 4 * 128 * 128; i += G * 512 * 4) { const f32x4 v = *(const f32x4*)(p.w_s + i); u32x2 w; w.x = cvt_pk_bf16(v[0], v[1]); w.y = cvt_pk_bf16(v[2], v[3]); *(u32x2*)(wsb + i) = w; } }
    { bf16_t* xb = (bf16_t*)(ws + WS_XB); float* ssq = (float*)(ws + WS_SSQ); const int wid = tid >> 6, lane = tid & 63;
      for (int r = bx * 8 + wid; r < T; r += G * 8) { const float* xr = p.x + (size_t)r * D; float ss = 0.f;
#pragma unroll
          for (int i = 0; i < 4; ++i) { const int c = i * 256 + lane * 4; const f32x4 v = *(const f32x4*)(xr + c); ss += (v[0] * v[0] + v[1] * v[1]) + (v[2] * v[2] + v[3] * v[3]);
              u32x2 w; w.x = cvt_pk_bf16(v[0], v[1]); w.y = cvt_pk_bf16(v[2], v[3]); *(u32x2*)(xb + (size_t)r * D + c) = w; }
#pragma unroll
          for (int o = 32; o >= 1; o >>= 1) ss += __shfl_xor(ss, o);
          if (lane < 16) ssq[(size_t)r * 16 + lane] = lane == 0 ? ss : 0.f; } }
}

constexpr int GP = 72;
constexpr int VP = 132;
#define ROT(row, col) (((col) + 16 * ((row) >> 4)) & 63)
constexpr int L_QIN = 0, L_KIN = 9216, L_QOUT = 18432, L_KOUTT = 27648;
constexpr int L_DEC = 36864;
constexpr int L_RED = L_DEC + 256;
constexpr int L_QRAW = L_RED + 1024;
constexpr int L_KRAW = L_QRAW + 8192;
constexpr int L_ARAW = L_KRAW + 8192;
constexpr int L_VRAW = L_ARAW + 2048;
static_assert(L_VRAW + 64 * VP * 2 <= 131072, "GLA LDS map");

__device__ __forceinline__ float logsig2(float d) {
    const float t = fabsf(d) * 1.44269504089f; const float e = __builtin_amdgcn_exp2f(-t); const float lg = __builtin_amdgcn_logf(1.0f + e);
    return (fminf(d, 0.f) * 1.44269504089f - lg) * 0.0625f;
}
#define GLA_BAR() do { asm volatile("s_waitcnt lgkmcnt(0)" ::: "memory"); __builtin_amdgcn_s_barrier(); asm volatile("" ::: "memory"); } while (0)
#define CHUNK(si) (dir ? 63 - (si) : (si))
#define POS(r) (dir ? 63 - (r) : (r))

struct GlaRegs { u32x4 q0, q1, k0, k1, a, v0, v1, v2, v3; };
struct GlaPrepCtx {
    const bf16_t* Z; const bf16_t* DEC; unsigned* myflag; unsigned* paflag;
    bf16_t* qin; bf16_t* kin; bf16_t* qout; bf16_t* koutT; float* decs; bf16_t* qraw; bf16_t* kraw; bf16_t* araw; bf16_t* vraw;
    int tid, wid, lr, q4, b, h, dir, lrow, lcs, vrow, vcs, arow, acs, ch; bf16x8 w2f; float bias;
};
#define ST8_(pp, v) do { *(u32x2*)(pp) = (u32x2){(v).x, (v).y}; *(u32x2*)((pp) + 4) = (u32x2){(v).z, (v).w}; } while (0)
__device__ __forceinline__ void gla_load_qka(const GlaPrepCtx& c, int si, GlaRegs& R) {
    const int dir = c.dir; const size_t t0 = (size_t)(c.b * SEQ + CHUNK(si) * 64); const bf16_t* zr = c.Z + (t0 + c.lrow) * ZW + c.h * 64 + c.lcs;
    R.q0 = *(const u32x4*)(zr + ZQ); R.k0 = *(const u32x4*)(zr + ZK); R.q1 = *(const u32x4*)(zr + (size_t)32 * ZW + ZQ); R.k1 = *(const u32x4*)(zr + (size_t)32 * ZW + ZK);
    if (c.tid < 128) R.a = *(const u32x4*)(c.DEC + (t0 + c.arow) * 32 + dir * 16 + c.acs);
}
__device__ __forceinline__ void gla_load_v(const GlaPrepCtx& c, int si, GlaRegs& R) {
    const int dir = c.dir; const size_t t0 = (size_t)(c.b * SEQ + CHUNK(si) * 64); const bf16_t* vr = c.Z + (t0 + c.vrow) * ZW + ZV + c.h * 128 + c.vcs;
    R.v0 = *(const u32x4*)vr; R.v1 = *(const u32x4*)(vr + (size_t)16 * ZW); R.v2 = *(const u32x4*)(vr + (size_t)32 * ZW); R.v3 = *(const u32x4*)(vr + (size_t)48 * ZW);
}
__device__ __forceinline__ void gla_store_qka(const GlaPrepCtx& c, const GlaRegs& R) {
    const int dir = c.dir; const int r0_ = POS(c.lrow), r1_ = POS(c.lrow + 32);
    *(u32x4*)(c.qraw + r0_ * 64 + ROT(r0_, c.lcs)) = R.q0; *(u32x4*)(c.kraw + r0_ * 64 + ROT(r0_, c.lcs)) = R.k0; *(u32x4*)(c.qraw + r1_ * 64 + ROT(r1_, c.lcs)) = R.q1; *(u32x4*)(c.kraw + r1_ * 64 + ROT(r1_, c.lcs)) = R.k1;
    if (c.tid < 128) *(u32x4*)(c.araw + POS(c.arow) * 16 + c.acs) = R.a;
}
__device__ __forceinline__ void gla_store_v(const GlaPrepCtx& c, const GlaRegs& R) {
    const int dir = c.dir;
    ST8_(c.vraw + POS(c.vrow) * VP + c.vcs, R.v0); ST8_(c.vraw + POS(c.vrow + 16) * VP + c.vcs, R.v1); ST8_(c.vraw + POS(c.vrow + 32) * VP + c.vcs, R.v2); ST8_(c.vraw + POS(c.vrow + 48) * VP + c.vcs, R.v3);
}
__device__ __forceinline__ void gla_prep_step(const GlaPrepCtx& c, int s, GlaRegs& LD, GlaRegs& ST) {
    const int wid = c.wid, lr = c.lr, q4 = c.q4, ch = c.ch, tid = c.tid;
    if (s == 32) {
        if (wid == 0) { while (__hip_atomic_load(c.paflag, __ATOMIC_RELAXED, __HIP_MEMORY_SCOPE_AGENT) == 0u) __builtin_amdgcn_s_sleep(4);
            __builtin_amdgcn_fence(__ATOMIC_ACQUIRE, "agent"); asm volatile("s_waitcnt vmcnt(0)" ::: "memory"); }
        __syncthreads();
    }
    if (s + 3 < 64) gla_load_qka(c, s + 3, LD);
    if (s + 2 < 64) gla_load_v(c, s + 2, LD);
    unsigned rq[8], rk[8], ro[8], rko[8]; float rdec = 0.f;
    if (s < 63) {
        float la[16];
#pragma unroll
        for (int cb = 0; cb < 4; ++cb) { const int pr = 16 * (lr >> 2) + 4 * cb + (lr & 3);
            u32x4 aw = (u32x4){0u, 0u, 0u, 0u}; if (q4 < 2) aw = *(const u32x4*)(c.araw + pr * 16 + 8 * q4);
            f32x4 d = (f32x4){c.bias, c.bias, c.bias, c.bias};
            d = __builtin_amdgcn_mfma_f32_16x16x32_bf16(__builtin_bit_cast(bf16x8, aw), c.w2f, d, 0, 0, 0);
#pragma unroll
            for (int jj = 0; jj < 4; ++jj) la[4 * cb + jj] = logsig2(d[jj]); }
#pragma unroll
        for (int i = 1; i < 16; ++i) la[i] += la[i - 1];
        const float tq = la[15]; float inc = tq;
        { const float t1 = __shfl_up(inc, 16); if (q4 >= 1) inc += t1; const float t2 = __shfl_up(inc, 32); if (q4 >= 2) inc += t2; }
        const float off = inc - tq;
        const float tot = __shfl(inc, lr + 48);
        const float bmid = __shfl(off + la[0], lr + 32);
        const float emid = __builtin_amdgcn_exp2f(bmid), etm = __builtin_amdgcn_exp2f(tot - bmid);
        rdec = __builtin_amdgcn_exp2f(tot);
        const int chr = (ch + 16 * q4) & 63;
#pragma unroll
        for (int i = 0; i < 16; i += 2) {
            const int p0 = 16 * q4 + i;
            const float x0 = off + la[i] - bmid, x1 = off + la[i + 1] - bmid;
            const float e10 = __builtin_amdgcn_exp2f(x0), e20 = __builtin_amdgcn_exp2f(-x0), e11 = __builtin_amdgcn_exp2f(x1), e21 = __builtin_amdgcn_exp2f(-x1);
            const float q0 = bf2f(c.qraw[p0 * 64 + chr]) * e10, q1 = bf2f(c.qraw[(p0 + 1) * 64 + chr]) * e11;
            const float k0 = bf2f(c.kraw[p0 * 64 + chr]) * e20, k1 = bf2f(c.kraw[(p0 + 1) * 64 + chr]) * e21;
            rq[i >> 1] = cvt_pk_bf16(q0, q1); rk[i >> 1] = cvt_pk_bf16(k0, k1); ro[i >> 1] = cvt_pk_bf16(q0 * emid, q1 * emid); rko[i >> 1] = cvt_pk_bf16(k0 * etm, k1 * etm);
        }
    }
    GLA_BAR();
    if (s < 63) {
        const int chr = (ch + 16 * q4) & 63;
#pragma unroll
        for (int i = 0; i < 8; ++i) { const int p0 = 16 * q4 + 2 * i;
            c.qin[p0 * GP + chr] = (bf16_t)(rq[i] & 0xffffu); c.qin[(p0 + 1) * GP + chr] = (bf16_t)(rq[i] >> 16);
            c.kin[p0 * GP + chr] = (bf16_t)(rk[i] & 0xffffu); c.kin[(p0 + 1) * GP + chr] = (bf16_t)(rk[i] >> 16);
            c.qout[p0 * GP + chr] = (bf16_t)(ro[i] & 0xffffu); c.qout[(p0 + 1) * GP + chr] = (bf16_t)(ro[i] >> 16); }
        *(u32x4*)(c.koutT + ch * GP + 16 * q4) = (u32x4){rko[0], rko[1], rko[2], rko[3]}; *(u32x4*)(c.koutT + ch * GP + 16 * q4 + 8) = (u32x4){rko[4], rko[5], rko[6], rko[7]};
        if (q4 == 0) c.decs[ch] = rdec;
    }
    if (s + 2 < 64) gla_store_qka(c, ST);
    if (s + 1 < 64) gla_store_v(c, ST);
    if (s == 31) {
        asm volatile("s_waitcnt vmcnt(0)" ::: "memory"); __syncthreads();
        if (tid == 0) { __builtin_amdgcn_fence(__ATOMIC_RELEASE, "agent"); asm volatile("s_waitcnt vmcnt(0)" ::: "memory"); __hip_atomic_store(c.myflag, 1u, __ATOMIC_RELAXED, __HIP_MEMORY_SCOPE_AGENT); }
    }
    GLA_BAR();
}

__device__ __forceinline__ void gla_prep(const Params& p, unsigned char* lds, int l, int item, int tid) {
    unsigned char* ws = p.ws;
    GlaPrepCtx c;
    c.tid = tid; c.wid = __builtin_amdgcn_readfirstlane(tid >> 6); const int lane = tid & 63; c.lr = lane & 15; c.q4 = lane >> 4;
    c.b = item >> 3; c.h = (item >> 1) & 3; c.dir = item & 1; const int dir = c.dir;
    c.Z = (const bf16_t*)(ws + WS_Z); c.DEC = (const bf16_t*)(ws + WS_DEC);
    unsigned* flags = (unsigned*)(ws + WS_CTL);
    c.myflag = flags + (size_t)(l * 128 + item) * 64; c.paflag = flags + (size_t)(l * 128 + (item ^ 1)) * 64;
    c.qin = (bf16_t*)(lds + L_QIN); c.kin = (bf16_t*)(lds + L_KIN); c.qout = (bf16_t*)(lds + L_QOUT); c.koutT = (bf16_t*)(lds + L_KOUTT);
    c.decs = (float*)(lds + L_DEC);
    c.qraw = (bf16_t*)(lds + L_QRAW); c.kraw = (bf16_t*)(lds + L_KRAW); c.araw = (bf16_t*)(lds + L_ARAW); c.vraw = (bf16_t*)(lds + L_VRAW);
    c.lrow = tid >> 3; c.lcs = (tid & 7) * 8; c.vrow = tid >> 4; c.vcs = (tid & 15) * 8; c.arow = tid >> 1; c.acs = (tid & 1) * 8;
    c.ch = 16 * c.wid + c.lr;
    { const float* w2 = (dir ? p.w_a2_bwd : p.w_a2_fwd) + (size_t)l * 16 * 256 + c.h * 64 + c.ch; u32x4 w = (u32x4){0u, 0u, 0u, 0u};
      if (c.q4 < 2) { float t[8];
#pragma unroll
          for (int i = 0; i < 8; ++i) t[i] = w2[(8 * c.q4 + i) * 256];
          w.x = cvt_pk_bf16(t[0], t[1]); w.y = cvt_pk_bf16(t[2], t[3]); w.z = cvt_pk_bf16(t[4], t[5]); w.w = cvt_pk_bf16(t[6], t[7]); }
      c.w2f = __builtin_bit_cast(bf16x8, w); c.bias = (dir ? p.b_a_bwd : p.b_a_fwd)[l * 256 + c.h * 64 + c.ch]; }
    GlaRegs RA, RB;
    gla_load_qka(c, 0, RA); gla_store_qka(c, RA);
    gla_load_qka(c, 1, RB); gla_load_v(c, 0, RB);
    GLA_BAR();
    for (int s = -1; s < 63; s += 2) { gla_prep_step(c, s, RA, RB); gla_prep_step(c, s + 1, RB, RA); }
    gla_prep_step(c, 63, RA, RB);
}
#undef ST8_

__device__ __forceinline__ void gla_mma(const Params& p, unsigned char* lds, int l, int item, int tid) {
    unsigned char* ws = p.ws;
    const int wid = __builtin_amdgcn_readfirstlane(tid >> 6), lane = tid & 63, lr = lane & 15, q4 = lane >> 4;
    const int b = item >> 3, h = (item >> 1) & 3, dir = item & 1;
    const bf16_t* Z = (const bf16_t*)(ws + WS_Z); bf16_t* OX = (bf16_t*)(ws + WS_OX); bf16_t* MIX = (bf16_t*)(ws + WS_MIX);
    const bf16_t* qin = (const bf16_t*)(lds + L_QIN); const bf16_t* kin = (const bf16_t*)(lds + L_KIN); const bf16_t* qout = (const bf16_t*)(lds + L_QOUT); const bf16_t* koutT = (const bf16_t*)(lds + L_KOUTT);
    const float* decs = (const float*)(lds + L_DEC); float* red = (float*)(lds + L_RED); const bf16_t* vraw = (const bf16_t*)(lds + L_VRAW);
    const int vq = wid & 3;
    const int ocol = h * 128 + 32 * vq + 8 * q4;
    f32x4 ng[2];
#pragma unroll
    for (int vb = 0; vb < 2; ++vb) ng[vb] = *(const f32x4*)(p.gla_norm_g + (size_t)l * 512 + ocol + 4 * vb);
    f32x4 accS[2][4];
#pragma unroll
    for (int vb = 0; vb < 2; ++vb)
#pragma unroll
        for (int i = 0; i < 4; ++i) accS[vb][i] = (f32x4){0.f, 0.f, 0.f, 0.f};
    GLA_BAR();
    for (int s = -1; s < 64; ++s) {
        const int tok0 = b * SEQ + CHUNK(s < 0 ? 0 : s) * 64;
#define TOK(c) (tok0 + (dir ? 63 - (c) : (c)))
        if (s == 32) __syncthreads();
        f32x4 accO[2][4]; u32x4 gw[4];
        if (s >= 0) {
            u32x4 ox[4];
            bf16x8 vfrag[2][2];
#pragma unroll
            for (int vb = 0; vb < 2; ++vb)
#pragma unroll
                for (int pp = 0; pp < 2; ++pp)
#pragma unroll
                    for (int i = 0; i < 8; ++i) { const int pos = 32 * pp + 4 * q4 + (i & 3) + ((i >> 2) << 4); vfrag[vb][pp][i] = (short)vraw[pos * VP + 32 * vq + 8 * (lr >> 2) + 4 * vb + (lr & 3)]; }
            bf16x8 qf[4][2], kf[4][2];
#pragma unroll
            for (int cb = 0; cb < 4; ++cb) { qf[cb][0] = *(const bf16x8*)(qin + (16 * cb + lr) * GP + ((8 * q4 + 16 * cb) & 63)); qf[cb][1] = *(const bf16x8*)(qin + (16 * cb + lr) * GP + ((32 + 8 * q4 + 16 * cb) & 63));
                kf[cb][0] = *(const bf16x8*)(kin + (16 * cb + lr) * GP + ((8 * q4 + 16 * cb) & 63)); kf[cb][1] = *(const bf16x8*)(kin + (16 * cb + lr) * GP + ((32 + 8 * q4 + 16 * cb) & 63)); }
            bf16x8 P0[4], P1[2];
            {
                f32x4 sc[4][4];
#pragma unroll
                for (int cb = 0; cb < 4; ++cb)
#pragma unroll
                    for (int jb = 0; jb < 4; ++jb) {
                        if (jb > cb) { sc[jb][cb] = (f32x4){0.f, 0.f, 0.f, 0.f}; continue; }
                        f32x4 a = (f32x4){0.f, 0.f, 0.f, 0.f};
                        a = __builtin_amdgcn_mfma_f32_16x16x32_bf16(kf[jb][0], qf[cb][0], a, 0, 0, 0);
                        sc[jb][cb] = a;
                    }
#pragma unroll
                for (int cb = 0; cb < 4; ++cb)
#pragma unroll
                    for (int jb = 0; jb <= cb; ++jb) sc[jb][cb] = __builtin_amdgcn_mfma_f32_16x16x32_bf16(kf[jb][1], qf[cb][1], sc[jb][cb], 0, 0, 0);
            __builtin_amdgcn_sched_barrier(0);
            if (s >= 32) {
#pragma unroll
                for (int cb = 0; cb < 4; ++cb) { const size_t tk = (size_t)TOK(16 * cb + lr); ox[cb] = *(const u32x4*)(OX + tk * 512 + ocol); gw[cb] = *(const u32x4*)(Z + tk * ZW + ZG + ocol); }
            }
#pragma unroll
                for (int cb = 0; cb < 4; ++cb) {
#pragma unroll
                    for (int jj = 0; jj < 4; ++jj) { const int j = 4 * q4 + jj; const bool keep = dir ? (lr > j) : (lr >= j); sc[cb][cb][jj] = keep ? sc[cb][cb][jj] : 0.f; }
                    { u32x4 w; w.x = cvt_pk_bf16(sc[0][cb][0], sc[0][cb][1]); w.y = cvt_pk_bf16(sc[0][cb][2], sc[0][cb][3]); w.z = cvt_pk_bf16(sc[1][cb][0], sc[1][cb][1]); w.w = cvt_pk_bf16(sc[1][cb][2], sc[1][cb][3]); P0[cb] = __builtin_bit_cast(bf16x8, w); }
                    if (cb >= 2) { u32x4 w; w.x = cvt_pk_bf16(sc[2][cb][0], sc[2][cb][1]); w.y = cvt_pk_bf16(sc[2][cb][2], sc[2][cb][3]); w.z = cvt_pk_bf16(sc[3][cb][0], sc[3][cb][1]); w.w = cvt_pk_bf16(sc[3][cb][2], sc[3][cb][3]); P1[cb - 2] = __builtin_bit_cast(bf16x8, w); }
                }
            }
            bf16x8 qo[4][2];
#pragma unroll
            for (int cb = 0; cb < 4; ++cb)
#pragma unroll
                for (int pp = 0; pp < 2; ++pp) { const bf16_t* qr = qout + (16 * cb + lr) * GP; const u32x2 lo = *(const u32x2*)(qr + ((32 * pp + 4 * q4 + 16 * cb) & 63)), hi = *(const u32x2*)(qr + ((32 * pp + 4 * q4 + 16 + 16 * cb) & 63)); qo[cb][pp] = __builtin_bit_cast(bf16x8, ((u32x4){lo.x, lo.y, hi.x, hi.y})); }
            bf16x8 Sp[2][2];
#pragma unroll
            for (int vb = 0; vb < 2; ++vb)
#pragma unroll
                for (int pp = 0; pp < 2; ++pp) { u32x4 w; w.x = cvt_pk_bf16(accS[vb][2 * pp][0], accS[vb][2 * pp][1]); w.y = cvt_pk_bf16(accS[vb][2 * pp][2], accS[vb][2 * pp][3]);
                    w.z = cvt_pk_bf16(accS[vb][2 * pp + 1][0], accS[vb][2 * pp + 1][1]); w.w = cvt_pk_bf16(accS[vb][2 * pp + 1][2], accS[vb][2 * pp + 1][3]); Sp[vb][pp] = __builtin_bit_cast(bf16x8, w); }
#pragma unroll
            for (int cb = 0; cb < 4; ++cb)
#pragma unroll
                for (int vb = 0; vb < 2; ++vb) {
                    f32x4 a = (f32x4){0.f, 0.f, 0.f, 0.f};
                    a = __builtin_amdgcn_mfma_f32_16x16x32_bf16(Sp[vb][0], qo[cb][0], a, 0, 0, 0);
                    accO[vb][cb] = a; }
#pragma unroll
            for (int cb = 0; cb < 4; ++cb)
#pragma unroll
                for (int vb = 0; vb < 2; ++vb) accO[vb][cb] = __builtin_amdgcn_mfma_f32_16x16x32_bf16(Sp[vb][1], qo[cb][1], accO[vb][cb], 0, 0, 0);
#pragma unroll
            for (int cb = 0; cb < 4; ++cb)
#pragma unroll
                for (int vb = 0; vb < 2; ++vb) accO[vb][cb] = __builtin_amdgcn_mfma_f32_16x16x32_bf16(vfrag[vb][0], P0[cb], accO[vb][cb], 0, 0, 0);
#pragma unroll
            for (int cb = 2; cb < 4; ++cb)
#pragma unroll
                for (int vb = 0; vb < 2; ++vb) accO[vb][cb] = __builtin_amdgcn_mfma_f32_16x16x32_bf16(vfrag[vb][1], P1[cb - 2], accO[vb][cb], 0, 0, 0);
            __builtin_amdgcn_sched_barrier(0);
            bf16x8 ko[4][2]; f32x4 dv[4];
#pragma unroll
            for (int kb = 0; kb < 4; ++kb) { dv[kb] = *(const f32x4*)(decs + 16 * kb + 4 * q4);
#pragma unroll
                for (int pp = 0; pp < 2; ++pp) { const bf16_t* kp = koutT + (16 * kb + lr) * GP + 32 * pp + 4 * q4; const u32x2 lo = *(const u32x2*)kp, hi = *(const u32x2*)(kp + 16); ko[kb][pp] = __builtin_bit_cast(bf16x8, ((u32x4){lo.x, lo.y, hi.x, hi.y})); } }
#pragma unroll
            for (int kb = 0; kb < 4; ++kb)
#pragma unroll
                for (int vb = 0; vb < 2; ++vb) accS[vb][kb] = __builtin_amdgcn_mfma_f32_16x16x32_bf16(ko[kb][0], vfrag[vb][0], accS[vb][kb] * dv[kb], 0, 0, 0);
#pragma unroll
            for (int kb = 0; kb < 4; ++kb)
#pragma unroll
                for (int vb = 0; vb < 2; ++vb) accS[vb][kb] = __builtin_amdgcn_mfma_f32_16x16x32_bf16(ko[kb][1], vfrag[vb][1], accS[vb][kb], 0, 0, 0);
            if (s < 32) {
#pragma unroll
                for (int cb = 0; cb < 4; ++cb) { const f32x4 o0 = accO[0][cb], o1 = accO[1][cb]; *(u32x4*)(OX + (size_t)TOK(16 * cb + lr) * 512 + ocol) = (u32x4){cvt_pk_bf16(o0[0], o0[1]), cvt_pk_bf16(o0[2], o0[3]), cvt_pk_bf16(o1[0], o1[1]), cvt_pk_bf16(o1[2], o1[3])}; }
            } else {
#pragma unroll
                for (int cb = 0; cb < 4; ++cb) { float ss = 0.f;
#pragma unroll
                    for (int vb = 0; vb < 2; ++vb) { const unsigned xa = vb ? ox[cb].z : ox[cb].x, xb2 = vb ? ox[cb].w : ox[cb].y; accO[vb][cb] += (f32x4){bflo(xa), bfhi(xa), bflo(xb2), bfhi(xb2)}; const f32x4 o = accO[vb][cb]; ss += (o[0] * o[0] + o[1] * o[1]) + (o[2] * o[2] + o[3] * o[3]); }
                    ss += __shfl_xor(ss, 16); ss += __shfl_xor(ss, 32);
                    if (q4 == 0) red[vq * 64 + 16 * cb + lr] = ss; }
            }
        }
        GLA_BAR();
        if (s >= 32) {
#pragma unroll
            for (int cb = 0; cb < 4; ++cb) { const float ss = (red[16 * cb + lr] + red[64 + 16 * cb + lr]) + (red[128 + 16 * cb + lr] + red[192 + 16 * cb + lr]);
                const float rs = rsqrtf(ss * (1.0f / 128.0f) + EPS); const size_t tk = (size_t)TOK(16 * cb + lr);
                const f32x4 o0 = accO[0][cb] * rs * ng[0], o1 = accO[1][cb] * rs * ng[1]; const u32x4 g4 = gw[cb];
                u32x4 w; w.x = cvt_pk_bf16(o0[0] * bflo(g4.x), o0[1] * bfhi(g4.x)); w.y = cvt_pk_bf16(o0[2] * bflo(g4.y), o0[3] * bfhi(g4.y)); w.z = cvt_pk_bf16(o1[0] * bflo(g4.z), o1[1] * bfhi(g4.z)); w.w = cvt_pk_bf16(o1[2] * bflo(g4.w), o1[3] * bfhi(g4.w));
                *(u32x4*)(MIX + tk * D + ocol) = w; }
        }
        if (s == 31) { asm volatile("s_waitcnt vmcnt(0)" ::: "memory"); __syncthreads(); }
        GLA_BAR();
#undef TOK
    }
}
#undef CHUNK
#undef POS

PHASE_FN void gla_item(const Params& p, unsigned char* lds, int l, int item) {
    int tid = threadIdx.x; asm volatile("" : "+v"(tid));
    if (tid < 256) gla_prep(p, lds, l, item, tid); else gla_mma(p, lds, l, item, tid);
    __syncthreads();
}

constexpr int SP = 136;
constexpr int L_SW = 0;
constexpr int L_SV0 = 128 * SP * 2;
constexpr int L_SV1 = 2 * 128 * SP * 2;
PHASE_FN void sgu_block(const Params& p, unsigned char* lds, int l, int g, int ch0, int nch) {
    unsigned char* ws = p.ws;
    int tid = threadIdx.x; asm volatile("" : "+v"(tid));
    const int wid = __builtin_amdgcn_readfirstlane(tid >> 6), lane = tid & 63, lr = lane & 15, q4 = lane >> 4;
    const bf16_t* __restrict__ Z = (const bf16_t*)(ws + WS_Z); bf16_t* __restrict__ MIX = (bf16_t*)(ws + WS_MIX);
    const bf16_t* __restrict__ wsb = (const bf16_t*)(ws + WS_WSB) + (size_t)(l * 4 + g) * 128 * 128;
    bf16_t* wl = (bf16_t*)(lds + L_SW);
    const int lrow = tid >> 4, cs = (tid & 15) * 8;
#pragma unroll
    for (int i = 0; i < 4; ++i) *(u32x4*)(wl + (lrow + 32 * i) * SP + cs) = *(const u32x4*)(wsb + (size_t)(lrow + 32 * i) * 128 + cs);
    const float* ngp = p.sgu_norm_g + (size_t)l * 512 + g * 128 + cs; const f32x4 g0 = *(const f32x4*)ngp, g1 = *(const f32x4*)(ngp + 4);
    float bs[8];
#pragma unroll
    for (int pb = 0; pb < 8; ++pb) bs[pb] = p.b_s[(size_t)l * 512 + g * 128 + 16 * pb + lr];
    const int ocol = g * 128 + 16 * wid + 4 * q4;
    u32x4 pv[4];
#define SGU_LOAD(ch) do { _Pragma("unroll") for (int i = 0; i < 4; ++i) pv[i] = *(const u32x4*)(Z + (size_t)((ch) * 128 + lrow + 32 * i) * ZW + ZSV + g * 128 + cs); } while (0)
    SGU_LOAD(ch0);
    int buf = 0;
    for (int ch = ch0; ch < ch0 + nch; ++ch, buf ^= 1) {
        const int tok0 = ch * 128;
        bf16_t* vt = (bf16_t*)(lds + (buf ? L_SV1 : L_SV0));
#pragma unroll
        for (int i = 0; i < 4; ++i) { const u32x4 w = pv[i];
            float v[8];
            { const f32x2 a = gelu_pk((f32x2){bflo(w.x), bfhi(w.x)}), b2 = gelu_pk((f32x2){bflo(w.y), bfhi(w.y)}), c = gelu_pk((f32x2){bflo(w.z), bfhi(w.z)}), d = gelu_pk((f32x2){bflo(w.w), bfhi(w.w)});
              v[0] = a.x; v[1] = a.y; v[2] = b2.x; v[3] = b2.y; v[4] = c.x; v[5] = c.y; v[6] = d.x; v[7] = d.y; }
            float ss = 0.f;
#pragma unroll
            for (int k = 0; k < 8; ++k) ss += v[k] * v[k];
            ss += __shfl_xor(ss, 1); ss += __shfl_xor(ss, 2); ss += __shfl_xor(ss, 4); ss += __shfl_xor(ss, 8);
            const float rs = rsqrtf(ss * (1.0f / 128.0f) + EPS);
            u32x4 o; o.x = cvt_pk_bf16(v[0] * rs * g0[0], v[1] * rs * g0[1]); o.y = cvt_pk_bf16(v[2] * rs * g0[2], v[3] * rs * g0[3]);
            o.z = cvt_pk_bf16(v[4] * rs * g1[0], v[5] * rs * g1[1]); o.w = cvt_pk_bf16(v[6] * rs * g1[2], v[7] * rs * g1[3]);
            *(u32x4*)(vt + (lrow + 32 * i) * SP + cs) = o; }
        if (ch + 1 < ch0 + nch) SGU_LOAD(ch + 1);
        u32x2 uw[8];
#pragma unroll
        for (int pb = 0; pb < 8; ++pb) uw[pb] = *(const u32x2*)(Z + (size_t)(tok0 + 16 * pb + lr) * ZW + ZSU + ocol);
        asm volatile("s_waitcnt lgkmcnt(0)" ::: "memory"); __builtin_amdgcn_s_barrier(); asm volatile("" ::: "memory");
        bf16x8 af[4];
#pragma unroll
        for (int ks = 0; ks < 4; ++ks)
#pragma unroll
            for (int i = 0; i < 8; ++i) af[ks][i] = (short)vt[(32 * ks + 8 * q4 + i) * SP + 16 * wid + lr];
#pragma unroll
        for (int pb = 0; pb < 8; ++pb) {
            f32x4 a = (f32x4){0.f, 0.f, 0.f, 0.f};
#pragma unroll
            for (int ks = 0; ks < 4; ++ks) { const bf16x8 bf = *(const bf16x8*)(wl + (16 * pb + lr) * SP + 32 * ks + 8 * q4); a = __builtin_amdgcn_mfma_f32_16x16x32_bf16(af[ks], bf, a, 0, 0, 0); }
            const f32x2 u0 = gelu_pk((f32x2){bflo(uw[pb].x), bfhi(uw[pb].x)}), u1 = gelu_pk((f32x2){bflo(uw[pb].y), bfhi(uw[pb].y)});
            u32x2 w; w.x = cvt_pk_bf16((a[0] + bs[pb]) * u0.x, (a[1] + bs[pb]) * u0.y); w.y = cvt_pk_bf16((a[2] + bs[pb]) * u1.x, (a[3] + bs[pb]) * u1.y);
            *(u32x2*)(MIX + (size_t)(tok0 + 16 * pb + lr) * D + 512 + ocol) = w;
        }
    }
#undef SGU_LOAD
    __syncthreads();
}

#define XB_TMO      128
#define XB_XCNT(j)  (256  + 64 * (j))
#define XB_XSUB(j)  (1280 + 64 * (j))
#define XB_XGEN(j)  (2304 + 64 * (j))
#define XB_TOP      3328
#define XB_TOPGEN   3392
#define XCD_BAR_WORDS 3456
#define XB_SPIN_CAP (1u << 18)

__device__ __forceinline__ unsigned xb_ld(unsigned* p)              { return __hip_atomic_load(p, __ATOMIC_RELAXED, __HIP_MEMORY_SCOPE_AGENT); }
__device__ __forceinline__ unsigned xb_add(unsigned* p, unsigned v) { return __hip_atomic_fetch_add(p, v, __ATOMIC_RELAXED, __HIP_MEMORY_SCOPE_AGENT); }
__device__ __forceinline__ unsigned xb_xcc_id() { return (unsigned)__builtin_amdgcn_s_getreg((3 << 11) | 20) & 0xFu; }
#define XB_SPIN(cond, bar) do { unsigned _sp = 0; while (cond) { __builtin_amdgcn_s_sleep(1); \
    if ((++_sp & 255u) == 0u) { if (xb_ld(&(bar)[XB_TMO])) break; if (_sp > XB_SPIN_CAP) { atomicAdd(&(bar)[XB_TMO], 1u); break; } } } } while (0)

struct XcdBarrier {
    unsigned* bar; unsigned x;
    volatile LAS unsigned* st;
};

__device__ __forceinline__ XcdBarrier xcd_barrier_post(unsigned* bar, volatile LAS unsigned* st) {
    XcdBarrier b; b.bar = bar; b.x = xb_xcc_id(); b.st = st;
    if (threadIdx.x == 0) (void)xb_add(&bar[XB_XCNT(b.x)], 1u);
    return b;
}
__device__ __forceinline__ void xcd_barrier_complete(unsigned* bar, unsigned x, unsigned& nloc, unsigned& nx) {
    const unsigned G = gridDim.x * gridDim.y * gridDim.z;
    unsigned sum, cnt, mine, sp = 0u;
    for (;;) {
        sum = 0u; cnt = 0u; mine = 0u;
#pragma unroll
        for (unsigned j = 0; j < 16; ++j) { const unsigned c = xb_ld(&bar[XB_XCNT(j)]); sum += c; cnt += (c > 0u) ? 1u : 0u; mine = (j == x) ? c : mine; }
        if (sum == G) break;
        __builtin_amdgcn_s_sleep(1);
        if ((++sp & 255u) == 0u) { if (xb_ld(&bar[XB_TMO])) break; if (sp > XB_SPIN_CAP) { atomicAdd(&bar[XB_TMO], 1u); break; } }
    }
    nloc = mine > 0u ? mine : 1u; nx = cnt > 0u ? cnt : 1u;
}

__device__ __forceinline__ void xcd_barrier(const XcdBarrier& b) {
    asm volatile("s_waitcnt vmcnt(0)" ::: "memory");
    __syncthreads();
    if (threadIdx.x == 0) {
        unsigned* bar = b.bar;
        __builtin_amdgcn_s_waitcnt(0);
        unsigned nloc = b.st[0], nx = b.st[1];
        if (nloc == 0u) { xcd_barrier_complete(bar, b.x, nloc, nx); b.st[0] = nloc; b.st[1] = nx; }
        const unsigned old = xb_add(&bar[XB_XSUB(b.x)], 1u);
        const unsigned gen = old / nloc;
        if (old + 1u == (gen + 1u) * nloc) {
            __builtin_amdgcn_fence(__ATOMIC_RELEASE, "agent");
            asm volatile("s_waitcnt vmcnt(0)" ::: "memory");
            const unsigned og = xb_add(&bar[XB_TOP], 1u);
            const unsigned tg = og / nx;
            if (og + 1u == (tg + 1u) * nx) xb_add(&bar[XB_TOPGEN], 1u);
            else XB_SPIN(xb_ld(&bar[XB_TOPGEN]) == tg, bar);
            __builtin_amdgcn_fence(__ATOMIC_ACQUIRE, "agent");
            xb_add(&bar[XB_XGEN(b.x)], 1u);
            asm volatile("s_waitcnt vmcnt(0)" ::: "memory");
        } else {
            XB_SPIN(xb_ld(&bar[XB_XGEN(b.x)]) == gen, bar);
            __builtin_amdgcn_fence(__ATOMIC_ACQUIRE, "agent");
            asm volatile("s_waitcnt vmcnt(0)" ::: "memory");
        }
    }
    __syncthreads();
}

template <class Epi>
PHASE_FN void gemm_call(LAS unsigned char* ldsl, const bf16_t* A, const bf16_t* Bt, int N, int K, Epi E, int smode = 0, int sbase = 0) {
    pg8::Gemm g{A, Bt, T, N, K}; pg8::StaticOrder S; S.init(T, N, (int)gridDim.x, (int)blockIdx.x); S.mode = smode; S.base = sbase;
    pg8::gemm_phase<Epi, pg8::StaticOrder, true, true>(ldsl, g, S, E);
}
__global__ void __launch_bounds__(512, 2) fwd_megakernel(Params p) {
    extern __shared__ __attribute__((aligned(16))) unsigned char lds[];
    cg::grid_group grid = cg::this_grid();
    unsigned char* ws = p.ws;
    const int G = gridDim.x, bx = blockIdx.x;
    bf16_t* XB = (bf16_t*)(ws + WS_XB); float* SSQ = (float*)(ws + WS_SSQ); bf16_t* Zb = (bf16_t*)(ws + WS_Z); bf16_t* DECb = (bf16_t*)(ws + WS_DEC);
    bf16_t* MIXb = (bf16_t*)(ws + WS_MIX); bf16_t* HID = (bf16_t*)(ws + WS_HID);
    LAS unsigned char* ldsl = (LAS unsigned char*)lds;
    volatile LAS unsigned* xst = (volatile LAS unsigned*)(ldsl + 131072 + 320);
    if (threadIdx.x < 4) xst[threadIdx.x] = 0u;
    __syncthreads();
    const XcdBarrier xbar = xcd_barrier_post((unsigned*)(ws + WS_CTL + 512 * 1024), xst);

#ifndef NO_PREP
    phase_prep(p, (float*)lds);
#endif
    asm volatile("s_waitcnt vmcnt(0)" ::: "memory"); __syncthreads();
    __threadfence();
    grid.sync();
    for (int l = 0; l < DEPTH; ++l) {
        for (int part = 0; part < 2; ++part) {
            if (part == 1 && bx < 128) break;
            gemm_call<pg8::EpiZ>(ldsl, XB, (const bf16_t*)(ws + WS_WIN) + (size_t)l * ZW * D, part == 0 ? ZN_A : ZW, D, pg8::EpiZ{Zb, DECb, SSQ}, part, 2 * (bx - 128));
            if (part == 0) xcd_barrier(xbar);
        }
        if (bx < 128) gla_item(p, lds, l, bx);
        else if (bx < 256) {
            __builtin_amdgcn_fence(__ATOMIC_ACQUIRE, "agent"); asm volatile("s_waitcnt vmcnt(0)" ::: "memory"); __syncthreads();
            for (int g = 0; g < 4; ++g) sgu_block(p, lds, l, g, 4 * (bx - 128), 4);
        }
        xcd_barrier(xbar);
#ifndef NO_G2
        gemm_call<pg8::EpiRes>(ldsl, MIXb, (const bf16_t*)(ws + WS_WOUT) + (size_t)l * D * D, D, D, pg8::EpiRes{p.x, p.out, XB, SSQ, l == 0 ? 1 : 0});
#endif
        xcd_barrier(xbar);
#ifndef NO_G3
        gemm_call<pg8::EpiH>(ldsl, XB, (const bf16_t*)(ws + WS_W1) + (size_t)l * FF * D, FF, D, pg8::EpiH{HID, SSQ});
#endif
        xcd_barrier(xbar);
#ifndef NO_G4
        gemm_call<pg8::EpiRes>(ldsl, HID, (const bf16_t*)(ws + WS_W2) + (size_t)l * D * FF, D, FF, pg8::EpiRes{p.x, p.out, XB, SSQ, 0});
#endif
        xcd_barrier(xbar);
    }
    { const int tid = threadIdx.x;
      for (size_t i = ((size_t)bx * 512 + tid) * 8; i < (size_t)T * D; i += (size_t)G * 512 * 8) {
          const int r = (int)(i >> 10), c = (int)(i & 1023);
          const float* sp = SSQ + (size_t)r * 16; float s = 0.f;
#pragma unroll
          for (int j = 0; j < 4; ++j) { const f32x4 q = *(const f32x4*)(sp + 4 * j); s += (q[0] + q[1]) + (q[2] + q[3]); }
          const float rs = rsqrtf(s * (1.0f / 1024.0f) + EPS);
          const u32x4 w = *(const u32x4*)(XB + i); const f32x4 g0 = *(const f32x4*)(p.final_norm_g + c), g1 = *(const f32x4*)(p.final_norm_g + c + 4);
          *(f32x4*)(p.out + i) = (f32x4){bflo(w.x), bfhi(w.x), bflo(w.y), bfhi(w.y)} * rs * g0;
          *(f32x4*)(p.out + i + 4) = (f32x4){bflo(w.z), bfhi(w.z), bflo(w.w), bfhi(w.w)} * rs * g1; } }
}

extern "C" void kernel_launch(void* const* d_in, const int* in_sizes, int n_in, void* d_out, int out_size, void* d_ws, size_t ws_size, hipStream_t stream) {
    static int grid = 0;
    if (grid == 0) {
        if (n_in != 16 || out_size != T * D || ws_size < WS_END) { fprintf(stderr, "kernel_launch: unexpected shapes: n_in %d out %d ws %zu (need %zu)\n", n_in, out_size, ws_size, (size_t)WS_END); grid = -1; return; }
        int dev = 0, cus = 0, per_cu = 0;
        (void)hipGetDevice(&dev); (void)hipDeviceGetAttribute(&cus, hipDeviceAttributeMultiprocessorCount, dev);
        if (hipFuncSetAttribute((const void*)fwd_megakernel, hipFuncAttributeMaxDynamicSharedMemorySize, LDS_BYTES) != hipSuccess) { fprintf(stderr, "kernel_launch: hipFuncSetAttribute failed\n"); grid = -1; return; }
        (void)hipOccupancyMaxActiveBlocksPerMultiprocessor(&per_cu, (const void*)fwd_megakernel, 512, LDS_BYTES);
        (void)hipGetLastError();
        if (per_cu < 1) { fprintf(stderr, "kernel_launch: occupancy query says %d blocks per CU\n", per_cu); per_cu = 1; }
        grid = cus;
        if (grid < 256) { fprintf(stderr, "kernel_launch: %d CUs; this kernel's mixer phase needs a grid of at least 256\n", grid); }
    }
    if (grid < 0) return;
    (void)hipMemsetAsync((char*)d_ws + WS_CTL, 0, CTL_BYTES, stream);
    Params p{};
    p.x = (const float*)d_in[0]; p.norm_mix_g = (const float*)d_in[1]; p.w_in = (const float*)d_in[2]; p.w_a2_fwd = (const float*)d_in[3]; p.b_a_fwd = (const float*)d_in[4];
    p.w_a2_bwd = (const float*)d_in[5]; p.b_a_bwd = (const float*)d_in[6]; p.gla_norm_g = (const float*)d_in[7]; p.sgu_norm_g = (const float*)d_in[8]; p.w_s = (const float*)d_in[9];
    p.b_s = (const float*)d_in[10]; p.w_out = (const float*)d_in[11]; p.norm_mlp_g = (const float*)d_in[12]; p.w_mlp1 = (const float*)d_in[13]; p.w_mlp2 = (const float*)d_in[14];
    p.final_norm_g = (const float*)d_in[15]; p.out = (float*)d_out; p.ws = (unsigned char*)d_ws;
    void* args[] = {&p};
    hipError_t e = hipLaunchCooperativeKernel((const void*)fwd_megakernel, dim3(grid), dim3(512), args, LDS_BYTES, stream);
    if (e != hipSuccess) fprintf(stderr, "cooperative launch failed: %s (grid %d)\n", hipGetErrorString(e), grid);
}
```

```cpp
#include <hip/hip_runtime.h>
#include <hip/hip_cooperative_groups.h>
#include <cstdio>
namespace cg = cooperative_groups;

#define LAS __attribute__((address_space(3)))
#ifndef PHASE_FN
#define PHASE_FN __device__ __forceinline__
#endif
typedef unsigned short bf16_t;
typedef short bf16x8 __attribute__((ext_vector_type(8)));
typedef short bf16x4 __attribute__((ext_vector_type(4)));
typedef float f32x4 __attribute__((ext_vector_type(4)));
typedef float f32x2 __attribute__((ext_vector_type(2)));
typedef unsigned u32x4 __attribute__((ext_vector_type(4)));
typedef unsigned u32x2 __attribute__((ext_vector_type(2)));

constexpr int T = 65536, D = 1024, FF = 4096, SEQ = 4096, DEPTH = 4;
constexpr int ZW = 2816;
constexpr int D_IN = 2592;
constexpr float EPS = 1e-6f;
constexpr int ZQ = 0, ZK = 256, ZV = 512, ZG = 1024, ZSU = 1536, ZSV = 2304;
constexpr int ZN_A = 2304;

constexpr size_t MiB = 1u << 20;
constexpr size_t WS_CTL = 0, CTL_BYTES = 1 * MiB;
constexpr size_t WS_WIN = 1 * MiB;
constexpr size_t WS_WOUT = 23 * MiB;
constexpr size_t WS_W1 = 31 * MiB;
constexpr size_t WS_W2 = 63 * MiB;
constexpr size_t WS_WSB = 95 * MiB;
constexpr size_t WS_SSQ = 96 * MiB;
constexpr size_t WS_DEC = 100 * MiB;
constexpr size_t WS_XB = 108 * MiB;
constexpr size_t WS_Z = 236 * MiB;
constexpr size_t WS_MIX = 588 * MiB;
constexpr size_t WS_OX = 716 * MiB;
constexpr size_t WS_HID = 236 * MiB;
constexpr size_t WS_END = 844 * MiB;
constexpr int LDS_BYTES = 147456;

struct Params {
    const float* x; const float* norm_mix_g; const float* w_in; const float* w_a2_fwd; const float* b_a_fwd; const float* w_a2_bwd; const float* b_a_bwd;
    const float* gla_norm_g; const float* sgu_norm_g; const float* w_s; const float* b_s; const float* w_out; const float* norm_mlp_g; const float* w_mlp1;
    const float* w_mlp2; const float* final_norm_g; float* out; unsigned char* ws;
};

__device__ __forceinline__ unsigned cvt_pk_bf16(float lo, float hi) { unsigned r; asm volatile("v_cvt_pk_bf16_f32 %0, %1, %2" : "=v"(r) : "v"(lo), "v"(hi)); return r; }
__device__ __forceinline__ float bf2f(unsigned short b) { return __uint_as_float(((unsigned)b) << 16); }
__device__ __forceinline__ float bflo(unsigned w) { return __uint_as_float(w << 16); }
__device__ __forceinline__ float bfhi(unsigned w) { return __uint_as_float(w & 0xffff0000u); }

__device__ __forceinline__ f32x2 gelu_pk(f32x2 v) {
    const f32x2 av = __builtin_elementwise_abs(v), d = av * 0.2316418882f + 1.0f;
    f32x2 t; t.x = __builtin_amdgcn_rcpf(d.x); t.y = __builtin_amdgcn_rcpf(d.y);
    f32x2 q = t * 0.5307027145f + (-0.7265760135f); q = q * t + 0.7107068705f; q = q * t + (-0.142248368f); q = q * t + 0.127414796f; q = q * t;
    const f32x2 s = (v * v) * (-0.72134752044f);
    f32x2 e; e.x = __builtin_amdgcn_exp2f(s.x); e.y = __builtin_amdgcn_exp2f(s.y);
    const f32x2 m = v * (q * e), r = v - m;
    f32x2 o; o.x = v.x < 0.f ? m.x : r.x; o.y = v.y < 0.f ? m.y : r.y; return o;
}
__device__ __forceinline__ float silu_f(float v) { return v * __builtin_amdgcn_rcpf(1.0f + __expf(-v)); }

namespace pg8 {
constexpr int BM = 256, BK = 64, HALF = 128, HTB = HALF * BK * 2, STAGE_BYTES = 8 * HTB, NXCD = 8, WGM = 8;
__host__ __device__ __forceinline__ int lds_byte(int r, int c) { const int st = (r >> 4) * 2 + (c >> 5), rr = r & 15, cc = c & 31, ob = rr * 64 + cc * 2; return st * 1024 + (ob ^ (((ob >> 9) & 1) << 5)); }
__host__ __device__ __forceinline__ void stage_rc(int b, int& R, int& C) { const int st = b / 1024, sb = b % 1024, swz = sb ^ (((sb >> 9) & 1) << 5); R = (st >> 1) * 16 + swz / 64; C = (st & 1) * 32 + (swz % 64) / 2; }
__host__ __device__ __forceinline__ int perm32(int rho) { const int n = rho >> 4, i = rho & 15; return 8 * (i >> 2) + 4 * n + (i & 3); }
struct Unit { int pm, pn; };
struct Gemm { const bf16_t* A; const bf16_t* Bt; int M, N, K; };
struct StaticOrder {
    int nM, nN, nwg, G, c, mode, base;
    __device__ void init(int M, int N, int G_, int c_) { nM = M / BM; nN = N / BM; nwg = nM * nN; G = G_; c = c_; mode = 0; base = 0; }
    __device__ bool next(int i, Unit& u) const {
        if (mode == 1) { if (i >= 4) return false; u.pm = base + (i >> 1); u.pn = 9 + (i & 1); return true; }
        const long L = (long)i * G + c; if (L >= nwg) return false;
        int wgid = (int)L; { const int q = nwg / NXCD, r = nwg % NXCD, xcd = wgid % NXCD, off = wgid / NXCD; wgid = (xcd < r ? xcd * (q + 1) : r * (q + 1) + (xcd - r) * q) + off; }
        const int nig = WGM * nN, gid = wgid / nig, fm = gid * WGM, gsz = (nM - fm) < WGM ? (nM - fm) : WGM;
        u.pm = fm + ((wgid % nig) % gsz); u.pn = (wgid % nig) / gsz; return true;
    }
    __device__ __forceinline__ void a_ready(const Unit&) const {}
    __device__ __forceinline__ void done(const Unit&) const {}
};

template <class Epi, class Sched, bool ALIGN_EPI = false, bool SP2 = false>
__device__ __forceinline__ void gemm_phase(LAS unsigned char* lds, const Gemm g, const Sched& S, const Epi& E) {
    int tid = threadIdx.x; asm volatile("" : "+v"(tid));
    const int wid = __builtin_amdgcn_readfirstlane(tid >> 6), lane = tid & 63, wr = wid >> 2, wc = wid & 3, fr = lane & 15, fq = lane >> 4;
    const int K = g.K, nt = K / BK;
    unsigned voffA[2], voffB[2];
#pragma unroll
    for (int i = 0; i < 2; ++i) { int R, C; stage_rc(tid * 16 + i * 8192, R, C); const int Rb = Epi::PERM ? ((R & ~31) + perm32(R & 31)) : R;
        voffA[i] = (unsigned)(R * K + C) * 2u; voffB[i] = (unsigned)(Rb * K + C) * 2u; }
    const size_t kstep = (size_t)(BK * 2);
    const size_t hstep = (size_t)HALF * K * 2;
    const size_t tstep = 2 * hstep;
    const unsigned ldsw = (unsigned)wid * 1024u;
    const int aoff = lds_byte(wr * 64 + fr, fq * 8), boff = lds_byte(wc * 32 + fr, fq * 8);
#define PG8_SA(b, h) (((b) * 2 + (h)) * HTB)
#define PG8_SB(b, h) ((4 + (b) * 2 + (h)) * HTB)
#define PG8_STAGE(bufoff, gbase, voff) do { _Pragma("unroll") for (int _i = 0; _i < 2; ++_i) \
        __builtin_amdgcn_global_load_lds((const unsigned*)((const char*)(gbase) + (voff)[_i]), (LAS unsigned*)(lds + (bufoff) + ldsw + _i * 8192), 16, 0, 0); } while (0)
#define PG8_LDA(dst, b, h) do { _Pragma("unroll") for (int m = 0; m < 4; ++m) _Pragma("unroll") for (int k = 0; k < 2; ++k) dst[m][k] = *(const LAS bf16x8*)(lds + PG8_SA(b, h) + aoff + m * 2048 + k * 1024); } while (0)
#define PG8_LDB(dst, b, h) do { _Pragma("unroll") for (int n = 0; n < 2; ++n) _Pragma("unroll") for (int k = 0; k < 2; ++k) dst[n][k] = *(const LAS bf16x8*)(lds + PG8_SB(b, h) + boff + n * 2048 + k * 1024); } while (0)
#define PG8_MMA(ai, bj, At, Bt) do { __builtin_amdgcn_s_setprio(1); _Pragma("unroll") for (int m = 0; m < 4; ++m) _Pragma("unroll") for (int n = 0; n < 2; ++n) _Pragma("unroll") for (int k = 0; k < 2; ++k) \
        acc[ai][bj][m][n] = __builtin_amdgcn_mfma_f32_16x16x32_bf16(Bt[n][k], At[m][k], acc[ai][bj][m][n], 0, 0, 0); __builtin_amdgcn_s_setprio(0); } while (0)
#define PG8_WAIT_V(n) asm volatile("s_waitcnt vmcnt(" #n ")" ::: "memory")
#define PG8_WAIT_L(n) asm volatile("s_waitcnt lgkmcnt(" #n ")" ::: "memory")
#define PG8_BAR __builtin_amdgcn_s_barrier()
#define PG8_SCHED __builtin_amdgcn_sched_barrier(0)
    Unit cur, nxt; int ui = 0;
    if (!S.next(0, cur)) return;
    f32x4 acc[2][2][4][2];
#pragma unroll
    for (int a = 0; a < 2; ++a)
#pragma unroll
        for (int b = 0; b < 2; ++b)
#pragma unroll
            for (int m = 0; m < 4; ++m)
#pragma unroll
                for (int n = 0; n < 2; ++n) acc[a][b][m][n] = (f32x4){0.f, 0.f, 0.f, 0.f};
    bf16x8 At[4][2], B0[2][2], B1[2][2];
    const char* cA = (const char*)g.A + (size_t)cur.pm * tstep; const char* cB = (const char*)g.Bt + (size_t)cur.pn * tstep;
    S.a_ready(cur);
    if constexpr (SP2) {
        PG8_STAGE(PG8_SB(0, 0), cB, voffB); PG8_STAGE(PG8_SB(0, 1), cB + hstep, voffB); PG8_STAGE(PG8_SA(0, 0), cA, voffA); PG8_STAGE(PG8_SA(0, 1), cA + hstep, voffA);
        if (wr == 1) PG8_BAR;
        PG8_WAIT_V(2); PG8_BAR;
        PG8_STAGE(PG8_SB(1, 0), cB + kstep, voffB); PG8_STAGE(PG8_SA(1, 0), cA + kstep, voffA); PG8_STAGE(PG8_SB(1, 1), cB + hstep + kstep, voffB);
        PG8_WAIT_V(6); PG8_BAR;
    } else {
        PG8_STAGE(PG8_SB(0, 0), cB, voffB); PG8_STAGE(PG8_SA(0, 0), cA, voffA); PG8_STAGE(PG8_SB(0, 1), cB + hstep, voffB); PG8_STAGE(PG8_SA(0, 1), cA + hstep, voffA);
        if (wr == 1) PG8_BAR;
        PG8_WAIT_V(4); PG8_BAR;
        PG8_STAGE(PG8_SB(1, 0), cB + kstep, voffB); PG8_STAGE(PG8_SA(1, 0), cA + kstep, voffA); PG8_STAGE(PG8_SB(1, 1), cB + hstep + kstep, voffB);
        PG8_WAIT_V(6); PG8_BAR;
    }
    for (;;) {
        const bool has_next = S.next(ui + 1, nxt);
        const char* nA = has_next ? (const char*)g.A + (size_t)nxt.pm * tstep : cA; const char* nB = has_next ? (const char*)g.Bt + (size_t)nxt.pn * tstep : cB;
        for (int t = 0; t < nt; t += 2) {
            const bool last = (t == nt - 2);
            const char* a1 = cA + (size_t)(t + 1) * kstep;
            const char* a2 = last ? nA : cA + (size_t)(t + 2) * kstep; const char* b2 = last ? nB : cB + (size_t)(t + 2) * kstep;
            const char* a3 = a2 + kstep; const char* b3 = b2 + kstep;
            if (last && has_next) S.a_ready(nxt);
            if constexpr (SP2) {
            PG8_LDB(B0, 0, 0); PG8_LDB(B1, 0, 1); PG8_SCHED; PG8_LDA(At, 0, 0); PG8_STAGE(PG8_SA(1, 1), a1 + hstep, voffA);
            PG8_WAIT_V(8); PG8_WAIT_L(0); PG8_BAR; PG8_MMA(0, 0, At, B0); PG8_MMA(0, 1, At, B1); PG8_BAR; PG8_SCHED;
            PG8_LDA(At, 0, 1); PG8_STAGE(PG8_SB(0, 0), b2, voffB); PG8_STAGE(PG8_SB(0, 1), b2 + hstep, voffB); PG8_STAGE(PG8_SA(0, 0), a2, voffA);
            PG8_WAIT_V(8); PG8_WAIT_L(0); PG8_BAR; PG8_MMA(1, 0, At, B0); PG8_MMA(1, 1, At, B1); PG8_BAR; PG8_SCHED;
            PG8_LDB(B0, 1, 0); PG8_LDB(B1, 1, 1); PG8_SCHED; PG8_LDA(At, 1, 0); PG8_STAGE(PG8_SA(0, 1), a2 + hstep, voffA);
            PG8_WAIT_V(8); PG8_WAIT_L(0); PG8_BAR; PG8_MMA(0, 0, At, B0); PG8_MMA(0, 1, At, B1); PG8_BAR; PG8_SCHED;
            PG8_LDA(At, 1, 1); PG8_STAGE(PG8_SB(1, 0), b3, voffB); PG8_STAGE(PG8_SB(1, 1), b3 + hstep, voffB); PG8_STAGE(PG8_SA(1, 0), a3, voffA);
            PG8_WAIT_V(8); PG8_WAIT_L(0); PG8_BAR; PG8_MMA(1, 0, At, B0); PG8_MMA(1, 1, At, B1); PG8_BAR; PG8_SCHED;
            } else {
            PG8_LDB(B0, 0, 0); PG8_SCHED; PG8_LDA(At, 0, 0); PG8_STAGE(PG8_SA(1, 1), a1 + hstep, voffA);
            PG8_WAIT_L(8); PG8_BAR; PG8_WAIT_L(0); PG8_MMA(0, 0, At, B0); PG8_BAR; PG8_SCHED;
            PG8_LDB(B1, 0, 1); PG8_STAGE(PG8_SB(0, 0), b2, voffB);
            PG8_BAR; PG8_WAIT_L(0); PG8_MMA(0, 1, At, B1); PG8_BAR;
            PG8_LDA(At, 0, 1); PG8_STAGE(PG8_SA(0, 0), a2, voffA);
            PG8_BAR; PG8_WAIT_L(0); PG8_MMA(1, 0, At, B0); PG8_BAR; PG8_SCHED;
            PG8_STAGE(PG8_SB(0, 1), b2 + hstep, voffB);
            PG8_WAIT_V(6); PG8_BAR; PG8_MMA(1, 1, At, B1); PG8_BAR;
            PG8_LDB(B0, 1, 0); PG8_SCHED; PG8_LDA(At, 1, 0); PG8_STAGE(PG8_SA(0, 1), a2 + hstep, voffA);
            PG8_WAIT_L(8); PG8_BAR; PG8_WAIT_L(0); PG8_MMA(0, 0, At, B0); PG8_BAR; PG8_SCHED;
            PG8_LDB(B1, 1, 1); PG8_STAGE(PG8_SB(1, 0), b3, voffB);
            PG8_BAR; PG8_WAIT_L(0); PG8_MMA(0, 1, At, B1); PG8_BAR;
            PG8_LDA(At, 1, 1); PG8_STAGE(PG8_SA(1, 0), a3, voffA);
            PG8_BAR; PG8_WAIT_L(0); PG8_MMA(1, 0, At, B0); PG8_BAR; PG8_SCHED;
            PG8_STAGE(PG8_SB(1, 1), b3 + hstep, voffB);
            PG8_WAIT_V(6); PG8_BAR; PG8_MMA(1, 1, At, B1); PG8_BAR;
            }
        }
        if constexpr (ALIGN_EPI) { if (wr == 0) PG8_BAR; }
        E(acc, cur, wr, wc, fr, fq); S.done(cur);
        if (!has_next) break;
#pragma unroll
        for (int a = 0; a < 2; ++a)
#pragma unroll
            for (int b = 0; b < 2; ++b)
#pragma unroll
                for (int m = 0; m < 4; ++m)
#pragma unroll
                    for (int n = 0; n < 2; ++n) acc[a][b][m][n] = (f32x4){0.f, 0.f, 0.f, 0.f};
        cur = nxt; cA = nA; cB = nB; ++ui;
        if constexpr (ALIGN_EPI) { if (wr == 1) PG8_BAR; }
    }
    PG8_WAIT_V(0);
    if constexpr (!ALIGN_EPI) { if (wr == 0) PG8_BAR; }
    PG8_BAR;
#undef PG8_SA
#undef PG8_SB
#undef PG8_STAGE
#undef PG8_LDA
#undef PG8_LDB
#undef PG8_MMA
#undef PG8_WAIT_V
#undef PG8_WAIT_L
#undef PG8_BAR
#undef PG8_SCHED
}

__device__ __forceinline__ void rows_rstd(const float* __restrict__ ssq, int row0, int fq, float (&rs)[2][4]) {
    f32x4 pp[2][4];
#pragma unroll
    for (int ai = 0; ai < 2; ++ai)
#pragma unroll
        for (int m = 0; m < 4; ++m) pp[ai][m] = *(const f32x4*)(ssq + (size_t)(row0 + ai * HALF + m * 16) * 16 + 4 * fq);
#pragma unroll
    for (int ai = 0; ai < 2; ++ai)
#pragma unroll
        for (int m = 0; m < 4; ++m) { float s = (pp[ai][m][0] + pp[ai][m][1]) + (pp[ai][m][2] + pp[ai][m][3]); s += __shfl_xor(s, 16); s += __shfl_xor(s, 32); rs[ai][m] = rsqrtf(s * (1.0f / 1024.0f) + EPS); }
}
__device__ __forceinline__ void rows_rstd_cached(const float* __restrict__ ssq, int row0, int fq, float (&rs)[2][4], bool hit, LAS float* cache, int lrow0, bool writer) {
    if (hit) {
#pragma unroll
        for (int ai = 0; ai < 2; ++ai)
#pragma unroll
            for (int m = 0; m < 4; ++m) rs[ai][m] = cache[lrow0 + ai * HALF + m * 16];
    } else {
        rows_rstd(ssq, row0, fq, rs);
        if (writer) {
#pragma unroll
            for (int ai = 0; ai < 2; ++ai)
#pragma unroll
                for (int m = 0; m < 4; ++m) cache[lrow0 + ai * HALF + m * 16] = rs[ai][m];
        }
    }
}
struct EpiZ {
    static constexpr bool PERM = true;
    bf16_t* Z; bf16_t* DEC; const float* ssq; LAS float* rsc; mutable int cached_pm;
    __device__ __forceinline__ void operator()(const f32x4 (&acc)[2][2][4][2], const Unit& u, int wr, int wc, int fr, int fq) const {
        const int row0 = u.pm * BM + wr * 64 + fr; const int pn = u.pn;
        float rsv[2][4]; rows_rstd_cached(ssq, row0, fq, rsv, u.pm == cached_pm, rsc, wr * 64 + fr, wc == 0 && fq == 0); cached_pm = u.pm;
#pragma unroll
        for (int ai = 0; ai < 2; ++ai)
#pragma unroll
            for (int m = 0; m < 4; ++m) {
                const int r = row0 + ai * HALF + m * 16; const float rs = rsv[ai][m];
                if (pn == 8) {
                    if (wc == 0) { const f32x4 v0 = acc[ai][0][m][0] * rs, v1 = acc[ai][0][m][1] * rs; u32x4 w; w.x = cvt_pk_bf16(v0[0], v0[1]); w.y = cvt_pk_bf16(v0[2], v0[3]); w.z = cvt_pk_bf16(v1[0], v1[1]); w.w = cvt_pk_bf16(v1[2], v1[3]); *(u32x4*)(DEC + (size_t)r * 32 + 8 * fq) = w; }
                } else {
                    bf16_t* rowp = Z + (size_t)r * ZW + pn * BM + wc * 32 + 8 * fq;
#pragma unroll
                    for (int bj = 0; bj < 2; ++bj) { f32x4 v0 = acc[ai][bj][m][0] * rs, v1 = acc[ai][bj][m][1] * rs;
                        if (pn >= 4 && pn < 6) {
#pragma unroll
                            for (int j = 0; j < 4; ++j) { v0[j] = silu_f(v0[j]); v1[j] = silu_f(v1[j]); } }
                        u32x4 w; w.x = cvt_pk_bf16(v0[0], v0[1]); w.y = cvt_pk_bf16(v0[2], v0[3]); w.z = cvt_pk_bf16(v1[0], v1[1]); w.w = cvt_pk_bf16(v1[2], v1[3]);
                        *(u32x4*)(rowp + bj * HALF) = w; }
                }
            }
    }
};
struct EpiH {
    static constexpr bool PERM = true;
    bf16_t* H; const float* ssq; LAS float* rsc; mutable int cached_pm;
    __device__ __forceinline__ void operator()(const f32x4 (&acc)[2][2][4][2], const Unit& u, int wr, int wc, int fr, int fq) const {
        const int row0 = u.pm * BM + wr * 64 + fr;
        float rsv[2][4]; rows_rstd_cached(ssq, row0, fq, rsv, u.pm == cached_pm, rsc, wr * 64 + fr, wc == 0 && fq == 0); cached_pm = u.pm;
#pragma unroll
        for (int ai = 0; ai < 2; ++ai)
#pragma unroll
            for (int m = 0; m < 4; ++m) {
                const int r = row0 + ai * HALF + m * 16; const float rs = rsv[ai][m];
                bf16_t* rowp = H + (size_t)r * FF + u.pn * BM + wc * 32 + 8 * fq;
#pragma unroll
                for (int bj = 0; bj < 2; ++bj) { f32x4 v0 = acc[ai][bj][m][0] * rs, v1 = acc[ai][bj][m][1] * rs;
#pragma unroll
                    for (int j = 0; j < 4; ++j) { const float a = fmaxf(v0[j], 0.f), b = fmaxf(v1[j], 0.f); v0[j] = a * a; v1[j] = b * b; }
                    u32x4 w; w.x = cvt_pk_bf16(v0[0], v0[1]); w.y = cvt_pk_bf16(v0[2], v0[3]); w.z = cvt_pk_bf16(v1[0], v1[1]); w.w = cvt_pk_bf16(v1[2], v1[3]);
                    *(u32x4*)(rowp + bj * HALF) = w; }
            }
    }
};
template <bool RD32>
__device__ __forceinline__ void res_rows(const float* __restrict__ xold32, const bf16_t* __restrict__ xoldb, bf16_t* __restrict__ xb, float* __restrict__ ssq, const f32x4 (&acc)[2][2][4][2], int row0, int col0, int slot) {
    f32x4 xo[2][2][2];
    float ssv[8];
    auto ld = [&](size_t o, f32x4& a, f32x4& b) { if (RD32) { a = *(const f32x4*)(xold32 + o); b = *(const f32x4*)(xold32 + o + 4); }
        else { const u32x4 w = *(const u32x4*)(xoldb + o); a = (f32x4){bflo(w.x), bfhi(w.x), bflo(w.y), bfhi(w.y)}; b = (f32x4){bflo(w.z), bfhi(w.z), bflo(w.w), bfhi(w.w)}; } };
#pragma unroll
    for (int bj = 0; bj < 2; ++bj) ld((size_t)row0 * D + col0 + bj * HALF, xo[0][bj][0], xo[0][bj][1]);
#pragma unroll
    for (int idx = 0; idx < 8; ++idx) {
        const int ai = idx >> 2, m = idx & 3; const int r = row0 + ai * HALF + m * 16; const size_t off = (size_t)r * D + col0;
        if (idx < 7) { const int ai2 = (idx + 1) >> 2, m2 = (idx + 1) & 3; const size_t off2 = (size_t)(row0 + ai2 * HALF + m2 * 16) * D + col0;
#pragma unroll
            for (int bj = 0; bj < 2; ++bj) ld(off2 + bj * HALF, xo[(idx + 1) & 1][bj][0], xo[(idx + 1) & 1][bj][1]); }
        float ss = 0.f;
#pragma unroll
        for (int bj = 0; bj < 2; ++bj) { const f32x4 x0 = xo[idx & 1][bj][0] + acc[ai][bj][m][0], x1 = xo[idx & 1][bj][1] + acc[ai][bj][m][1];
            u32x4 w; w.x = cvt_pk_bf16(x0[0], x0[1]); w.y = cvt_pk_bf16(x0[2], x0[3]); w.z = cvt_pk_bf16(x1[0], x1[1]); w.w = cvt_pk_bf16(x1[2], x1[3]);
            *(u32x4*)(xb + off + bj * HALF) = w;
            ss += ((x0[0] * x0[0] + x0[1] * x0[1]) + (x0[2] * x0[2] + x0[3] * x0[3])) + ((x1[0] * x1[0] + x1[1] * x1[1]) + (x1[2] * x1[2] + x1[3] * x1[3])); }
        ss += __shfl_xor(ss, 16); ss += __shfl_xor(ss, 32);
        ssv[idx] = ss;
    }
    const int fq = slot >> 6;
#pragma unroll
    for (int j = 0; j < 2; ++j) { const float v = fq == 0 ? ssv[j] : fq == 1 ? ssv[2 + j] : fq == 2 ? ssv[4 + j] : ssv[6 + j]; const int idx = 2 * fq + j;
        ssq[(size_t)(row0 + (idx >> 2) * HALF + (idx & 3) * 16) * 16 + (slot & 15)] = v; }
}
struct EpiRes {
    static constexpr bool PERM = true;
    const float* xold32; float* xout; bf16_t* xb; float* ssq; int mode;
    __device__ __forceinline__ void operator()(const f32x4 (&acc)[2][2][4][2], const Unit& u, int wr, int wc, int fr, int fq) const {
        const int row0 = u.pm * BM + wr * 64 + fr, col0 = u.pn * BM + wc * 32 + 8 * fq, slot = (u.pn * 4 + wc) | (fq << 6);
        if (mode == 0) res_rows<false>(xold32, xb, xb, ssq, acc, row0, col0, slot);
        else res_rows<true>(xold32, xb, xb, ssq, acc, row0, col0, slot);
    }
};
}

struct WTile { const float* src; bf16_t* dst; const float* g; int ldsrc, K, n0, k0, mode; };
__device__ __forceinline__ WTile wtile_desc(const Params& p, int it) {
    unsigned char* ws = p.ws; WTile t; const int l = it / 3008; int r = it % 3008;
    if (r < 704) { t.src = p.w_in + (size_t)l * D * D_IN; t.ldsrc = D_IN; t.dst = (bf16_t*)(ws + WS_WIN) + (size_t)l * ZW * D; t.K = D; t.n0 = (r / 16) * 64; t.k0 = (r % 16) * 64; t.g = p.norm_mix_g + l * D; t.mode = 0; }
    else if (r < 960) { r -= 704; t.src = p.w_out + (size_t)l * D * D; t.ldsrc = D; t.dst = (bf16_t*)(ws + WS_WOUT) + (size_t)l * D * D; t.K = D; t.n0 = (r / 16) * 64; t.k0 = (r % 16) * 64; t.g = nullptr; t.mode = 1; }
    else if (r < 1984) { r -= 960; t.src = p.w_mlp1 + (size_t)l * D * FF; t.ldsrc = FF; t.dst = (bf16_t*)(ws + WS_W1) + (size_t)l * FF * D; t.K = D; t.n0 = (r / 16) * 64; t.k0 = (r % 16) * 64; t.g = p.norm_mlp_g + l * D; t.mode = 1; }
    else { r -= 1984; t.src = p.w_mlp2 + (size_t)l * FF * D; t.ldsrc = D; t.dst = (bf16_t*)(ws + WS_W2) + (size_t)l * D * FF; t.K = FF; t.n0 = (r / 64) * 64; t.k0 = (r % 64) * 64; t.g = nullptr; t.mode = 1; }
    return t;
}
__device__ __forceinline__ void wtile_load(const WTile& w, int t, f32x4& a, f32x4& b, float& rsc) {
    const int kk = t >> 3, ns = (t & 7) * 8; const int nd = w.n0 + ns; int nsrc = nd; bool valid = true; float cs = 1.0f;
    if (w.mode == 0) { if (nd < 1536) nsrc = nd; else if (nd < 2048) nsrc = nd + 32; else if (nd < 2080) nsrc = nd - 512; else if (nd < 2304) valid = false; else nsrc = nd - 224; if (nd < 256) cs = 0.125f; }
    a = (f32x4){0.f, 0.f, 0.f, 0.f}; b = a;
    if (valid) { const float* sp = w.src + (size_t)(w.k0 + kk) * w.ldsrc + nsrc; a = *(const f32x4*)sp; b = *(const f32x4*)(sp + 4); }
    rsc = (w.g ? w.g[w.k0 + kk] : 1.0f) * cs;
}

PHASE_FN void phase_prep(const Params& p, float* ldsf) {
    unsigned char* ws = p.ws;
    const int G = gridDim.x, bx = blockIdx.x; int tid = threadIdx.x; asm volatile("" : "+v"(tid));
    { const int NT = DEPTH * 3008; int it = bx, buf = 0; f32x4 a, b; float rsc;
      WTile cur = wtile_desc(p, it < NT ? it : 0);
      if (it < NT) wtile_load(cur, tid, a, b, rsc);
      for (; it < NT; it += G, buf ^= 1) {
          float* tile = ldsf + buf * (64 * 65);
          { const int kk = tid >> 3, ns = (tid & 7) * 8; float* tp = tile + kk * 65 + ns;
#pragma unroll
            for (int j = 0; j < 4; ++j) { tp[j] = a[j] * rsc; tp[4 + j] = b[j] * rsc; } }
          const WTile w = cur;
          if (it + G < NT) { cur = wtile_desc(p, it + G); wtile_load(cur, tid, a, b, rsc); }
          asm volatile("s_waitcnt lgkmcnt(0)" ::: "memory"); __builtin_amdgcn_s_barrier(); asm volatile("" ::: "memory");
          { const int nn = tid >> 3, ks = (tid & 7) * 8; float v[8];
#pragma unroll
            for (int i = 0; i < 8; ++i) v[i] = tile[(ks + i) * 65 + nn];
            u32x4 o; o.x = cvt_pk_bf16(v[0], v[1]); o.y = cvt_pk_bf16(v[2], v[3]); o.z = cvt_pk_bf16(v[4], v[5]); o.w = cvt_pk_bf16(v[6], v[7]);
            *(u32x4*)(w.dst + (size_t)(w.n0 + nn) * w.K + w.k0 + ks) = o; }
      }
      __syncthreads(); }
    { bf16_t* wsb = (bf16_t*)(ws + WS_WSB);
      for (int i = (bx * 512 + tid) * 4; i < DEPTH * 4 * 128 * 128; i += G * 512 * 4) { const f32x4 v = *(const f32x4*)(p.w_s + i); u32x2 w; w.x = cvt_pk_bf16(v[0], v[1]); w.y = cvt_pk_bf16(v[2], v[3]); *(u32x2*)(wsb + i) = w; } }
    { bf16_t* xb = (bf16_t*)(ws + WS_XB); float* ssq = (float*)(ws + WS_SSQ); const int wid = tid >> 6, lane = tid & 63;
      for (int r = bx * 8 + wid; r < T; r += G * 8) { const float* xr = p.x + (size_t)r * D; float ss = 0.f;
#pragma unroll
          for (int i = 0; i < 4; ++i) { const int c = i * 256 + lane * 4; const f32x4 v = *(const f32x4*)(xr + c); ss += (v[0] * v[0] + v[1] * v[1]) + (v[2] * v[2] + v[3] * v[3]);
              u32x2 w; w.x = cvt_pk_bf16(v[0], v[1]); w.y = cvt_pk_bf16(v[2], v[3]); *(u32x2*)(xb + (size_t)r * D + c) = w; }
#pragma unroll
          for (int o = 32; o >= 1; o >>= 1) ss += __shfl_xor(ss, o);
          if (lane < 16) ssq[(size_t)r * 16 + lane] = lane == 0 ? ss : 0.f; } }
}

constexpr int GP = 72;
constexpr int VP = 132;
#define ROT(row, col) (((col) + 16 * ((row) >> 4)) & 63)
constexpr int L_QIN = 0, L_KIN = 9216, L_QOUT = 18432, L_KOUTT = 27648;
constexpr int L_DEC = 36864;
constexpr int L_RED = L_DEC + 256;
constexpr int L_QRAW = L_RED + 1024;
constexpr int L_KRAW = L_QRAW + 8192;
constexpr int L_ARAW = L_KRAW + 8192;
constexpr int L_VRAW = L_ARAW + 2048;
static_assert(L_VRAW + 64 * VP * 2 <= 131072, "GLA LDS map");

__device__ __forceinline__ float logsig2(float d) {
    const float t = fabsf(d) * 1.44269504089f; const float e = __builtin_amdgcn_exp2f(-t); const float lg = __builtin_amdgcn_logf(1.0f + e);
    return (fminf(d, 0.f) * 1.44269504089f - lg) * 0.0625f;
}
#define GLA_BAR() do { asm volatile("s_waitcnt lgkmcnt(0)" ::: "memory"); __builtin_amdgcn_s_barrier(); asm volatile("" ::: "memory"); } while (0)
#define CHUNK(si) (dir ? 63 - (si) : (si))
#define POS(r) (dir ? 63 - (r) : (r))

struct GlaRegs { u32x4 q0, q1, k0, k1, a, v0, v1, v2, v3; };
struct GlaPrepCtx {
    const bf16_t* Z; const bf16_t* DEC; unsigned* myflag; unsigned* paflag;
    bf16_t* qin; bf16_t* kin; bf16_t* qout; bf16_t* koutT; float* decs; bf16_t* qraw; bf16_t* kraw; bf16_t* araw; bf16_t* vraw;
    int tid, wid, lr, q4, b, h, dir, lrow, lcs, vrow, vcs, arow, acs, ch; bf16x8 w2f; float bias;
};
#define ST8_(pp, v) do { *(u32x2*)(pp) = (u32x2){(v).x, (v).y}; *(u32x2*)((pp) + 4) = (u32x2){(v).z, (v).w}; } while (0)
__device__ __forceinline__ void gla_load_qka(const GlaPrepCtx& c, int si, GlaRegs& R) {
    const int dir = c.dir; const size_t t0 = (size_t)(c.b * SEQ + CHUNK(si) * 64); const bf16_t* zr = c.Z + (t0 + c.lrow) * ZW + c.h * 64 + c.lcs;
    R.q0 = *(const u32x4*)(zr + ZQ); R.k0 = *(const u32x4*)(zr + ZK); R.q1 = *(const u32x4*)(zr + (size_t)32 * ZW + ZQ); R.k1 = *(const u32x4*)(zr + (size_t)32 * ZW + ZK);
    if (c.tid < 128) R.a = *(const u32x4*)(c.DEC + (t0 + c.arow) * 32 + dir * 16 + c.acs);
}
__device__ __forceinline__ void gla_load_v(const GlaPrepCtx& c, int si, GlaRegs& R) {
    const int dir = c.dir; const size_t t0 = (size_t)(c.b * SEQ + CHUNK(si) * 64); const bf16_t* vr = c.Z + (t0 + c.vrow) * ZW + ZV + c.h * 128 + c.vcs;
    R.v0 = *(const u32x4*)vr; R.v1 = *(const u32x4*)(vr + (size_t)16 * ZW); R.v2 = *(const u32x4*)(vr + (size_t)32 * ZW); R.v3 = *(const u32x4*)(vr + (size_t)48 * ZW);
}
__device__ __forceinline__ void gla_store_qka(const GlaPrepCtx& c, const GlaRegs& R) {
    const int dir = c.dir; const int r0_ = POS(c.lrow), r1_ = POS(c.lrow + 32);
    *(u32x4*)(c.qraw + r0_ * 64 + ROT(r0_, c.lcs)) = R.q0; *(u32x4*)(c.kraw + r0_ * 64 + ROT(r0_, c.lcs)) = R.k0; *(u32x4*)(c.qraw + r1_ * 64 + ROT(r1_, c.lcs)) = R.q1; *(u32x4*)(c.kraw + r1_ * 64 + ROT(r1_, c.lcs)) = R.k1;
    if (c.tid < 128) *(u32x4*)(c.araw + POS(c.arow) * 16 + c.acs) = R.a;
}
__device__ __forceinline__ void gla_store_v(const GlaPrepCtx& c, const GlaRegs& R) {
    const int dir = c.dir;
    ST8_(c.vraw + POS(c.vrow) * VP + c.vcs, R.v0); ST8_(c.vraw + POS(c.vrow + 16) * VP + c.vcs, R.v1); ST8_(c.vraw + POS(c.vrow + 32) * VP + c.vcs, R.v2); ST8_(c.vraw + POS(c.vrow + 48) * VP + c.vcs, R.v3);
}
__device__ __forceinline__ void gla_prep_step(const GlaPrepCtx& c, int s, GlaRegs& LD, GlaRegs& ST) {
    const int wid = c.wid, lr = c.lr, q4 = c.q4, ch = c.ch, tid = c.tid;
    if (s == 32) {
        if (wid == 0) { while (__hip_atomic_load(c.paflag, __ATOMIC_RELAXED, __HIP_MEMORY_SCOPE_AGENT) == 0u) __builtin_amdgcn_s_sleep(4);
            __builtin_amdgcn_fence(__ATOMIC_ACQUIRE, "agent"); asm volatile("s_waitcnt vmcnt(0)" ::: "memory"); }
        __syncthreads();
    }
    if (s + 3 < 64) gla_load_qka(c, s + 3, LD);
    if (s + 2 < 64) gla_load_v(c, s + 2, LD);
    unsigned rq[8], rk[8], ro[8], rko[8]; float rdec = 0.f;
    if (s < 63) {
        float la[16];
#pragma unroll
        for (int cb = 0; cb < 4; ++cb) { const int pr = 16 * (lr >> 2) + 4 * cb + (lr & 3);
            u32x4 aw = (u32x4){0u, 0u, 0u, 0u}; if (q4 < 2) aw = *(const u32x4*)(c.araw + pr * 16 + 8 * q4);
            f32x4 d = (f32x4){c.bias, c.bias, c.bias, c.bias};
            d = __builtin_amdgcn_mfma_f32_16x16x32_bf16(__builtin_bit_cast(bf16x8, aw), c.w2f, d, 0, 0, 0);
#pragma unroll
            for (int jj = 0; jj < 4; ++jj) la[4 * cb + jj] = logsig2(d[jj]); }
#pragma unroll
        for (int i = 1; i < 16; ++i) la[i] += la[i - 1];
        const float tq = la[15]; float inc = tq;
        { const float t1 = __shfl_up(inc, 16); if (q4 >= 1) inc += t1; const float t2 = __shfl_up(inc, 32); if (q4 >= 2) inc += t2; }
        const float off = inc - tq;
        const float tot = __shfl(inc, lr + 48);
        const float bmid = __shfl(off + la[0], lr + 32);
        const float emid = __builtin_amdgcn_exp2f(bmid), etm = __builtin_amdgcn_exp2f(tot - bmid);
        rdec = __builtin_amdgcn_exp2f(tot);
        const int chr = (ch + 16 * q4) & 63;
#pragma unroll
        for (int i = 0; i < 16; i += 2) {
            const int p0 = 16 * q4 + i;
            const float x0 = off + la[i] - bmid, x1 = off + la[i + 1] - bmid;
            const float e10 = __builtin_amdgcn_exp2f(x0), e20 = __builtin_amdgcn_exp2f(-x0), e11 = __builtin_amdgcn_exp2f(x1), e21 = __builtin_amdgcn_exp2f(-x1);
            const float q0 = bf2f(c.qraw[p0 * 64 + chr]) * e10, q1 = bf2f(c.qraw[(p0 + 1) * 64 + chr]) * e11;
            const float k0 = bf2f(c.kraw[p0 * 64 + chr]) * e20, k1 = bf2f(c.kraw[(p0 + 1) * 64 + chr]) * e21;
            rq[i >> 1] = cvt_pk_bf16(q0, q1); rk[i >> 1] = cvt_pk_bf16(k0, k1); ro[i >> 1] = cvt_pk_bf16(q0 * emid, q1 * emid); rko[i >> 1] = cvt_pk_bf16(k0 * etm, k1 * etm);
        }
    }
    GLA_BAR();
    if (s < 63) {
        const int chr = (ch + 16 * q4) & 63;
#pragma unroll
        for (int i = 0; i < 8; ++i) { const int p0 = 16 * q4 + 2 * i;
            c.qin[p0 * GP + chr] = (bf16_t)(rq[i] & 0xffffu); c.qin[(p0 + 1) * GP + chr] = (bf16_t)(rq[i] >> 16);
            c.kin[p0 * GP + chr] = (bf16_t)(rk[i] & 0xffffu); c.kin[(p0 + 1) * GP + chr] = (bf16_t)(rk[i] >> 16);
            c.qout[p0 * GP + chr] = (bf16_t)(ro[i] & 0xffffu); c.qout[(p0 + 1) * GP + chr] = (bf16_t)(ro[i] >> 16); }
        *(u32x4*)(c.koutT + ch * GP + 16 * q4) = (u32x4){rko[0], rko[1], rko[2], rko[3]}; *(u32x4*)(c.koutT + ch * GP + 16 * q4 + 8) = (u32x4){rko[4], rko[5], rko[6], rko[7]};
        if (q4 == 0) c.decs[ch] = rdec;
    }
    if (s + 2 < 64) gla_store_qka(c, ST);
    if (s + 1 < 64) gla_store_v(c, ST);
    if (s == 31) {
        asm volatile("s_waitcnt vmcnt(0)" ::: "memory"); __syncthreads();
        if (tid == 0) { __builtin_amdgcn_fence(__ATOMIC_RELEASE, "agent"); asm volatile("s_waitcnt vmcnt(0)" ::: "memory"); __hip_atomic_store(c.myflag, 1u, __ATOMIC_RELAXED, __HIP_MEMORY_SCOPE_AGENT); }
    }
    GLA_BAR();
}

__device__ __forceinline__ void gla_prep(const Params& p, unsigned char* lds, int l, int item, int tid) {
    unsigned char* ws = p.ws;
    GlaPrepCtx c;
    c.tid = tid; c.wid = __builtin_amdgcn_readfirstlane(tid >> 6); const int lane = tid & 63; c.lr = lane & 15; c.q4 = lane >> 4;
    c.b = item >> 3; c.h = (item >> 1) & 3; c.dir = item & 1; const int dir = c.dir;
    c.Z = (const bf16_t*)(ws + WS_Z); c.DEC = (const bf16_t*)(ws + WS_DEC);
    unsigned* flags = (unsigned*)(ws + WS_CTL);
    c.myflag = flags + (size_t)(l * 128 + item) * 64; c.paflag = flags + (size_t)(l * 128 + (item ^ 1)) * 64;
    c.qin = (bf16_t*)(lds + L_QIN); c.kin = (bf16_t*)(lds + L_KIN); c.qout = (bf16_t*)(lds + L_QOUT); c.koutT = (bf16_t*)(lds + L_KOUTT);
    c.decs = (float*)(lds + L_DEC);
    c.qraw = (bf16_t*)(lds + L_QRAW); c.kraw = (bf16_t*)(lds + L_KRAW); c.araw = (bf16_t*)(lds + L_ARAW); c.vraw = (bf16_t*)(lds + L_VRAW);
    c.lrow = tid >> 3; c.lcs = (tid & 7) * 8; c.vrow = tid >> 4; c.vcs = (tid & 15) * 8; c.arow = tid >> 1; c.acs = (tid & 1) * 8;
    c.ch = 16 * c.wid + c.lr;
    { const float* w2 = (dir ? p.w_a2_bwd : p.w_a2_fwd) + (size_t)l * 16 * 256 + c.h * 64 + c.ch; u32x4 w = (u32x4){0u, 0u, 0u, 0u};
      if (c.q4 < 2) { float t[8];
#pragma unroll
          for (int i = 0; i < 8; ++i) t[i] = w2[(8 * c.q4 + i) * 256];
          w.x = cvt_pk_bf16(t[0], t[1]); w.y = cvt_pk_bf16(t[2], t[3]); w.z = cvt_pk_bf16(t[4], t[5]); w.w = cvt_pk_bf16(t[6], t[7]); }
      c.w2f = __builtin_bit_cast(bf16x8, w); c.bias = (dir ? p.b_a_bwd : p.b_a_fwd)[l * 256 + c.h * 64 + c.ch]; }
    GlaRegs RA, RB;
    gla_load_qka(c, 0, RA); gla_store_qka(c, RA);
    gla_load_qka(c, 1, RB); gla_load_v(c, 0, RB);
    GLA_BAR();
    for (int s = -1; s < 63; s += 2) { gla_prep_step(c, s, RA, RB); gla_prep_step(c, s + 1, RB, RA); }
    gla_prep_step(c, 63, RA, RB);
}
#undef ST8_

__device__ __forceinline__ void gla_mma(const Params& p, unsigned char* lds, int l, int item, int tid) {
    unsigned char* ws = p.ws;
    const int wid = __builtin_amdgcn_readfirstlane(tid >> 6), lane = tid & 63, lr = lane & 15, q4 = lane >> 4;
    const int b = item >> 3, h = (item >> 1) & 3, dir = item & 1;
    const bf16_t* Z = (const bf16_t*)(ws + WS_Z); bf16_t* OX = (bf16_t*)(ws + WS_OX); bf16_t* MIX = (bf16_t*)(ws + WS_MIX);
    const bf16_t* qin = (const bf16_t*)(lds + L_QIN); const bf16_t* kin = (const bf16_t*)(lds + L_KIN); const bf16_t* qout = (const bf16_t*)(lds + L_QOUT); const bf16_t* koutT = (const bf16_t*)(lds + L_KOUTT);
    const float* decs = (const float*)(lds + L_DEC); float* red = (float*)(lds + L_RED); const bf16_t* vraw = (const bf16_t*)(lds + L_VRAW);
    const int vq = wid & 3;
    const int ocol = h * 128 + 32 * vq + 8 * q4;
    f32x4 ng[2];
#pragma unroll
    for (int vb = 0; vb < 2; ++vb) ng[vb] = *(const f32x4*)(p.gla_norm_g + (size_t)l * 512 + ocol + 4 * vb);
    f32x4 accS[2][4];
#pragma unroll
    for (int vb = 0; vb < 2; ++vb)
#pragma unroll
        for (int i = 0; i < 4; ++i) accS[vb][i] = (f32x4){0.f, 0.f, 0.f, 0.f};
    GLA_BAR();
    for (int s = -1; s < 64; ++s) {
        const int tok0 = b * SEQ + CHUNK(s < 0 ? 0 : s) * 64;
#define TOK(c) (tok0 + (dir ? 63 - (c) : (c)))
        if (s == 32) __syncthreads();
        f32x4 accO[2][4]; u32x4 gw[4];
        if (s >= 0) {
            u32x4 ox[4];
            bf16x8 vfrag[2][2];
#pragma unroll
            for (int vb = 0; vb < 2; ++vb)
#pragma unroll
                for (int pp = 0; pp < 2; ++pp)
#pragma unroll
                    for (int i = 0; i < 8; ++i) { const int pos = 32 * pp + 4 * q4 + (i & 3) + ((i >> 2) << 4); vfrag[vb][pp][i] = (short)vraw[pos * VP + 32 * vq + 8 * (lr >> 2) + 4 * vb + (lr & 3)]; }
            bf16x8 qf[4][2], kf[4][2];
#pragma unroll
            for (int cb = 0; cb < 4; ++cb) { qf[cb][0] = *(const bf16x8*)(qin + (16 * cb + lr) * GP + ((8 * q4 + 16 * cb) & 63)); qf[cb][1] = *(const bf16x8*)(qin + (16 * cb + lr) * GP + ((32 + 8 * q4 + 16 * cb) & 63));
                kf[cb][0] = *(const bf16x8*)(kin + (16 * cb + lr) * GP + ((8 * q4 + 16 * cb) & 63)); kf[cb][1] = *(const bf16x8*)(kin + (16 * cb + lr) * GP + ((32 + 8 * q4 + 16 * cb) & 63)); }
            bf16x8 P0[4], P1[2];
            {
                f32x4 sc[4][4];
#pragma unroll
                for (int cb = 0; cb < 4; ++cb)
#pragma unroll
                    for (int jb = 0; jb < 4; ++jb) {
                        if (jb > cb) { sc[jb][cb] = (f32x4){0.f, 0.f, 0.f, 0.f}; continue; }
                        f32x4 a = (f32x4){0.f, 0.f, 0.f, 0.f};
                        a = __builtin_amdgcn_mfma_f32_16x16x32_bf16(kf[jb][0], qf[cb][0], a, 0, 0, 0);
                        sc[jb][cb] = a;
                    }
#pragma unroll
                for (int cb = 0; cb < 4; ++cb)
#pragma unroll
                    for (int jb = 0; jb <= cb; ++jb) sc[jb][cb] = __builtin_amdgcn_mfma_f32_16x16x32_bf16(kf[jb][1], qf[cb][1], sc[jb][cb], 0, 0, 0);
            __builtin_amdgcn_sched_barrier(0);
            if (s >= 32) {
#pragma unroll
                for (int cb = 0; cb < 4; ++cb) { const size_t tk = (size_t)TOK(16 * cb + lr); ox[cb] = *(const u32x4*)(OX + tk * 512 + ocol); gw[cb] = *(const u32x4*)(Z + tk * ZW + ZG + ocol); }
            }
#pragma unroll
                for (int cb = 0; cb < 4; ++cb) {
#pragma unroll
                    for (int jj = 0; jj < 4; ++jj) { const int j = 4 * q4 + jj; const bool keep = dir ? (lr > j) : (lr >= j); sc[cb][cb][jj] = keep ? sc[cb][cb][jj] : 0.f; }
                    { u32x4 w; w.x = cvt_pk_bf16(sc[0][cb][0], sc[0][cb][1]); w.y = cvt_pk_bf16(sc[0][cb][2], sc[0][cb][3]); w.z = cvt_pk_bf16(sc[1][cb][0], sc[1][cb][1]); w.w = cvt_pk_bf16(sc[1][cb][2], sc[1][cb][3]); P0[cb] = __builtin_bit_cast(bf16x8, w); }
                    if (cb >= 2) { u32x4 w; w.x = cvt_pk_bf16(sc[2][cb][0], sc[2][cb][1]); w.y = cvt_pk_bf16(sc[2][cb][2], sc[2][cb][3]); w.z = cvt_pk_bf16(sc[3][cb][0], sc[3][cb][1]); w.w = cvt_pk_bf16(sc[3][cb][2], sc[3][cb][3]); P1[cb - 2] = __builtin_bit_cast(bf16x8, w); }
                }
            }
            bf16x8 qo[4][2];
#pragma unroll
            for (int cb = 0; cb < 4; ++cb)
#pragma unroll
                for (int pp = 0; pp < 2; ++pp) { const bf16_t* qr = qout + (16 * cb + lr) * GP; const u32x2 lo = *(const u32x2*)(qr + ((32 * pp + 4 * q4 + 16 * cb) & 63)), hi = *(const u32x2*)(qr + ((32 * pp + 4 * q4 + 16 + 16 * cb) & 63)); qo[cb][pp] = __builtin_bit_cast(bf16x8, ((u32x4){lo.x, lo.y, hi.x, hi.y})); }
            bf16x8 Sp[2][2];
#pragma unroll
            for (int vb = 0; vb < 2; ++vb)
#pragma unroll
                for (int pp = 0; pp < 2; ++pp) { u32x4 w; w.x = cvt_pk_bf16(accS[vb][2 * pp][0], accS[vb][2 * pp][1]); w.y = cvt_pk_bf16(accS[vb][2 * pp][2], accS[vb][2 * pp][3]);
                    w.z = cvt_pk_bf16(accS[vb][2 * pp + 1][0], accS[vb][2 * pp + 1][1]); w.w = cvt_pk_bf16(accS[vb][2 * pp + 1][2], accS[vb][2 * pp + 1][3]); Sp[vb][pp] = __builtin_bit_cast(bf16x8, w); }
#pragma unroll
            for (int cb = 0; cb < 4; ++cb)
#pragma unroll
                for (int vb = 0; vb < 2; ++vb) {
                    f32x4 a = (f32x4){0.f, 0.f, 0.f, 0.f};
                    a = __builtin_amdgcn_mfma_f32_16x16x32_bf16(Sp[vb][0], qo[cb][0], a, 0, 0, 0);
                    accO[vb][cb] = a; }
#pragma unroll
            for (int cb = 0; cb < 4; ++cb)
#pragma unroll
                for (int vb = 0; vb < 2; ++vb) accO[vb][cb] = __builtin_amdgcn_mfma_f32_16x16x32_bf16(Sp[vb][1], qo[cb][1], accO[vb][cb], 0, 0, 0);
#pragma unroll
            for (int cb = 0; cb < 4; ++cb)
#pragma unroll
                for (int vb = 0; vb < 2; ++vb) accO[vb][cb] = __builtin_amdgcn_mfma_f32_16x16x32_bf16(vfrag[vb][0], P0[cb], accO[vb][cb], 0, 0, 0);
#pragma unroll
            for (int cb = 2; cb < 4; ++cb)
#pragma unroll
                for (int vb = 0; vb < 2; ++vb) accO[vb][cb] = __builtin_amdgcn_mfma_f32_16x16x32_bf16(vfrag[vb][1], P1[cb - 2], accO[vb][cb], 0, 0, 0);
            __builtin_amdgcn_sched_barrier(0);
            bf16x8 ko[4][2]; f32x4 dv[4];
#pragma unroll
            for (int kb = 0; kb < 4; ++kb) { dv[kb] = *(const f32x4*)(decs + 16 * kb + 4 * q4);
#pragma unroll
                for (int pp = 0; pp < 2; ++pp) { const bf16_t* kp = koutT + (16 * kb + lr) * GP + 32 * pp + 4 * q4; const u32x2 lo = *(const u32x2*)kp, hi = *(const u32x2*)(kp + 16); ko[kb][pp] = __builtin_bit_cast(bf16x8, ((u32x4){lo.x, lo.y, hi.x, hi.y})); } }
#pragma unroll
            for (int kb = 0; kb < 4; ++kb)
#pragma unroll
                for (int vb = 0; vb < 2; ++vb) accS[vb][kb] = __builtin_amdgcn_mfma_f32_16x16x32_bf16(ko[kb][0], vfrag[vb][0], accS[vb][kb] * dv[kb], 0, 0, 0);
#pragma unroll
            for (int kb = 0; kb < 4; ++kb)
#pragma unroll
                for (int vb = 0; vb < 2; ++vb) accS[vb][kb] = __builtin_amdgcn_mfma_f32_16x16x32_bf16(ko[kb][1], vfrag[vb][1], accS[vb][kb], 0, 0, 0);
            if (s < 32) {
#pragma unroll
                for (int cb = 0; cb < 4; ++cb) { const f32x4 o0 = accO[0][cb], o1 = accO[1][cb]; *(u32x4*)(OX + (size_t)TOK(16 * cb + lr) * 512 + ocol) = (u32x4){cvt_pk_bf16(o0[0], o0[1]), cvt_pk_bf16(o0[2], o0[3]), cvt_pk_bf16(o1[0], o1[1]), cvt_pk_bf16(o1[2], o1[3])}; }
            } else {
#pragma unroll
                for (int cb = 0; cb < 4; ++cb) { float ss = 0.f;
#pragma unroll
                    for (int vb = 0; vb < 2; ++vb) { const unsigned xa = vb ? ox[cb].z : ox[cb].x, xb2 = vb ? ox[cb].w : ox[cb].y; accO[vb][cb] += (f32x4){bflo(xa), bfhi(xa), bflo(xb2), bfhi(xb2)}; const f32x4 o = accO[vb][cb]; ss += (o[0] * o[0] + o[1] * o[1]) + (o[2] * o[2] + o[3] * o[3]); }
                    ss += __shfl_xor(ss, 16); ss += __shfl_xor(ss, 32);
                    if (q4 == 0) red[vq * 64 + 16 * cb + lr] = ss; }
            }
        }
        GLA_BAR();
        if (s >= 32) {
#pragma unroll
            for (int cb = 0; cb < 4; ++cb) { const float ss = (red[16 * cb + lr] + red[64 + 16 * cb + lr]) + (red[128 + 16 * cb + lr] + red[192 + 16 * cb + lr]);
                const float rs = rsqrtf(ss * (1.0f / 128.0f) + EPS); const size_t tk = (size_t)TOK(16 * cb + lr);
                const f32x4 o0 = accO[0][cb] * rs * ng[0], o1 = accO[1][cb] * rs * ng[1]; const u32x4 g4 = gw[cb];
                u32x4 w; w.x = cvt_pk_bf16(o0[0] * bflo(g4.x), o0[1] * bfhi(g4.x)); w.y = cvt_pk_bf16(o0[2] * bflo(g4.y), o0[3] * bfhi(g4.y)); w.z = cvt_pk_bf16(o1[0] * bflo(g4.z), o1[1] * bfhi(g4.z)); w.w = cvt_pk_bf16(o1[2] * bflo(g4.w), o1[3] * bfhi(g4.w));
                *(u32x4*)(MIX + tk * D + ocol) = w; }
        }
        if (s == 31) { asm volatile("s_waitcnt vmcnt(0)" ::: "memory"); __syncthreads(); }
        GLA_BAR();
#undef TOK
    }
}
#undef CHUNK
#undef POS

PHASE_FN void gla_item(const Params& p, unsigned char* lds, int l, int item) {
    int tid = threadIdx.x; asm volatile("" : "+v"(tid));
    if (tid < 256) gla_prep(p, lds, l, item, tid); else gla_mma(p, lds, l, item, tid);
    __syncthreads();
}

constexpr int SP = 136;
constexpr int L_SW = 0;
constexpr int L_SV0 = 128 * SP * 2;
constexpr int L_SV1 = 2 * 128 * SP * 2;
PHASE_FN void sgu_block(const Params& p, unsigned char* lds, int l, int g, int ch0, int nch) {
    unsigned char* ws = p.ws;
    int tid = threadIdx.x; asm volatile("" : "+v"(tid));
    const int wid = __builtin_amdgcn_readfirstlane(tid >> 6), lane = tid & 63, lr = lane & 15, q4 = lane >> 4;
    const bf16_t* __restrict__ Z = (const bf16_t*)(ws + WS_Z); bf16_t* __restrict__ MIX = (bf16_t*)(ws + WS_MIX);
    const bf16_t* __restrict__ wsb = (const bf16_t*)(ws + WS_WSB) + (size_t)(l * 4 + g) * 128 * 128;
    bf16_t* wl = (bf16_t*)(lds + L_SW);
    const int lrow = tid >> 4, cs = (tid & 15) * 8;
#pragma unroll
    for (int i = 0; i < 4; ++i) *(u32x4*)(wl + (lrow + 32 * i) * SP + cs) = *(const u32x4*)(wsb + (size_t)(lrow + 32 * i) * 128 + cs);
    const float* ngp = p.sgu_norm_g + (size_t)l * 512 + g * 128 + cs; const f32x4 g0 = *(const f32x4*)ngp, g1 = *(const f32x4*)(ngp + 4);
    float bs[8];
#pragma unroll
    for (int pb = 0; pb < 8; ++pb) bs[pb] = p.b_s[(size_t)l * 512 + g * 128 + 16 * pb + lr];
    const int ocol = g * 128 + 16 * wid + 4 * q4;
    u32x4 pv[4];
#define SGU_LOAD(ch) do { _Pragma("unroll") for (int i = 0; i < 4; ++i) pv[i] = *(const u32x4*)(Z + (size_t)((ch) * 128 + lrow + 32 * i) * ZW + ZSV + g * 128 + cs); } while (0)
    SGU_LOAD(ch0);
    int buf = 0;
    for (int ch = ch0; ch < ch0 + nch; ++ch, buf ^= 1) {
        const int tok0 = ch * 128;
        bf16_t* vt = (bf16_t*)(lds + (buf ? L_SV1 : L_SV0));
#pragma unroll
        for (int i = 0; i < 4; ++i) { const u32x4 w = pv[i];
            float v[8];
            { const f32x2 a = gelu_pk((f32x2){bflo(w.x), bfhi(w.x)}), b2 = gelu_pk((f32x2){bflo(w.y), bfhi(w.y)}), c = gelu_pk((f32x2){bflo(w.z), bfhi(w.z)}), d = gelu_pk((f32x2){bflo(w.w), bfhi(w.w)});
              v[0] = a.x; v[1] = a.y; v[2] = b2.x; v[3] = b2.y; v[4] = c.x; v[5] = c.y; v[6] = d.x; v[7] = d.y; }
            float ss = 0.f;
#pragma unroll
            for (int k = 0; k < 8; ++k) ss += v[k] * v[k];
            ss += __shfl_xor(ss, 1); ss += __shfl_xor(ss, 2); ss += __shfl_xor(ss, 4); ss += __shfl_xor(ss, 8);
            const float rs = rsqrtf(ss * (1.0f / 128.0f) + EPS);
            u32x4 o; o.x = cvt_pk_bf16(v[0] * rs * g0[0], v[1] * rs * g0[1]); o.y = cvt_pk_bf16(v[2] * rs * g0[2], v[3] * rs * g0[3]);
            o.z = cvt_pk_bf16(v[4] * rs * g1[0], v[5] * rs * g1[1]); o.w = cvt_pk_bf16(v[6] * rs * g1[2], v[7] * rs * g1[3]);
            *(u32x4*)(vt + (lrow + 32 * i) * SP + cs) = o; }
        if (ch + 1 < ch0 + nch) SGU_LOAD(ch + 1);
        u32x2 uw[8];
#pragma unroll
        for (int pb = 0; pb < 8; ++pb) uw[pb] = *(const u32x2*)(Z + (size_t)(tok0 + 16 * pb + lr) * ZW + ZSU + ocol);
        asm volatile("s_waitcnt lgkmcnt(0)" ::: "memory"); __builtin_amdgcn_s_barrier(); asm volatile("" ::: "memory");
        bf16x8 af[4];
#pragma unroll
        for (int ks = 0; ks < 4; ++ks)
#pragma unroll
            for (int i = 0; i < 8; ++i) af[ks][i] = (short)vt[(32 * ks + 8 * q4 + i) * SP + 16 * wid + lr];
#pragma unroll
        for (int pb = 0; pb < 8; ++pb) {
            f32x4 a = (f32x4){0.f, 0.f, 0.f, 0.f};
#pragma unroll
            for (int ks = 0; ks < 4; ++ks) { const bf16x8 bf = *(const bf16x8*)(wl + (16 * pb + lr) * SP + 32 * ks + 8 * q4); a = __builtin_amdgcn_mfma_f32_16x16x32_bf16(af[ks], bf, a, 0, 0, 0); }
            const f32x2 u0 = gelu_pk((f32x2){bflo(uw[pb].x), bfhi(uw[pb].x)}), u1 = gelu_pk((f32x2){bflo(uw[pb].y), bfhi(uw[pb].y)});
            u32x2 w; w.x = cvt_pk_bf16((a[0] + bs[pb]) * u0.x, (a[1] + bs[pb]) * u0.y); w.y = cvt_pk_bf16((a[2] + bs[pb]) * u1.x, (a[3] + bs[pb]) * u1.y);
            *(u32x2*)(MIX + (size_t)(tok0 + 16 * pb + lr) * D + 512 + ocol) = w;
        }
    }
#undef SGU_LOAD
    __syncthreads();
}

#define XB_TMO      128
#define XB_XCNT(j)  (256  + 64 * (j))
#define XB_XSUB(j)  (1280 + 64 * (j))
#define XB_XGEN(j)  (2304 + 64 * (j))
#define XB_TOP      3328
#define XB_TOPGEN   3392
#define XCD_BAR_WORDS 3456
#define XB_SPIN_CAP (1u << 18)

__device__ __forceinline__ unsigned xb_ld(unsigned* p)              { return __hip_atomic_load(p, __ATOMIC_RELAXED, __HIP_MEMORY_SCOPE_AGENT); }
__device__ __forceinline__ unsigned xb_add(unsigned* p, unsigned v) { return __hip_atomic_fetch_add(p, v, __ATOMIC_RELAXED, __HIP_MEMORY_SCOPE_AGENT); }
__device__ __forceinline__ unsigned xb_xcc_id() { return (unsigned)__builtin_amdgcn_s_getreg((3 << 11) | 20) & 0xFu; }
#define XB_SPIN(cond, bar) do { unsigned _sp = 0; while (cond) { __builtin_amdgcn_s_sleep(1); \
    if ((++_sp & 255u) == 0u) { if (xb_ld(&(bar)[XB_TMO])) break; if (_sp > XB_SPIN_CAP) { atomicAdd(&(bar)[XB_TMO], 1u); break; } } } } while (0)

struct XcdBarrier {
    unsigned* bar; unsigned x;
    volatile LAS unsigned* st;
};

__device__ __forceinline__ XcdBarrier xcd_barrier_post(unsigned* bar, volatile LAS unsigned* st) {
    XcdBarrier b; b.bar = bar; b.x = xb_xcc_id(); b.st = st;
    if (threadIdx.x == 0) (void)xb_add(&bar[XB_XCNT(b.x)], 1u);
    return b;
}
__device__ __forceinline__ void xcd_barrier_complete(unsigned* bar, unsigned x, unsigned& nloc, unsigned& nx) {
    const unsigned G = gridDim.x * gridDim.y * gridDim.z;
    unsigned sum, cnt, mine, sp = 0u;
    for (;;) {
        sum = 0u; cnt = 0u; mine = 0u;
#pragma unroll
        for (unsigned j = 0; j < 16; ++j) { const unsigned c = xb_ld(&bar[XB_XCNT(j)]); sum += c; cnt += (c > 0u) ? 1u : 0u; mine = (j == x) ? c : mine; }
        if (sum == G) break;
        __builtin_amdgcn_s_sleep(1);
        if ((++sp & 255u) == 0u) { if (xb_ld(&bar[XB_TMO])) break; if (sp > XB_SPIN_CAP) { atomicAdd(&bar[XB_TMO], 1u); break; } }
    }
    nloc = mine > 0u ? mine : 1u; nx = cnt > 0u ? cnt : 1u;
}

__device__ __forceinline__ void xcd_barrier(const XcdBarrier& b) {
    asm volatile("s_waitcnt vmcnt(0)" ::: "memory");
    __syncthreads();
    if (threadIdx.x == 0) {
        unsigned* bar = b.bar;
        __builtin_amdgcn_s_waitcnt(0);
        unsigned nloc = b.st[0], nx = b.st[1];
        if (nloc == 0u) { xcd_barrier_complete(bar, b.x, nloc, nx); b.st[0] = nloc; b.st[1] = nx; }
        const unsigned old = xb_add(&bar[XB_XSUB(b.x)], 1u);
        const unsigned gen = old / nloc;
        if (old + 1u == (gen + 1u) * nloc) {
            __builtin_amdgcn_fence(__ATOMIC_RELEASE, "agent");
            asm volatile("s_waitcnt vmcnt(0)" ::: "memory");
            const unsigned og = xb_add(&bar[XB_TOP], 1u);
            const unsigned tg = og / nx;
            if (og + 1u == (tg + 1u) * nx) xb_add(&bar[XB_TOPGEN], 1u);
            else XB_SPIN(xb_ld(&bar[XB_TOPGEN]) == tg, bar);
            __builtin_amdgcn_fence(__ATOMIC_ACQUIRE, "agent");
            xb_add(&bar[XB_XGEN(b.x)], 1u);
            asm volatile("s_waitcnt vmcnt(0)" ::: "memory");
        } else {
            XB_SPIN(xb_ld(&bar[XB_XGEN(b.x)]) == gen, bar);
            __builtin_amdgcn_fence(__ATOMIC_ACQUIRE, "agent");
            asm volatile("s_waitcnt vmcnt(0)" ::: "memory");
        }
    }
    __syncthreads();
}

template <class Epi>
PHASE_FN void gemm_call(LAS unsigned char* ldsl, const bf16_t* A, const bf16_t* Bt, int N, int K, Epi E, int smode = 0, int sbase = 0) {
    pg8::Gemm g{A, Bt, T, N, K}; pg8::StaticOrder S; S.init(T, N, (int)gridDim.x, (int)blockIdx.x); S.mode = smode; S.base = sbase;
    pg8::gemm_phase<Epi, pg8::StaticOrder, true, true>(ldsl, g, S, E);
}
__global__ void __launch_bounds__(512, 2) fwd_megakernel(Params p) {
    extern __shared__ __attribute__((aligned(16))) unsigned char lds[];
    cg::grid_group grid = cg::this_grid();
    unsigned char* ws = p.ws;
    const int G = gridDim.x, bx = blockIdx.x;
    bf16_t* XB = (bf16_t*)(ws + WS_XB); float* SSQ = (float*)(ws + WS_SSQ); bf16_t* Zb = (bf16_t*)(ws + WS_Z); bf16_t* DECb = (bf16_t*)(ws + WS_DEC);
    bf16_t* MIXb = (bf16_t*)(ws + WS_MIX); bf16_t* HID = (bf16_t*)(ws + WS_HID);
    LAS unsigned char* ldsl = (LAS unsigned char*)lds;
    volatile LAS unsigned* xst = (volatile LAS unsigned*)(ldsl + 131072 + 320);
    if (threadIdx.x < 4) xst[threadIdx.x] = 0u;
    __syncthreads();
    const XcdBarrier xbar = xcd_barrier_post((unsigned*)(ws + WS_CTL + 512 * 1024), xst);

#ifndef NO_PREP
    phase_prep(p, (float*)lds);
#endif
    asm volatile("s_waitcnt vmcnt(0)" ::: "memory"); __syncthreads();
    __threadfence();
    grid.sync();
    for (int l = 0; l < DEPTH; ++l) {
        for (int part = 0; part < 2; ++part) {
            if (part == 1 && bx < 128) break;
            gemm_call<pg8::EpiZ>(ldsl, XB, (const bf16_t*)(ws + WS_WIN) + (size_t)l * ZW * D, part == 0 ? ZN_A : ZW, D, pg8::EpiZ{Zb, DECb, SSQ, (LAS float*)(ldsl + 131072 + 1024), -1}, part, 2 * (bx - 128));
            if (part == 0) xcd_barrier(xbar);
        }
        if (bx < 128) gla_item(p, lds, l, bx);
        else if (bx < 256) {
            __builtin_amdgcn_fence(__ATOMIC_ACQUIRE, "agent"); asm volatile("s_waitcnt vmcnt(0)" ::: "memory"); __syncthreads();
            for (int g = 0; g < 4; ++g) sgu_block(p, lds, l, g, 4 * (bx - 128), 4);
        }
        xcd_barrier(xbar);
#ifndef NO_G2
        gemm_call<pg8::EpiRes>(ldsl, MIXb, (const bf16_t*)(ws + WS_WOUT) + (size_t)l * D * D, D, D, pg8::EpiRes{p.x, p.out, XB, SSQ, l == 0 ? 1 : 0});
#endif
        xcd_barrier(xbar);
#ifndef NO_G3
        gemm_call<pg8::EpiH>(ldsl, XB, (const bf16_t*)(ws + WS_W1) + (size_t)l * FF * D, FF, D, pg8::EpiH{HID, SSQ, (LAS float*)(ldsl + 131072 + 1024), -1});
#endif
        xcd_barrier(xbar);
#ifndef NO_G4
        gemm_call<pg8::EpiRes>(ldsl, HID, (const bf16_t*)(ws + WS_W2) + (size_t)l * D * FF, D, FF, pg8::EpiRes{p.x, p.out, XB, SSQ, 0});
#endif
        xcd_barrier(xbar);
    }
    { const int tid = threadIdx.x;
      for (size_t i = ((size_t)bx * 512 + tid) * 8; i < (size_t)T * D; i += (size_t)G * 512 * 8) {
          const int r = (int)(i >> 10), c = (int)(i & 1023);
          const float* sp = SSQ + (size_t)r * 16; float s = 0.f;
#pragma unroll
          for (int j = 0; j < 4; ++j) { const f32x4 q = *(const f32x4*)(sp + 4 * j); s += (q[0] + q[1]) + (q[2] + q[3]); }
          const float rs = rsqrtf(s * (1.0f / 1024.0f) + EPS);
          const u32x4 w = *(const u32x4*)(XB + i); const f32x4 g0 = *(const f32x4*)(p.final_norm_g + c), g1 = *(const f32x4*)(p.final_norm_g + c + 4);
          *(f32x4*)(p.out + i) = (f32x4){bflo(w.x), bfhi(w.x), bflo(w.y), bfhi(w.y)} * rs * g0;
          *(f32x4*)(p.out + i + 4) = (f32x4){bflo(w.z), bfhi(w.z), bflo(w.w), bfhi(w.w)} * rs * g1; } }
}

extern "C" void kernel_launch(void* const* d_in, const int* in_sizes, int n_in, void* d_out, int out_size, void* d_ws, size_t ws_size, hipStream_t stream) {
    static int grid = 0;
    if (grid == 0) {
        if (n_in != 16 || out_size != T * D || ws_size < WS_END) { fprintf(stderr, "kernel_launch: unexpected shapes: n_in %d out %d ws %zu (need %zu)\n", n_in, out_size, ws_size, (size_t)WS_END); grid = -1; return; }
        int dev = 0, cus = 0, per_cu = 0;
        (void)hipGetDevice(&dev); (void)hipDeviceGetAttribute(&cus, hipDeviceAttributeMultiprocessorCount, dev);
        if (hipFuncSetAttribute((const void*)fwd_megakernel, hipFuncAttributeMaxDynamicSharedMemorySize, LDS_BYTES) != hipSuccess) { fprintf(stderr, "kernel_launch: hipFuncSetAttribute failed\n"); grid = -1; return; }
        (void)hipOccupancyMaxActiveBlocksPerMultiprocessor(&per_cu, (const void*)fwd_megakernel, 512, LDS_BYTES);
        (void)hipGetLastError();
        if (per_cu < 1) { fprintf(stderr, "kernel_launch: occupancy query says %d blocks per CU\n", per_cu); per_cu = 1; }
        grid = cus;
        if (grid < 256) { fprintf(stderr, "kernel_launch: %d CUs; this kernel's mixer phase needs a grid of at least 256\n", grid); }
    }
    if (grid < 0) return;
    (void)hipMemsetAsync((char*)d_ws + WS_CTL, 0, CTL_BYTES, stream);
    Params p{};
    p.x = (const float*)d_in[0]; p.norm_mix_g = (const float*)d_in[1]; p.w_in = (const float*)d_in[2]; p.w_a2_fwd = (const float*)d_in[3]; p.b_a_fwd = (const float*)d_in[4];
    p.w_a2_bwd = (const float*)d_in[5]; p.b_a_bwd = (const float*)d_in[6]; p.gla_norm_g = (const float*)d_in[7]; p.sgu_norm_g = (const float*)d_in[8]; p.w_s = (const float*)d_in[9];
    p.b_s = (const float*)d_in[10]; p.w_out = (const float*)d_in[11]; p.norm_mlp_g = (const float*)d_in[12]; p.w_mlp1 = (const float*)d_in[13]; p.w_mlp2 = (const float*)d_in[14];
    p.final_norm_g = (const float*)d_in[15]; p.out = (float*)d_out; p.ws = (unsigned char*)d_ws;
    void* args[] = {&p};
    hipError_t e = hipLaunchCooperativeKernel((const void*)fwd_megakernel, dim3(grid), dim3(512), args, LDS_BYTES, stream);
    if (e != hipSuccess) fprintf(stderr, "cooperative launch failed: %s (grid %d)\n", hipGetErrorString(e), grid);
}
```

```cpp
#include <hip/hip_runtime.h>
#include <hip/hip_cooperative_groups.h>
#include <cstdio>
namespace cg = cooperative_groups;

#define LAS __attribute__((address_space(3)))
#ifndef PHASE_FN
#define PHASE_FN __device__ __forceinline__
#endif
typedef unsigned short bf16_t;
typedef short bf16x8 __attribute__((ext_vector_type(8)));
typedef short bf16x4 __attribute__((ext_vector_type(4)));
typedef float f32x4 __attribute__((ext_vector_type(4)));
typedef float f32x2 __attribute__((ext_vector_type(2)));
typedef unsigned u32x4 __attribute__((ext_vector_type(4)));
typedef unsigned u32x2 __attribute__((ext_vector_type(2)));

constexpr int T = 65536, D = 1024, FF = 4096, SEQ = 4096, DEPTH = 4;
constexpr int ZW = 2816;
constexpr int D_IN = 2592;
constexpr float EPS = 1e-6f;
constexpr int ZQ = 0, ZK = 256, ZV = 512, ZG = 1024, ZSU = 1536, ZSV = 2304;
constexpr int ZN_A = 2304;

constexpr size_t MiB = 1u << 20;
constexpr size_t WS_CTL = 0, CTL_BYTES = 1 * MiB;
constexpr size_t WS_WIN = 1 * MiB;
constexpr size_t WS_WOUT = 23 * MiB;
constexpr size_t WS_W1 = 31 * MiB;
constexpr size_t WS_W2 = 63 * MiB;
constexpr size_t WS_WSB = 95 * MiB;
constexpr size_t WS_SSQ = 96 * MiB;
constexpr size_t WS_DEC = 100 * MiB;
constexpr size_t WS_XB = 108 * MiB;
constexpr size_t WS_Z = 236 * MiB;
constexpr size_t WS_MIX = 588 * MiB;
constexpr size_t WS_OX = 716 * MiB;
constexpr size_t WS_HID = 236 * MiB;
constexpr size_t WS_END = 844 * MiB;
constexpr int LDS_BYTES = 147456;

struct Params {
    const float* x; const float* norm_mix_g; const float* w_in; const float* w_a2_fwd; const float* b_a_fwd; const float* w_a2_bwd; const float* b_a_bwd;
    const float* gla_norm_g; const float* sgu_norm_g; const float* w_s; const float* b_s; const float* w_out; const float* norm_mlp_g; const float* w_mlp1;
    const float* w_mlp2; const float* final_norm_g; float* out; unsigned char* ws;
};

__device__ __forceinline__ unsigned cvt_pk_bf16(float lo, float hi) { unsigned r; asm volatile("v_cvt_pk_bf16_f32 %0, %1, %2" : "=v"(r) : "v"(lo), "v"(hi)); return r; }
__device__ __forceinline__ float bf2f(unsigned short b) { return __uint_as_float(((unsigned)b) << 16); }
__device__ __forceinline__ float bflo(unsigned w) { return __uint_as_float(w << 16); }
__device__ __forceinline__ float bfhi(unsigned w) { return __uint_as_float(w & 0xffff0000u); }

__device__ __forceinline__ f32x2 gelu_pk(f32x2 v) {
    const f32x2 av = __builtin_elementwise_abs(v), d = av * 0.2316418882f + 1.0f;
    f32x2 t; t.x = __builtin_amdgcn_rcpf(d.x); t.y = __builtin_amdgcn_rcpf(d.y);
    f32x2 q = t * 0.5307027145f + (-0.7265760135f); q = q * t + 0.7107068705f; q = q * t + (-0.142248368f); q = q * t + 0.127414796f; q = q * t;
    const f32x2 s = (v * v) * (-0.72134752044f);
    f32x2 e; e.x = __builtin_amdgcn_exp2f(s.x); e.y = __builtin_amdgcn_exp2f(s.y);
    const f32x2 m = v * (q * e), r = v - m;
    f32x2 o; o.x = v.x < 0.f ? m.x : r.x; o.y = v.y < 0.f ? m.y : r.y; return o;
}
__device__ __forceinline__ float silu_f(float v) { return v * __builtin_amdgcn_rcpf(1.0f + __expf(-v)); }

namespace pg8 {
constexpr int BM = 256, BK = 64, HALF = 128, HTB = HALF * BK * 2, STAGE_BYTES = 8 * HTB, NXCD = 8, WGM = 8;
__host__ __device__ __forceinline__ int lds_byte(int r, int c) { const int st = (r >> 4) * 2 + (c >> 5), rr = r & 15, cc = c & 31, ob = rr * 64 + cc * 2; return st * 1024 + (ob ^ (((ob >> 9) & 1) << 5)); }
__host__ __device__ __forceinline__ void stage_rc(int b, int& R, int& C) { const int st = b / 1024, sb = b % 1024, swz = sb ^ (((sb >> 9) & 1) << 5); R = (st >> 1) * 16 + swz / 64; C = (st & 1) * 32 + (swz % 64) / 2; }
__host__ __device__ __forceinline__ int perm32(int rho) { const int n = rho >> 4, i = rho & 15; return 8 * (i >> 2) + 4 * n + (i & 3); }
struct Unit { int pm, pn; };
struct Gemm { const bf16_t* A; const bf16_t* Bt; int M, N, K; };
struct StaticOrder {
    int nM, nN, nwg, G, c, mode, base;
    __device__ void init(int M, int N, int G_, int c_) { nM = M / BM; nN = N / BM; nwg = nM * nN; G = G_; c = c_; mode = 0; base = 0; }
    __device__ bool next(int i, Unit& u) const {
        if (mode == 1) { if (i >= 4) return false; u.pm = base + (i >> 1); u.pn = 9 + (i & 1); return true; }
        const long L = (long)i * G + c; if (L >= nwg) return false;
        int wgid = (int)L; { const int q = nwg / NXCD, r = nwg % NXCD, xcd = wgid % NXCD, off = wgid / NXCD; wgid = (xcd < r ? xcd * (q + 1) : r * (q + 1) + (xcd - r) * q) + off; }
        const int nig = WGM * nN, gid = wgid / nig, fm = gid * WGM, gsz = (nM - fm) < WGM ? (nM - fm) : WGM;
        u.pm = fm + ((wgid % nig) % gsz); u.pn = (wgid % nig) / gsz; return true;
    }
    __device__ __forceinline__ void a_ready(const Unit&) const {}
    __device__ __forceinline__ void done(const Unit&) const {}
};

template <class Epi, class Sched, bool ALIGN_EPI = false, bool SP2 = false>
__device__ __forceinline__ void gemm_phase(LAS unsigned char* lds, const Gemm g, const Sched& S, const Epi& E) {
    int tid = threadIdx.x; asm volatile("" : "+v"(tid));
    const int wid = __builtin_amdgcn_readfirstlane(tid >> 6), lane = tid & 63, wr = wid >> 2, wc = wid & 3, fr = lane & 15, fq = lane >> 4;
    const int K = g.K, nt = K / BK;
    unsigned voffA[2], voffB[2];
#pragma unroll
    for (int i = 0; i < 2; ++i) { int R, C; stage_rc(tid * 16 + i * 8192, R, C); const int Rb = Epi::PERM ? ((R & ~31) + perm32(R & 31)) : R;
        voffA[i] = (unsigned)(R * K + C) * 2u; voffB[i] = (unsigned)(Rb * K + C) * 2u; }
    const size_t kstep = (size_t)(BK * 2);
    const size_t hstep = (size_t)HALF * K * 2;
    const size_t tstep = 2 * hstep;
    const unsigned ldsw = (unsigned)wid * 1024u;
    const int aoff = lds_byte(wr * 64 + fr, fq * 8), boff = lds_byte(wc * 32 + fr, fq * 8);
#define PG8_SA(b, h) (((b) * 2 + (h)) * HTB)
#define PG8_SB(b, h) ((4 + (b) * 2 + (h)) * HTB)
#define PG8_STAGE(bufoff, gbase, voff) do { _Pragma("unroll") for (int _i = 0; _i < 2; ++_i) \
        __builtin_amdgcn_global_load_lds((const unsigned*)((const char*)(gbase) + (voff)[_i]), (LAS unsigned*)(lds + (bufoff) + ldsw + _i * 8192), 16, 0, 0); } while (0)
#define PG8_LDA(dst, b, h) do { _Pragma("unroll") for (int m = 0; m < 4; ++m) _Pragma("unroll") for (int k = 0; k < 2; ++k) dst[m][k] = *(const LAS bf16x8*)(lds + PG8_SA(b, h) + aoff + m * 2048 + k * 1024); } while (0)
#define PG8_LDB(dst, b, h) do { _Pragma("unroll") for (int n = 0; n < 2; ++n) _Pragma("unroll") for (int k = 0; k < 2; ++k) dst[n][k] = *(const LAS bf16x8*)(lds + PG8_SB(b, h) + boff + n * 2048 + k * 1024); } while (0)
#define PG8_MMA(ai, bj, At, Bt) do { __builtin_amdgcn_s_setprio(1); _Pragma("unroll") for (int m = 0; m < 4; ++m) _Pragma("unroll") for (int n = 0; n < 2; ++n) _Pragma("unroll") for (int k = 0; k < 2; ++k) \
        acc[ai][bj][m][n] = __builtin_amdgcn_mfma_f32_16x16x32_bf16(Bt[n][k], At[m][k], acc[ai][bj][m][n], 0, 0, 0); __builtin_amdgcn_s_setprio(0); } while (0)
#define PG8_WAIT_V(n) asm volatile("s_waitcnt vmcnt(" #n ")" ::: "memory")
#define PG8_WAIT_L(n) asm volatile("s_waitcnt lgkmcnt(" #n ")" ::: "memory")
#define PG8_BAR __builtin_amdgcn_s_barrier()
#define PG8_SCHED __builtin_amdgcn_sched_barrier(0)
    Unit cur, nxt; int ui = 0;
    if (!S.next(0, cur)) return;
    f32x4 acc[2][2][4][2];
#pragma unroll
    for (int a = 0; a < 2; ++a)
#pragma unroll
        for (int b = 0; b < 2; ++b)
#pragma unroll
            for (int m = 0; m < 4; ++m)
#pragma unroll
                for (int n = 0; n < 2; ++n) acc[a][b][m][n] = (f32x4){0.f, 0.f, 0.f, 0.f};
    bf16x8 At[4][2], B0[2][2], B1[2][2];
    const char* cA = (const char*)g.A + (size_t)cur.pm * tstep; const char* cB = (const char*)g.Bt + (size_t)cur.pn * tstep;
    S.a_ready(cur);
    if constexpr (SP2) {
        PG8_STAGE(PG8_SB(0, 0), cB, voffB); PG8_STAGE(PG8_SB(0, 1), cB + hstep, voffB); PG8_STAGE(PG8_SA(0, 0), cA, voffA); PG8_STAGE(PG8_SA(0, 1), cA + hstep, voffA);
        if (wr == 1) PG8_BAR;
        PG8_WAIT_V(2); PG8_BAR;
        PG8_STAGE(PG8_SB(1, 0), cB + kstep, voffB); PG8_STAGE(PG8_SA(1, 0), cA + kstep, voffA); PG8_STAGE(PG8_SB(1, 1), cB + hstep + kstep, voffB);
        PG8_WAIT_V(6); PG8_BAR;
    } else {
        PG8_STAGE(PG8_SB(0, 0), cB, voffB); PG8_STAGE(PG8_SA(0, 0), cA, voffA); PG8_STAGE(PG8_SB(0, 1), cB + hstep, voffB); PG8_STAGE(PG8_SA(0, 1), cA + hstep, voffA);
        if (wr == 1) PG8_BAR;
        PG8_WAIT_V(4); PG8_BAR;
        PG8_STAGE(PG8_SB(1, 0), cB + kstep, voffB); PG8_STAGE(PG8_SA(1, 0), cA + kstep, voffA); PG8_STAGE(PG8_SB(1, 1), cB + hstep + kstep, voffB);
        PG8_WAIT_V(6); PG8_BAR;
    }
    for (;;) {
        const bool has_next = S.next(ui + 1, nxt);
        const char* nA = has_next ? (const char*)g.A + (size_t)nxt.pm * tstep : cA; const char* nB = has_next ? (const char*)g.Bt + (size_t)nxt.pn * tstep : cB;
        for (int t = 0; t < nt; t += 2) {
            const bool last = (t == nt - 2);
            const char* a1 = cA + (size_t)(t + 1) * kstep;
            const char* a2 = last ? nA : cA + (size_t)(t + 2) * kstep; const char* b2 = last ? nB : cB + (size_t)(t + 2) * kstep;
            const char* a3 = a2 + kstep; const char* b3 = b2 + kstep;
            if (last && has_next) S.a_ready(nxt);
            if constexpr (SP2) {
            PG8_LDB(B0, 0, 0); PG8_LDB(B1, 0, 1); PG8_SCHED; PG8_LDA(At, 0, 0); PG8_STAGE(PG8_SA(1, 1), a1 + hstep, voffA);
            PG8_WAIT_V(8); PG8_WAIT_L(0); PG8_BAR; PG8_MMA(0, 0, At, B0); PG8_MMA(0, 1, At, B1); PG8_BAR; PG8_SCHED;
            PG8_LDA(At, 0, 1); PG8_STAGE(PG8_SB(0, 0), b2, voffB); PG8_STAGE(PG8_SB(0, 1), b2 + hstep, voffB); PG8_STAGE(PG8_SA(0, 0), a2, voffA);
            PG8_WAIT_V(8); PG8_WAIT_L(0); PG8_BAR; PG8_MMA(1, 0, At, B0); PG8_MMA(1, 1, At, B1); PG8_BAR; PG8_SCHED;
            PG8_LDB(B0, 1, 0); PG8_LDB(B1, 1, 1); PG8_SCHED; PG8_LDA(At, 1, 0); PG8_STAGE(PG8_SA(0, 1), a2 + hstep, voffA);
            PG8_WAIT_V(8); PG8_WAIT_L(0); PG8_BAR; PG8_MMA(0, 0, At, B0); PG8_MMA(0, 1, At, B1); PG8_BAR; PG8_SCHED;
            PG8_LDA(At, 1, 1); PG8_STAGE(PG8_SB(1, 0), b3, voffB); PG8_STAGE(PG8_SB(1, 1), b3 + hstep, voffB); PG8_STAGE(PG8_SA(1, 0), a3, voffA);
            PG8_WAIT_V(8); PG8_WAIT_L(0); PG8_BAR; PG8_MMA(1, 0, At, B0); PG8_MMA(1, 1, At, B1); PG8_BAR; PG8_SCHED;
            } else {
            PG8_LDB(B0, 0, 0); PG8_SCHED; PG8_LDA(At, 0, 0); PG8_STAGE(PG8_SA(1, 1), a1 + hstep, voffA);
            PG8_WAIT_L(8); PG8_BAR; PG8_WAIT_L(0); PG8_MMA(0, 0, At, B0); PG8_BAR; PG8_SCHED;
            PG8_LDB(B1, 0, 1); PG8_STAGE(PG8_SB(0, 0), b2, voffB);
            PG8_BAR; PG8_WAIT_L(0); PG8_MMA(0, 1, At, B1); PG8_BAR;
            PG8_LDA(At, 0, 1); PG8_STAGE(PG8_SA(0, 0), a2, voffA);
            PG8_BAR; PG8_WAIT_L(0); PG8_MMA(1, 0, At, B0); PG8_BAR; PG8_SCHED;
            PG8_STAGE(PG8_SB(0, 1), b2 + hstep, voffB);
            PG8_WAIT_V(6); PG8_BAR; PG8_MMA(1, 1, At, B1); PG8_BAR;
            PG8_LDB(B0, 1, 0); PG8_SCHED; PG8_LDA(At, 1, 0); PG8_STAGE(PG8_SA(0, 1), a2 + hstep, voffA);
            PG8_WAIT_L(8); PG8_BAR; PG8_WAIT_L(0); PG8_MMA(0, 0, At, B0); PG8_BAR; PG8_SCHED;
            PG8_LDB(B1, 1, 1); PG8_STAGE(PG8_SB(1, 0), b3, voffB);
            PG8_BAR; PG8_WAIT_L(0); PG8_MMA(0, 1, At, B1); PG8_BAR;
            PG8_LDA(At, 1, 1); PG8_STAGE(PG8_SA(1, 0), a3, voffA);
            PG8_BAR; PG8_WAIT_L(0); PG8_MMA(1, 0, At, B0); PG8_BAR; PG8_SCHED;
            PG8_STAGE(PG8_SB(1, 1), b3 + hstep, voffB);
            PG8_WAIT_V(6); PG8_BAR; PG8_MMA(1, 1, At, B1); PG8_BAR;
            }
        }
        if constexpr (ALIGN_EPI) { if (wr == 0) PG8_BAR; }
        E(acc, cur, wr, wc, fr, fq); S.done(cur);
        if (!has_next) break;
#pragma unroll
        for (int a = 0; a < 2; ++a)
#pragma unroll
            for (int b = 0; b < 2; ++b)
#pragma unroll
                for (int m = 0; m < 4; ++m)
#pragma unroll
                    for (int n = 0; n < 2; ++n) acc[a][b][m][n] = (f32x4){0.f, 0.f, 0.f, 0.f};
        cur = nxt; cA = nA; cB = nB; ++ui;
        if constexpr (ALIGN_EPI) { if (wr == 1) PG8_BAR; }
    }
    PG8_WAIT_V(0);
    if constexpr (!ALIGN_EPI) { if (wr == 0) PG8_BAR; }
    PG8_BAR;
#undef PG8_SA
#undef PG8_SB
#undef PG8_STAGE
#undef PG8_LDA
#undef PG8_LDB
#undef PG8_MMA
#undef PG8_WAIT_V
#undef PG8_WAIT_L
#undef PG8_BAR
#undef PG8_SCHED
}

__device__ __forceinline__ void rows_rstd(const float* __restrict__ ssq, int row0, int fq, float (&rs)[2][4]) {
    f32x4 pp[2][4];
#pragma unroll
    for (int ai = 0; ai < 2; ++ai)
#pragma unroll
        for (int m = 0; m < 4; ++m) pp[ai][m] = *(const f32x4*)(ssq + (size_t)(row0 + ai * HALF + m * 16) * 16 + 4 * fq);
#pragma unroll
    for (int ai = 0; ai < 2; ++ai)
#pragma unroll
        for (int m = 0; m < 4; ++m) { float s = (pp[ai][m][0] + pp[ai][m][1]) + (pp[ai][m][2] + pp[ai][m][3]); s += __shfl_xor(s, 16); s += __shfl_xor(s, 32); rs[ai][m] = rsqrtf(s * (1.0f / 1024.0f) + EPS); }
}
__device__ __forceinline__ void rows_rstd_cached(const float* __restrict__ ssq, int row0, int fq, float (&rs)[2][4], bool hit, LAS float* cache, int lrow0, bool writer) {
    if (hit) {
#pragma unroll
        for (int ai = 0; ai < 2; ++ai)
#pragma unroll
            for (int m = 0; m < 4; ++m) rs[ai][m] = cache[lrow0 + ai * HALF + m * 16];
    } else {
        rows_rstd(ssq, row0, fq, rs);
        if (writer) {
#pragma unroll
            for (int ai = 0; ai < 2; ++ai)
#pragma unroll
                for (int m = 0; m < 4; ++m) cache[lrow0 + ai * HALF + m * 16] = rs[ai][m];
        }
    }
}
struct EpiZ {
    static constexpr bool PERM = true;
    bf16_t* Z; bf16_t* DEC; const float* ssq; LAS float* rsc; mutable int cached_pm;
    __device__ __forceinline__ void operator()(const f32x4 (&acc)[2][2][4][2], const Unit& u, int wr, int wc, int fr, int fq) const {
        const int row0 = u.pm * BM + wr * 64 + fr; const int pn = u.pn;
        float rsv[2][4]; rows_rstd_cached(ssq, row0, fq, rsv, u.pm == cached_pm, rsc, wr * 64 + fr, wc == 0 && fq == 0); cached_pm = u.pm;
#pragma unroll
        for (int ai = 0; ai < 2; ++ai)
#pragma unroll
            for (int m = 0; m < 4; ++m) {
                const int r = row0 + ai * HALF + m * 16; const float rs = rsv[ai][m];
                if (pn == 8) {
                    if (wc == 0) { const f32x4 v0 = acc[ai][0][m][0] * rs, v1 = acc[ai][0][m][1] * rs; u32x4 w; w.x = cvt_pk_bf16(v0[0], v0[1]); w.y = cvt_pk_bf16(v0[2], v0[3]); w.z = cvt_pk_bf16(v1[0], v1[1]); w.w = cvt_pk_bf16(v1[2], v1[3]); *(u32x4*)(DEC + (size_t)r * 32 + 8 * fq) = w; }
                } else {
                    bf16_t* rowp = Z + (size_t)r * ZW + pn * BM + wc * 32 + 8 * fq;
#pragma unroll
                    for (int bj = 0; bj < 2; ++bj) { f32x4 v0 = acc[ai][bj][m][0] * rs, v1 = acc[ai][bj][m][1] * rs;
                        if (pn >= 4 && pn < 6) {
#pragma unroll
                            for (int j = 0; j < 4; ++j) { v0[j] = silu_f(v0[j]); v1[j] = silu_f(v1[j]); } }
                        u32x4 w; w.x = cvt_pk_bf16(v0[0], v0[1]); w.y = cvt_pk_bf16(v0[2], v0[3]); w.z = cvt_pk_bf16(v1[0], v1[1]); w.w = cvt_pk_bf16(v1[2], v1[3]);
                        *(u32x4*)(rowp + bj * HALF) = w; }
                }
            }
    }
};
struct EpiH {
    static constexpr bool PERM = true;
    bf16_t* H; const float* ssq; LAS float* rsc; mutable int cached_pm;
    __device__ __forceinline__ void operator()(const f32x4 (&acc)[2][2][4][2], const Unit& u, int wr, int wc, int fr, int fq) const {
        const int row0 = u.pm * BM + wr * 64 + fr;
        float rsv[2][4]; rows_rstd_cached(ssq, row0, fq, rsv, u.pm == cached_pm, rsc, wr * 64 + fr, wc == 0 && fq == 0); cached_pm = u.pm;
#pragma unroll
        for (int ai = 0; ai < 2; ++ai)
#pragma unroll
            for (int m = 0; m < 4; ++m) {
                const int r = row0 + ai * HALF + m * 16; const float rs = rsv[ai][m];
                bf16_t* rowp = H + (size_t)r * FF + u.pn * BM + wc * 32 + 8 * fq;
#pragma unroll
                for (int bj = 0; bj < 2; ++bj) { f32x4 v0 = acc[ai][bj][m][0] * rs, v1 = acc[ai][bj][m][1] * rs;
#pragma unroll
                    for (int j = 0; j < 4; ++j) { const float a = fmaxf(v0[j], 0.f), b = fmaxf(v1[j], 0.f); v0[j] = a * a; v1[j] = b * b; }
                    u32x4 w; w.x = cvt_pk_bf16(v0[0], v0[1]); w.y = cvt_pk_bf16(v0[2], v0[3]); w.z = cvt_pk_bf16(v1[0], v1[1]); w.w = cvt_pk_bf16(v1[2], v1[3]);
                    *(u32x4*)(rowp + bj * HALF) = w; }
            }
    }
};
template <bool RD32>
__device__ __forceinline__ void res_rows(const float* __restrict__ xold32, const bf16_t* __restrict__ xoldb, bf16_t* __restrict__ xb, float* __restrict__ ssq, const f32x4 (&acc)[2][2][4][2], int row0, int col0, int slot) {
    f32x4 xo[2][2][2];
    float ssv[8];
    auto ld = [&](size_t o, f32x4& a, f32x4& b) { if (RD32) { a = *(const f32x4*)(xold32 + o); b = *(const f32x4*)(xold32 + o + 4); }
        else { const u32x4 w = *(const u32x4*)(xoldb + o); a = (f32x4){bflo(w.x), bfhi(w.x), bflo(w.y), bfhi(w.y)}; b = (f32x4){bflo(w.z), bfhi(w.z), bflo(w.w), bfhi(w.w)}; } };
#pragma unroll
    for (int bj = 0; bj < 2; ++bj) ld((size_t)row0 * D + col0 + bj * HALF, xo[0][bj][0], xo[0][bj][1]);
#pragma unroll
    for (int idx = 0; idx < 8; ++idx) {
        const int ai = idx >> 2, m = idx & 3; const int r = row0 + ai * HALF + m * 16; const size_t off = (size_t)r * D + col0;
        if (idx < 7) { const int ai2 = (idx + 1) >> 2, m2 = (idx + 1) & 3; const size_t off2 = (size_t)(row0 + ai2 * HALF + m2 * 16) * D + col0;
#pragma unroll
            for (int bj = 0; bj < 2; ++bj) ld(off2 + bj * HALF, xo[(idx + 1) & 1][bj][0], xo[(idx + 1) & 1][bj][1]); }
        float ss = 0.f;
#pragma unroll
        for (int bj = 0; bj < 2; ++bj) { const f32x4 x0 = xo[idx & 1][bj][0] + acc[ai][bj][m][0], x1 = xo[idx & 1][bj][1] + acc[ai][bj][m][1];
            u32x4 w; w.x = cvt_pk_bf16(x0[0], x0[1]); w.y = cvt_pk_bf16(x0[2], x0[3]); w.z = cvt_pk_bf16(x1[0], x1[1]); w.w = cvt_pk_bf16(x1[2], x1[3]);
            *(u32x4*)(xb + off + bj * HALF) = w;
            ss += ((x0[0] * x0[0] + x0[1] * x0[1]) + (x0[2] * x0[2] + x0[3] * x0[3])) + ((x1[0] * x1[0] + x1[1] * x1[1]) + (x1[2] * x1[2] + x1[3] * x1[3])); }
        ss += __shfl_xor(ss, 16); ss += __shfl_xor(ss, 32);
        ssv[idx] = ss;
    }
    const int fq = slot >> 6;
#pragma unroll
    for (int j = 0; j < 2; ++j) { const float v = fq == 0 ? ssv[j] : fq == 1 ? ssv[2 + j] : fq == 2 ? ssv[4 + j] : ssv[6 + j]; const int idx = 2 * fq + j;
        ssq[(size_t)(row0 + (idx >> 2) * HALF + (idx & 3) * 16) * 16 + (slot & 15)] = v; }
}
struct EpiRes {
    static constexpr bool PERM = true;
    const float* xold32; float* xout; bf16_t* xb; float* ssq; int mode;
    __device__ __forceinline__ void operator()(const f32x4 (&acc)[2][2][4][2], const Unit& u, int wr, int wc, int fr, int fq) const {
        const int row0 = u.pm * BM + wr * 64 + fr, col0 = u.pn * BM + wc * 32 + 8 * fq, slot = (u.pn * 4 + wc) | (fq << 6);
        if (mode == 0) res_rows<false>(xold32, xb, xb, ssq, acc, row0, col0, slot);
        else res_rows<true>(xold32, xb, xb, ssq, acc, row0, col0, slot);
    }
};
}

struct WTile { const float* src; bf16_t* dst; const float* g; int ldsrc, K, n0, k0, mode; };
__device__ __forceinline__ WTile wtile_desc(const Params& p, int it) {
    unsigned char* ws = p.ws; WTile t; const int l = it / 3008; int r = it % 3008;
    if (r < 704) { t.src = p.w_in + (size_t)l * D * D_IN; t.ldsrc = D_IN; t.dst = (bf16_t*)(ws + WS_WIN) + (size_t)l * ZW * D; t.K = D; t.n0 = (r / 16) * 64; t.k0 = (r % 16) * 64; t.g = p.norm_mix_g + l * D; t.mode = 0; }
    else if (r < 960) { r -= 704; t.src = p.w_out + (size_t)l * D * D; t.ldsrc = D; t.dst = (bf16_t*)(ws + WS_WOUT) + (size_t)l * D * D; t.K = D; t.n0 = (r / 16) * 64; t.k0 = (r % 16) * 64; t.g = nullptr; t.mode = 1; }
    else if (r < 1984) { r -= 960; t.src = p.w_mlp1 + (size_t)l * D * FF; t.ldsrc = FF; t.dst = (bf16_t*)(ws + WS_W1) + (size_t)l * FF * D; t.K = D; t.n0 = (r / 16) * 64; t.k0 = (r % 16) * 64; t.g = p.norm_mlp_g + l * D; t.mode = 1; }
    else { r -= 1984; t.src = p.w_mlp2 + (size_t)l * FF * D; t.ldsrc = D; t.dst = (bf16_t*)(ws + WS_W2) + (size_t)l * D * FF; t.K = FF; t.n0 = (r / 64) * 64; t.k0 = (r % 64) * 64; t.g = nullptr; t.mode = 1; }
    return t;
}
__device__ __forceinline__ void wtile_load(const WTile& w, int t, f32x4& a, f32x4& b, float& rsc) {
    const int kk = t >> 3, ns = (t & 7) * 8; const int nd = w.n0 + ns; int nsrc = nd; bool valid = true; float cs = 1.0f;
    if (w.mode == 0) { if (nd < 1536) nsrc = nd; else if (nd < 2048) nsrc = nd + 32; else if (nd < 2080) nsrc = nd - 512; else if (nd < 2304) valid = false; else nsrc = nd - 224; if (nd < 256) cs = 0.125f; }
    a = (f32x4){0.f, 0.f, 0.f, 0.f}; b = a;
    if (valid) { const float* sp = w.src + (size_t)(w.k0 + kk) * w.ldsrc + nsrc; a = *(const f32x4*)sp; b = *(const f32x4*)(sp + 4); }
    rsc = (w.g ? w.g[w.k0 + kk] : 1.0f) * cs;
}

PHASE_FN void phase_prep(const Params& p, float* ldsf) {
    unsigned char* ws = p.ws;
    const int G = gridDim.x, bx = blockIdx.x; int tid = threadIdx.x; asm volatile("" : "+v"(tid));
    { const int NT = DEPTH * 3008; int it = bx, buf = 0; f32x4 a, b; float rsc;
      WTile cur = wtile_desc(p, it < NT ? it : 0);
      if (it < NT) wtile_load(cur, tid, a, b, rsc);
      for (; it < NT; it += G, buf ^= 1) {
          float* tile = ldsf + buf * (64 * 65);
          { const int kk = tid >> 3, ns = (tid & 7) * 8; float* tp = tile + kk * 65 + ns;
#pragma unroll
            for (int j = 0; j < 4; ++j) { tp[j] = a[j] * rsc; tp[4 + j] = b[j] * rsc; } }
          const WTile w = cur;
          if (it + G < NT) { cur = wtile_desc(p, it + G); wtile_load(cur, tid, a, b, rsc); }
          asm volatile("s_waitcnt lgkmcnt(0)" ::: "memory"); __builtin_amdgcn_s_barrier(); asm volatile("" ::: "memory");
          { const int nn = tid >> 3, ks = (tid & 7) * 8; float v[8];
#pragma unroll
            for (int i = 0; i < 8; ++i) v[i] = tile[(ks + i) * 65 + nn];
            u32x4 o; o.x = cvt_pk_bf16(v[0], v[1]); o.y = cvt_pk_bf16(v[2], v[3]); o.z = cvt_pk_bf16(v[4], v[5]); o.w = cvt_pk_bf16(v[6], v[7]);
            *(u32x4*)(w.dst + (size_t)(w.n0 + nn) * w.K + w.k0 + ks) = o; }
      }
      __syncthreads(); }
    { bf16_t* wsb = (bf16_t*)(ws + WS_WSB);
      for (int i = (bx * 512 + tid) * 4; i < DEPTH * 4 * 128 * 128; i += G * 512 * 4) { const f32x4 v = *(const f32x4*)(p.w_s + i); u32x2 w; w.x = cvt_pk_bf16(v[0], v[1]); w.y = cvt_pk_bf16(v[2], v[3]); *(u32x2*)(wsb + i) = w; } }
    { bf16_t* xb = (bf16_t*)(ws + WS_XB); float* ssq = (float*)(ws + WS_SSQ); const int wid = tid >> 6, lane = tid & 63;
      for (int r = bx * 8 + wid; r < T; r += G * 8) { const float* xr = p.x + (size_t)r * D; float ss = 0.f;
#pragma unroll
          for (int i = 0; i < 4; ++i) { const int c = i * 256 + lane * 4; const f32x4 v = *(const f32x4*)(xr + c); ss += (v[0] * v[0] + v[1] * v[1]) + (v[2] * v[2] + v[3] * v[3]);
              u32x2 w; w.x = cvt_pk_bf16(v[0], v[1]); w.y = cvt_pk_bf16(v[2], v[3]); *(u32x2*)(xb + (size_t)r * D + c) = w; }
#pragma unroll
          for (int o = 32; o >= 1; o >>= 1) ss += __shfl_xor(ss, o);
          if (lane < 16) ssq[(size_t)r * 16 + lane] = lane == 0 ? ss : 0.f; } }
}

constexpr int GP = 72;
constexpr int VP = 132;
#define ROT(row, col) (((col) + 16 * ((row) >> 4)) & 63)
constexpr int L_QIN = 0, L_KIN = 9216, L_QOUT = 18432, L_KOUTT = 27648;
constexpr int L_DEC = 36864;
constexpr int L_RED = L_DEC + 256;
constexpr int L_QRAW = L_RED + 1024;
constexpr int L_KRAW = L_QRAW + 8192;
constexpr int L_ARAW = L_KRAW + 8192;
constexpr int L_VRAW = L_ARAW + 2048;
static_assert(L_VRAW + 64 * VP * 2 <= 131072, "GLA LDS map");

__device__ __forceinline__ float logsig2(float d) {
    const float e = __builtin_amdgcn_exp2f(d * -1.44269504089f);
    return __builtin_amdgcn_logf(1.0f + e) * -0.0625f;
}
#define GLA_BAR() do { asm volatile("s_waitcnt lgkmcnt(0)" ::: "memory"); __builtin_amdgcn_s_barrier(); asm volatile("" ::: "memory"); } while (0)
#define CHUNK(si) (dir ? 63 - (si) : (si))
#define POS(r) (dir ? 63 - (r) : (r))

struct GlaRegs { u32x4 q0, q1, k0, k1, a, v0, v1, v2, v3; };
struct GlaPrepCtx {
    const bf16_t* Z; const bf16_t* DEC; unsigned* myflag; unsigned* paflag;
    bf16_t* qin; bf16_t* kin; bf16_t* qout; bf16_t* koutT; float* decs; bf16_t* qraw; bf16_t* kraw; bf16_t* araw; bf16_t* vraw;
    int tid, wid, lr, q4, b, h, dir, lrow, lcs, vrow, vcs, arow, acs, ch; bf16x8 w2f; float bias;
};
#define ST8_(pp, v) do { *(u32x2*)(pp) = (u32x2){(v).x, (v).y}; *(u32x2*)((pp) + 4) = (u32x2){(v).z, (v).w}; } while (0)
__device__ __forceinline__ void gla_load_qka(const GlaPrepCtx& c, int si, GlaRegs& R) {
    const int dir = c.dir; const size_t t0 = (size_t)(c.b * SEQ + CHUNK(si) * 64); const bf16_t* zr = c.Z + (t0 + c.lrow) * ZW + c.h * 64 + c.lcs;
    R.q0 = *(const u32x4*)(zr + ZQ); R.k0 = *(const u32x4*)(zr + ZK); R.q1 = *(const u32x4*)(zr + (size_t)32 * ZW + ZQ); R.k1 = *(const u32x4*)(zr + (size_t)32 * ZW + ZK);
    if (c.tid < 128) R.a = *(const u32x4*)(c.DEC + (t0 + c.arow) * 32 + dir * 16 + c.acs);
}
__device__ __forceinline__ void gla_load_v(const GlaPrepCtx& c, int si, GlaRegs& R) {
    const int dir = c.dir; const size_t t0 = (size_t)(c.b * SEQ + CHUNK(si) * 64); const bf16_t* vr = c.Z + (t0 + c.vrow) * ZW + ZV + c.h * 128 + c.vcs;
    R.v0 = *(const u32x4*)vr; R.v1 = *(const u32x4*)(vr + (size_t)16 * ZW); R.v2 = *(const u32x4*)(vr + (size_t)32 * ZW); R.v3 = *(const u32x4*)(vr + (size_t)48 * ZW);
}
__device__ __forceinline__ void gla_store_qka(const GlaPrepCtx& c, const GlaRegs& R) {
    const int dir = c.dir; const int r0_ = POS(c.lrow), r1_ = POS(c.lrow + 32);
    *(u32x4*)(c.qraw + r0_ * 64 + ROT(r0_, c.lcs)) = R.q0; *(u32x4*)(c.kraw + r0_ * 64 + ROT(r0_, c.lcs)) = R.k0; *(u32x4*)(c.qraw + r1_ * 64 + ROT(r1_, c.lcs)) = R.q1; *(u32x4*)(c.kraw + r1_ * 64 + ROT(r1_, c.lcs)) = R.k1;
    if (c.tid < 128) *(u32x4*)(c.araw + POS(c.arow) * 16 + c.acs) = R.a;
}
__device__ __forceinline__ void gla_store_v(const GlaPrepCtx& c, const GlaRegs& R) {
    const int dir = c.dir;
    ST8_(c.vraw + POS(c.vrow) * VP + c.vcs, R.v0); ST8_(c.vraw + POS(c.vrow + 16) * VP + c.vcs, R.v1); ST8_(c.vraw + POS(c.vrow + 32) * VP + c.vcs, R.v2); ST8_(c.vraw + POS(c.vrow + 48) * VP + c.vcs, R.v3);
}
__device__ __forceinline__ void gla_prep_step(const GlaPrepCtx& c, int s, GlaRegs& LD, GlaRegs& ST) {
    const int wid = c.wid, lr = c.lr, q4 = c.q4, ch = c.ch, tid = c.tid;
    if (s == 32) {
        if (wid == 0) { while (__hip_atomic_load(c.paflag, __ATOMIC_RELAXED, __HIP_MEMORY_SCOPE_AGENT) == 0u) __builtin_amdgcn_s_sleep(4);
            __builtin_amdgcn_fence(__ATOMIC_ACQUIRE, "agent"); asm volatile("s_waitcnt vmcnt(0)" ::: "memory"); }
        __syncthreads();
    }
    if (s + 3 < 64) gla_load_qka(c, s + 3, LD);
    if (s + 2 < 64) gla_load_v(c, s + 2, LD);
    unsigned rq[8], rk[8], ro[8], rko[8]; float rdec = 0.f;
    if (s < 63) {
        float la[16];
#pragma unroll
        for (int cb = 0; cb < 4; ++cb) { const int pr = 16 * (lr >> 2) + 4 * cb + (lr & 3);
            u32x4 aw = (u32x4){0u, 0u, 0u, 0u}; if (q4 < 2) aw = *(const u32x4*)(c.araw + pr * 16 + 8 * q4);
            f32x4 d = (f32x4){c.bias, c.bias, c.bias, c.bias};
            d = __builtin_amdgcn_mfma_f32_16x16x32_bf16(__builtin_bit_cast(bf16x8, aw), c.w2f, d, 0, 0, 0);
#pragma unroll
            for (int jj = 0; jj < 4; ++jj) la[4 * cb + jj] = logsig2(d[jj]); }
#pragma unroll
        for (int i = 1; i < 16; ++i) la[i] += la[i - 1];
        const float tq = la[15]; float inc = tq;
        { const float t1 = __shfl_up(inc, 16); if (q4 >= 1) inc += t1; const float t2 = __shfl_up(inc, 32); if (q4 >= 2) inc += t2; }
        const float off = inc - tq;
        const float tot = __shfl(inc, lr + 48);
        const float bmid = __shfl(off + la[0], lr + 32);
        const float emid = __builtin_amdgcn_exp2f(bmid), etm = __builtin_amdgcn_exp2f(tot - bmid);
        rdec = __builtin_amdgcn_exp2f(tot);
        const int chr = (ch + 16 * q4) & 63;
#pragma unroll
        for (int i = 0; i < 16; i += 2) {
            const int p0 = 16 * q4 + i;
            const float x0 = off + la[i] - bmid, x1 = off + la[i + 1] - bmid;
            const float e10 = __builtin_amdgcn_exp2f(x0), e20 = __builtin_amdgcn_exp2f(-x0), e11 = __builtin_amdgcn_exp2f(x1), e21 = __builtin_amdgcn_exp2f(-x1);
            const float q0 = bf2f(c.qraw[p0 * 64 + chr]) * e10, q1 = bf2f(c.qraw[(p0 + 1) * 64 + chr]) * e11;
            const float k0 = bf2f(c.kraw[p0 * 64 + chr]) * e20, k1 = bf2f(c.kraw[(p0 + 1) * 64 + chr]) * e21;
            rq[i >> 1] = cvt_pk_bf16(q0, q1); rk[i >> 1] = cvt_pk_bf16(k0, k1); ro[i >> 1] = cvt_pk_bf16(q0 * emid, q1 * emid); rko[i >> 1] = cvt_pk_bf16(k0 * etm, k1 * etm);
        }
    }
    GLA_BAR();
    if (s < 63) {
        const int chr = (ch + 16 * q4) & 63;
#pragma unroll
        for (int i = 0; i < 8; ++i) { const int p0 = 16 * q4 + 2 * i;
            c.qin[p0 * GP + chr] = (bf16_t)(rq[i] & 0xffffu); c.qin[(p0 + 1) * GP + chr] = (bf16_t)(rq[i] >> 16);
            c.kin[p0 * GP + chr] = (bf16_t)(rk[i] & 0xffffu); c.kin[(p0 + 1) * GP + chr] = (bf16_t)(rk[i] >> 16);
            c.qout[p0 * GP + chr] = (bf16_t)(ro[i] & 0xffffu); c.qout[(p0 + 1) * GP + chr] = (bf16_t)(ro[i] >> 16); }
        *(u32x4*)(c.koutT + ch * GP + 16 * q4) = (u32x4){rko[0], rko[1], rko[2], rko[3]}; *(u32x4*)(c.koutT + ch * GP + 16 * q4 + 8) = (u32x4){rko[4], rko[5], rko[6], rko[7]};
        if (q4 == 0) c.decs[ch] = rdec;
    }
    if (s + 2 < 64) gla_store_qka(c, ST);
    if (s + 1 < 64) gla_store_v(c, ST);
    if (s == 31) {
        asm volatile("s_waitcnt vmcnt(0)" ::: "memory"); __syncthreads();
        if (tid == 0) { __builtin_amdgcn_fence(__ATOMIC_RELEASE, "agent"); asm volatile("s_waitcnt vmcnt(0)" ::: "memory"); __hip_atomic_store(c.myflag, 1u, __ATOMIC_RELAXED, __HIP_MEMORY_SCOPE_AGENT); }
    }
    GLA_BAR();
}

__device__ __forceinline__ void gla_prep(const Params& p, unsigned char* lds, int l, int item, int tid) {
    unsigned char* ws = p.ws;
    GlaPrepCtx c;
    c.tid = tid; c.wid = __builtin_amdgcn_readfirstlane(tid >> 6); const int lane = tid & 63; c.lr = lane & 15; c.q4 = lane >> 4;
    c.b = item >> 3; c.h = (item >> 1) & 3; c.dir = item & 1; const int dir = c.dir;
    c.Z = (const bf16_t*)(ws + WS_Z); c.DEC = (const bf16_t*)(ws + WS_DEC);
    unsigned* flags = (unsigned*)(ws + WS_CTL);
    c.myflag = flags + (size_t)(l * 128 + item) * 64; c.paflag = flags + (size_t)(l * 128 + (item ^ 1)) * 64;
    c.qin = (bf16_t*)(lds + L_QIN); c.kin = (bf16_t*)(lds + L_KIN); c.qout = (bf16_t*)(lds + L_QOUT); c.koutT = (bf16_t*)(lds + L_KOUTT);
    c.decs = (float*)(lds + L_DEC);
    c.qraw = (bf16_t*)(lds + L_QRAW); c.kraw = (bf16_t*)(lds + L_KRAW); c.araw = (bf16_t*)(lds + L_ARAW); c.vraw = (bf16_t*)(lds + L_VRAW);
    c.lrow = tid >> 3; c.lcs = (tid & 7) * 8; c.vrow = tid >> 4; c.vcs = (tid & 15) * 8; c.arow = tid >> 1; c.acs = (tid & 1) * 8;
    c.ch = 16 * c.wid + c.lr;
    { const float* w2 = (dir ? p.w_a2_bwd : p.w_a2_fwd) + (size_t)l * 16 * 256 + c.h * 64 + c.ch; u32x4 w = (u32x4){0u, 0u, 0u, 0u};
      if (c.q4 < 2) { float t[8];
#pragma unroll
          for (int i = 0; i < 8; ++i) t[i] = w2[(8 * c.q4 + i) * 256];
          w.x = cvt_pk_bf16(t[0], t[1]); w.y = cvt_pk_bf16(t[2], t[3]); w.z = cvt_pk_bf16(t[4], t[5]); w.w = cvt_pk_bf16(t[6], t[7]); }
      c.w2f = __builtin_bit_cast(bf16x8, w); c.bias = (dir ? p.b_a_bwd : p.b_a_fwd)[l * 256 + c.h * 64 + c.ch]; }
    GlaRegs RA, RB;
    gla_load_qka(c, 0, RA); gla_store_qka(c, RA);
    gla_load_qka(c, 1, RB); gla_load_v(c, 0, RB);
    GLA_BAR();
    for (int s = -1; s < 63; s += 2) { gla_prep_step(c, s, RA, RB); gla_prep_step(c, s + 1, RB, RA); }
    gla_prep_step(c, 63, RA, RB);
}
#undef ST8_

__device__ __forceinline__ void gla_mma(const Params& p, unsigned char* lds, int l, int item, int tid) {
    unsigned char* ws = p.ws;
    const int wid = __builtin_amdgcn_readfirstlane(tid >> 6), lane = tid & 63, lr = lane & 15, q4 = lane >> 4;
    const int b = item >> 3, h = (item >> 1) & 3, dir = item & 1;
    const bf16_t* Z = (const bf16_t*)(ws + WS_Z); bf16_t* OX = (bf16_t*)(ws + WS_OX); bf16_t* MIX = (bf16_t*)(ws + WS_MIX);
    const bf16_t* qin = (const bf16_t*)(lds + L_QIN); const bf16_t* kin = (const bf16_t*)(lds + L_KIN); const bf16_t* qout = (const bf16_t*)(lds + L_QOUT); const bf16_t* koutT = (const bf16_t*)(lds + L_KOUTT);
    const float* decs = (const float*)(lds + L_DEC); float* red = (float*)(lds + L_RED); const bf16_t* vraw = (const bf16_t*)(lds + L_VRAW);
    const int vq = wid & 3;
    const int ocol = h * 128 + 32 * vq + 8 * q4;
    f32x4 ng[2];
#pragma unroll
    for (int vb = 0; vb < 2; ++vb) ng[vb] = *(const f32x4*)(p.gla_norm_g + (size_t)l * 512 + ocol + 4 * vb);
    f32x4 accS[2][4];
#pragma unroll
    for (int vb = 0; vb < 2; ++vb)
#pragma unroll
        for (int i = 0; i < 4; ++i) accS[vb][i] = (f32x4){0.f, 0.f, 0.f, 0.f};
    GLA_BAR();
    for (int s = -1; s < 64; ++s) {
        const int tok0 = b * SEQ + CHUNK(s < 0 ? 0 : s) * 64;
#define TOK(c) (tok0 + (dir ? 63 - (c) : (c)))
        if (s == 32) __syncthreads();
        f32x4 accO[2][4]; u32x4 gw[4];
        if (s >= 0) {
            u32x4 ox[4];
            bf16x8 vfrag[2][2];
#pragma unroll
            for (int vb = 0; vb < 2; ++vb)
#pragma unroll
                for (int pp = 0; pp < 2; ++pp)
#pragma unroll
                    for (int i = 0; i < 8; ++i) { const int pos = 32 * pp + 4 * q4 + (i & 3) + ((i >> 2) << 4); vfrag[vb][pp][i] = (short)vraw[pos * VP + 32 * vq + 8 * (lr >> 2) + 4 * vb + (lr & 3)]; }
            bf16x8 qf[4][2], kf[4][2];
#pragma unroll
            for (int cb = 0; cb < 4; ++cb) { qf[cb][0] = *(const bf16x8*)(qin + (16 * cb + lr) * GP + ((8 * q4 + 16 * cb) & 63)); qf[cb][1] = *(const bf16x8*)(qin + (16 * cb + lr) * GP + ((32 + 8 * q4 + 16 * cb) & 63));
                kf[cb][0] = *(const bf16x8*)(kin + (16 * cb + lr) * GP + ((8 * q4 + 16 * cb) & 63)); kf[cb][1] = *(const bf16x8*)(kin + (16 * cb + lr) * GP + ((32 + 8 * q4 + 16 * cb) & 63)); }
            bf16x8 P0[4], P1[2];
            {
                f32x4 sc[4][4];
#pragma unroll
                for (int cb = 0; cb < 4; ++cb)
#pragma unroll
                    for (int jb = 0; jb < 4; ++jb) {
                        if (jb > cb) { sc[jb][cb] = (f32x4){0.f, 0.f, 0.f, 0.f}; continue; }
                        f32x4 a = (f32x4){0.f, 0.f, 0.f, 0.f};
                        a = __builtin_amdgcn_mfma_f32_16x16x32_bf16(kf[jb][0], qf[cb][0], a, 0, 0, 0);
                        sc[jb][cb] = a;
                    }
#pragma unroll
                for (int cb = 0; cb < 4; ++cb)
#pragma unroll
                    for (int jb = 0; jb <= cb; ++jb) sc[jb][cb] = __builtin_amdgcn_mfma_f32_16x16x32_bf16(kf[jb][1], qf[cb][1], sc[jb][cb], 0, 0, 0);
            __builtin_amdgcn_sched_barrier(0);
            if (s >= 32) {
#pragma unroll
                for (int cb = 0; cb < 4; ++cb) { const size_t tk = (size_t)TOK(16 * cb + lr); ox[cb] = *(const u32x4*)(OX + tk * 512 + ocol); gw[cb] = *(const u32x4*)(Z + tk * ZW + ZG + ocol); }
            }
#pragma unroll
                for (int cb = 0; cb < 4; ++cb) {
#pragma unroll
                    for (int jj = 0; jj < 4; ++jj) { const int j = 4 * q4 + jj; const bool keep = dir ? (lr > j) : (lr >= j); sc[cb][cb][jj] = keep ? sc[cb][cb][jj] : 0.f; }
                    { u32x4 w; w.x = cvt_pk_bf16(sc[0][cb][0], sc[0][cb][1]); w.y = cvt_pk_bf16(sc[0][cb][2], sc[0][cb][3]); w.z = cvt_pk_bf16(sc[1][cb][0], sc[1][cb][1]); w.w = cvt_pk_bf16(sc[1][cb][2], sc[1][cb][3]); P0[cb] = __builtin_bit_cast(bf16x8, w); }
                    if (cb >= 2) { u32x4 w; w.x = cvt_pk_bf16(sc[2][cb][0], sc[2][cb][1]); w.y = cvt_pk_bf16(sc[2][cb][2], sc[2][cb][3]); w.z = cvt_pk_bf16(sc[3][cb][0], sc[3][cb][1]); w.w = cvt_pk_bf16(sc[3][cb][2], sc[3][cb][3]); P1[cb - 2] = __builtin_bit_cast(bf16x8, w); }
                }
            }
            bf16x8 qo[4][2];
#pragma unroll
            for (int cb = 0; cb < 4; ++cb)
#pragma unroll
                for (int pp = 0; pp < 2; ++pp) { const bf16_t* qr = qout + (16 * cb + lr) * GP; const u32x2 lo = *(const u32x2*)(qr + ((32 * pp + 4 * q4 + 16 * cb) & 63)), hi = *(const u32x2*)(qr + ((32 * pp + 4 * q4 + 16 + 16 * cb) & 63)); qo[cb][pp] = __builtin_bit_cast(bf16x8, ((u32x4){lo.x, lo.y, hi.x, hi.y})); }
            bf16x8 Sp[2][2];
#pragma unroll
            for (int vb = 0; vb < 2; ++vb)
#pragma unroll
                for (int pp = 0; pp < 2; ++pp) { u32x4 w; w.x = cvt_pk_bf16(accS[vb][2 * pp][0], accS[vb][2 * pp][1]); w.y = cvt_pk_bf16(accS[vb][2 * pp][2], accS[vb][2 * pp][3]);
                    w.z = cvt_pk_bf16(accS[vb][2 * pp + 1][0], accS[vb][2 * pp + 1][1]); w.w = cvt_pk_bf16(accS[vb][2 * pp + 1][2], accS[vb][2 * pp + 1][3]); Sp[vb][pp] = __builtin_bit_cast(bf16x8, w); }
#pragma unroll
            for (int cb = 0; cb < 4; ++cb)
#pragma unroll
                for (int vb = 0; vb < 2; ++vb) {
                    f32x4 a = (f32x4){0.f, 0.f, 0.f, 0.f};
                    a = __builtin_amdgcn_mfma_f32_16x16x32_bf16(Sp[vb][0], qo[cb][0], a, 0, 0, 0);
                    accO[vb][cb] = a; }
#pragma unroll
            for (int cb = 0; cb < 4; ++cb)
#pragma unroll
                for (int vb = 0; vb < 2; ++vb) accO[vb][cb] = __builtin_amdgcn_mfma_f32_16x16x32_bf16(Sp[vb][1], qo[cb][1], accO[vb][cb], 0, 0, 0);
#pragma unroll
            for (int cb = 0; cb < 4; ++cb)
#pragma unroll
                for (int vb = 0; vb < 2; ++vb) accO[vb][cb] = __builtin_amdgcn_mfma_f32_16x16x32_bf16(vfrag[vb][0], P0[cb], accO[vb][cb], 0, 0, 0);
#pragma unroll
            for (int cb = 2; cb < 4; ++cb)
#pragma unroll
                for (int vb = 0; vb < 2; ++vb) accO[vb][cb] = __builtin_amdgcn_mfma_f32_16x16x32_bf16(vfrag[vb][1], P1[cb - 2], accO[vb][cb], 0, 0, 0);
            __builtin_amdgcn_sched_barrier(0);
            bf16x8 ko[4][2]; f32x4 dv[4];
#pragma unroll
            for (int kb = 0; kb < 4; ++kb) { dv[kb] = *(const f32x4*)(decs + 16 * kb + 4 * q4);
#pragma unroll
                for (int pp = 0; pp < 2; ++pp) { const bf16_t* kp = koutT + (16 * kb + lr) * GP + 32 * pp + 4 * q4; const u32x2 lo = *(const u32x2*)kp, hi = *(const u32x2*)(kp + 16); ko[kb][pp] = __builtin_bit_cast(bf16x8, ((u32x4){lo.x, lo.y, hi.x, hi.y})); } }
#pragma unroll
            for (int kb = 0; kb < 4; ++kb)
#pragma unroll
                for (int vb = 0; vb < 2; ++vb) accS[vb][kb] = __builtin_amdgcn_mfma_f32_16x16x32_bf16(ko[kb][0], vfrag[vb][0], accS[vb][kb] * dv[kb], 0, 0, 0);
#pragma unroll
            for (int kb = 0; kb < 4; ++kb)
#pragma unroll
                for (int vb = 0; vb < 2; ++vb) accS[vb][kb] = __builtin_amdgcn_mfma_f32_16x16x32_bf16(ko[kb][1], vfrag[vb][1], accS[vb][kb], 0, 0, 0);
            if (s < 32) {
#pragma unroll
                for (int cb = 0; cb < 4; ++cb) { const f32x4 o0 = accO[0][cb], o1 = accO[1][cb]; *(u32x4*)(OX + (size_t)TOK(16 * cb + lr) * 512 + ocol) = (u32x4){cvt_pk_bf16(o0[0], o0[1]), cvt_pk_bf16(o0[2], o0[3]), cvt_pk_bf16(o1[0], o1[1]), cvt_pk_bf16(o1[2], o1[3])}; }
            } else {
#pragma unroll
                for (int cb = 0; cb < 4; ++cb) { float ss = 0.f;
#pragma unroll
                    for (int vb = 0; vb < 2; ++vb) { const unsigned xa = vb ? ox[cb].z : ox[cb].x, xb2 = vb ? ox[cb].w : ox[cb].y; accO[vb][cb] += (f32x4){bflo(xa), bfhi(xa), bflo(xb2), bfhi(xb2)}; const f32x4 o = accO[vb][cb]; ss += (o[0] * o[0] + o[1] * o[1]) + (o[2] * o[2] + o[3] * o[3]); }
                    ss += __shfl_xor(ss, 16); ss += __shfl_xor(ss, 32);
                    if (q4 == 0) red[vq * 64 + 16 * cb + lr] = ss; }
            }
        }
        GLA_BAR();
        if (s >= 32) {
#pragma unroll
            for (int cb = 0; cb < 4; ++cb) { const float ss = (red[16 * cb + lr] + red[64 + 16 * cb + lr]) + (red[128 + 16 * cb + lr] + red[192 + 16 * cb + lr]);
                const float rs = rsqrtf(ss * (1.0f / 128.0f) + EPS); const size_t tk = (size_t)TOK(16 * cb + lr);
                const f32x4 o0 = accO[0][cb] * rs * ng[0], o1 = accO[1][cb] * rs * ng[1]; const u32x4 g4 = gw[cb];
                u32x4 w; w.x = cvt_pk_bf16(o0[0] * bflo(g4.x), o0[1] * bfhi(g4.x)); w.y = cvt_pk_bf16(o0[2] * bflo(g4.y), o0[3] * bfhi(g4.y)); w.z = cvt_pk_bf16(o1[0] * bflo(g4.z), o1[1] * bfhi(g4.z)); w.w = cvt_pk_bf16(o1[2] * bflo(g4.w), o1[3] * bfhi(g4.w));
                *(u32x4*)(MIX + tk * D + ocol) = w; }
        }
        if (s == 31) { asm volatile("s_waitcnt vmcnt(0)" ::: "memory"); __syncthreads(); }
        GLA_BAR();
#undef TOK
    }
}
#undef CHUNK
#undef POS

PHASE_FN void gla_item(const Params& p, unsigned char* lds, int l, int item) {
    int tid = threadIdx.x; asm volatile("" : "+v"(tid));
    if (tid < 256) gla_prep(p, lds, l, item, tid); else gla_mma(p, lds, l, item, tid);
    __syncthreads();
}

constexpr int SP = 136;
constexpr int L_SW = 0;
constexpr int L_SV0 = 128 * SP * 2;
constexpr int L_SV1 = 2 * 128 * SP * 2;
PHASE_FN void sgu_block(const Params& p, unsigned char* lds, int l, int g, int ch0, int nch) {
    unsigned char* ws = p.ws;
    int tid = threadIdx.x; asm volatile("" : "+v"(tid));
    const int wid = __builtin_amdgcn_readfirstlane(tid >> 6), lane = tid & 63, lr = lane & 15, q4 = lane >> 4;
    const bf16_t* __restrict__ Z = (const bf16_t*)(ws + WS_Z); bf16_t* __restrict__ MIX = (bf16_t*)(ws + WS_MIX);
    const bf16_t* __restrict__ wsb = (const bf16_t*)(ws + WS_WSB) + (size_t)(l * 4 + g) * 128 * 128;
    bf16_t* wl = (bf16_t*)(lds + L_SW);
    const int lrow = tid >> 4, cs = (tid & 15) * 8;
#pragma unroll
    for (int i = 0; i < 4; ++i) *(u32x4*)(wl + (lrow + 32 * i) * SP + cs) = *(const u32x4*)(wsb + (size_t)(lrow + 32 * i) * 128 + cs);
    const float* ngp = p.sgu_norm_g + (size_t)l * 512 + g * 128 + cs; const f32x4 g0 = *(const f32x4*)ngp, g1 = *(const f32x4*)(ngp + 4);
    float bs[8];
#pragma unroll
    for (int pb = 0; pb < 8; ++pb) bs[pb] = p.b_s[(size_t)l * 512 + g * 128 + 16 * pb + lr];
    const int ocol = g * 128 + 16 * wid + 4 * q4;
    u32x4 pv[4];
#define SGU_LOAD(ch) do { _Pragma("unroll") for (int i = 0; i < 4; ++i) pv[i] = *(const u32x4*)(Z + (size_t)((ch) * 128 + lrow + 32 * i) * ZW + ZSV + g * 128 + cs); } while (0)
    SGU_LOAD(ch0);
    int buf = 0;
    for (int ch = ch0; ch < ch0 + nch; ++ch, buf ^= 1) {
        const int tok0 = ch * 128;
        bf16_t* vt = (bf16_t*)(lds + (buf ? L_SV1 : L_SV0));
#pragma unroll
        for (int i = 0; i < 4; ++i) { const u32x4 w = pv[i];
            float v[8];
            { const f32x2 a = gelu_pk((f32x2){bflo(w.x), bfhi(w.x)}), b2 = gelu_pk((f32x2){bflo(w.y), bfhi(w.y)}), c = gelu_pk((f32x2){bflo(w.z), bfhi(w.z)}), d = gelu_pk((f32x2){bflo(w.w), bfhi(w.w)});
              v[0] = a.x; v[1] = a.y; v[2] = b2.x; v[3] = b2.y; v[4] = c.x; v[5] = c.y; v[6] = d.x; v[7] = d.y; }
            float ss = 0.f;
#pragma unroll
            for (int k = 0; k < 8; ++k) ss += v[k] * v[k];
            ss += __shfl_xor(ss, 1); ss += __shfl_xor(ss, 2); ss += __shfl_xor(ss, 4); ss += __shfl_xor(ss, 8);
            const float rs = rsqrtf(ss * (1.0f / 128.0f) + EPS);
            u32x4 o; o.x = cvt_pk_bf16(v[0] * rs * g0[0], v[1] * rs * g0[1]); o.y = cvt_pk_bf16(v[2] * rs * g0[2], v[3] * rs * g0[3]);
            o.z = cvt_pk_bf16(v[4] * rs * g1[0], v[5] * rs * g1[1]); o.w = cvt_pk_bf16(v[6] * rs * g1[2], v[7] * rs * g1[3]);
            *(u32x4*)(vt + (lrow + 32 * i) * SP + cs) = o; }
        if (ch + 1 < ch0 + nch) SGU_LOAD(ch + 1);
        u32x2 uw[8];
#pragma unroll
        for (int pb = 0; pb < 8; ++pb) uw[pb] = *(const u32x2*)(Z + (size_t)(tok0 + 16 * pb + lr) * ZW + ZSU + ocol);
        asm volatile("s_waitcnt lgkmcnt(0)" ::: "memory"); __builtin_amdgcn_s_barrier(); asm volatile("" ::: "memory");
        bf16x8 af[4];
#pragma unroll
        for (int ks = 0; ks < 4; ++ks)
#pragma unroll
            for (int i = 0; i < 8; ++i) af[ks][i] = (short)vt[(32 * ks + 8 * q4 + i) * SP + 16 * wid + lr];
#pragma unroll
        for (int pb = 0; pb < 8; ++pb) {
            f32x4 a = (f32x4){0.f, 0.f, 0.f, 0.f};
#pragma unroll
            for (int ks = 0; ks < 4; ++ks) { const bf16x8 bf = *(const bf16x8*)(wl + (16 * pb + lr) * SP + 32 * ks + 8 * q4); a = __builtin_amdgcn_mfma_f32_16x16x32_bf16(af[ks], bf, a, 0, 0, 0); }
            const f32x2 u0 = gelu_pk((f32x2){bflo(uw[pb].x), bfhi(uw[pb].x)}), u1 = gelu_pk((f32x2){bflo(uw[pb].y), bfhi(uw[pb].y)});
            u32x2 w; w.x = cvt_pk_bf16((a[0] + bs[pb]) * u0.x, (a[1] + bs[pb]) * u0.y); w.y = cvt_pk_bf16((a[2] + bs[pb]) * u1.x, (a[3] + bs[pb]) * u1.y);
            *(u32x2*)(MIX + (size_t)(tok0 + 16 * pb + lr) * D + 512 + ocol) = w;
        }
    }
#undef SGU_LOAD
    __syncthreads();
}

#define XB_TMO      128
#define XB_XCNT(j)  (256  + 64 * (j))
#define XB_XSUB(j)  (1280 + 64 * (j))
#define XB_XGEN(j)  (2304 + 64 * (j))
#define XB_TOP      3328
#define XB_TOPGEN   3392
#define XCD_BAR_WORDS 3456
#define XB_SPIN_CAP (1u << 18)

__device__ __forceinline__ unsigned xb_ld(unsigned* p)              { return __hip_atomic_load(p, __ATOMIC_RELAXED, __HIP_MEMORY_SCOPE_AGENT); }
__device__ __forceinline__ unsigned xb_add(unsigned* p, unsigned v) { return __hip_atomic_fetch_add(p, v, __ATOMIC_RELAXED, __HIP_MEMORY_SCOPE_AGENT); }
__device__ __forceinline__ unsigned xb_xcc_id() { return (unsigned)__builtin_amdgcn_s_getreg((3 << 11) | 20) & 0xFu; }
#define XB_SPIN(cond, bar) do { unsigned _sp = 0; while (cond) { __builtin_amdgcn_s_sleep(1); \
    if ((++_sp & 255u) == 0u) { if (xb_ld(&(bar)[XB_TMO])) break; if (_sp > XB_SPIN_CAP) { atomicAdd(&(bar)[XB_TMO], 1u); break; } } } } while (0)

struct XcdBarrier {
    unsigned* bar; unsigned x;
    volatile LAS unsigned* st;
};

__device__ __forceinline__ XcdBarrier xcd_barrier_post(unsigned* bar, volatile LAS unsigned* st) {
    XcdBarrier b; b.bar = bar; b.x = xb_xcc_id(); b.st = st;
    if (threadIdx.x == 0) (void)xb_add(&bar[XB_XCNT(b.x)], 1u);
    return b;
}
__device__ __forceinline__ void xcd_barrier_complete(unsigned* bar, unsigned x, unsigned& nloc, unsigned& nx) {
    const unsigned G = gridDim.x * gridDim.y * gridDim.z;
    unsigned sum, cnt, mine, sp = 0u;
    for (;;) {
        sum = 0u; cnt = 0u; mine = 0u;
#pragma unroll
        for (unsigned j = 0; j < 16; ++j) { const unsigned c = xb_ld(&bar[XB_XCNT(j)]); sum += c; cnt += (c > 0u) ? 1u : 0u; mine = (j == x) ? c : mine; }
        if (sum == G) break;
        __builtin_amdgcn_s_sleep(1);
        if ((++sp & 255u) == 0u) { if (xb_ld(&bar[XB_TMO])) break; if (sp > XB_SPIN_CAP) { atomicAdd(&bar[XB_TMO], 1u); break; } }
    }
    nloc = mine > 0u ? mine : 1u; nx = cnt > 0u ? cnt : 1u;
}

__device__ __forceinline__ void xcd_barrier(const XcdBarrier& b) {
    asm volatile("s_waitcnt vmcnt(0)" ::: "memory");
    __syncthreads();
    if (threadIdx.x == 0) {
        unsigned* bar = b.bar;
        __builtin_amdgcn_s_waitcnt(0);
        unsigned nloc = b.st[0], nx = b.st[1];
        if (nloc == 0u) { xcd_barrier_complete(bar, b.x, nloc, nx); b.st[0] = nloc; b.st[1] = nx; }
        const unsigned old = xb_add(&bar[XB_XSUB(b.x)], 1u);
        const unsigned gen = old / nloc;
        if (old + 1u == (gen + 1u) * nloc) {
            __builtin_amdgcn_fence(__ATOMIC_RELEASE, "agent");
            asm volatile("s_waitcnt vmcnt(0)" ::: "memory");
            const unsigned og = xb_add(&bar[XB_TOP], 1u);
            const unsigned tg = og / nx;
            if (og + 1u == (tg + 1u) * nx) xb_add(&bar[XB_TOPGEN], 1u);
            else XB_SPIN(xb_ld(&bar[XB_TOPGEN]) == tg, bar);
            __builtin_amdgcn_fence(__ATOMIC_ACQUIRE, "agent");
            xb_add(&bar[XB_XGEN(b.x)], 1u);
            asm volatile("s_waitcnt vmcnt(0)" ::: "memory");
        } else {
            XB_SPIN(xb_ld(&bar[XB_XGEN(b.x)]) == gen, bar);
            __builtin_amdgcn_fence(__ATOMIC_ACQUIRE, "agent");
            asm volatile("s_waitcnt vmcnt(0)" ::: "memory");
        }
    }
    __syncthreads();
}

template <class Epi>
PHASE_FN void gemm_call(LAS unsigned char* ldsl, const bf16_t* A, const bf16_t* Bt, int N, int K, Epi E, int smode = 0, int sbase = 0) {
    pg8::Gemm g{A, Bt, T, N, K}; pg8::StaticOrder S; S.init(T, N, (int)gridDim.x, (int)blockIdx.x); S.mode = smode; S.base = sbase;
    pg8::gemm_phase<Epi, pg8::StaticOrder, true, true>(ldsl, g, S, E);
}
__global__ void __launch_bounds__(512, 2) fwd_megakernel(Params p) {
    extern __shared__ __attribute__((aligned(16))) unsigned char lds[];
    cg::grid_group grid = cg::this_grid();
    unsigned char* ws = p.ws;
    const int G = gridDim.x, bx = blockIdx.x;
    bf16_t* XB = (bf16_t*)(ws + WS_XB); float* SSQ = (float*)(ws + WS_SSQ); bf16_t* Zb = (bf16_t*)(ws + WS_Z); bf16_t* DECb = (bf16_t*)(ws + WS_DEC);
    bf16_t* MIXb = (bf16_t*)(ws + WS_MIX); bf16_t* HID = (bf16_t*)(ws + WS_HID);
    LAS unsigned char* ldsl = (LAS unsigned char*)lds;
    volatile LAS unsigned* xst = (volatile LAS unsigned*)(ldsl + 131072 + 320);
    if (threadIdx.x < 4) xst[threadIdx.x] = 0u;
    __syncthreads();
    const XcdBarrier xbar = xcd_barrier_post((unsigned*)(ws + WS_CTL + 512 * 1024), xst);

#ifndef NO_PREP
    phase_prep(p, (float*)lds);
#endif
    asm volatile("s_waitcnt vmcnt(0)" ::: "memory"); __syncthreads();
    __threadfence();
    grid.sync();
    for (int l = 0; l < DEPTH; ++l) {
        for (int part = 0; part < 2; ++part) {
            if (part == 1 && bx < 128) break;
            gemm_call<pg8::EpiZ>(ldsl, XB, (const bf16_t*)(ws + WS_WIN) + (size_t)l * ZW * D, part == 0 ? ZN_A : ZW, D, pg8::EpiZ{Zb, DECb, SSQ, (LAS float*)(ldsl + 131072 + 1024), -1}, part, 2 * (bx - 128));
            if (part == 0) xcd_barrier(xbar);
        }
        if (bx < 128) gla_item(p, lds, l, bx);
        else if (bx < 256) {
            __builtin_amdgcn_fence(__ATOMIC_ACQUIRE, "agent"); asm volatile("s_waitcnt vmcnt(0)" ::: "memory"); __syncthreads();
            for (int g = 0; g < 4; ++g) sgu_block(p, lds, l, g, 4 * (bx - 128), 4);
        }
        xcd_barrier(xbar);
#ifndef NO_G2
        gemm_call<pg8::EpiRes>(ldsl, MIXb, (const bf16_t*)(ws + WS_WOUT) + (size_t)l * D * D, D, D, pg8::EpiRes{p.x, p.out, XB, SSQ, l == 0 ? 1 : 0});
#endif
        xcd_barrier(xbar);
#ifndef NO_G3
        gemm_call<pg8::EpiH>(ldsl, XB, (const bf16_t*)(ws + WS_W1) + (size_t)l * FF * D, FF, D, pg8::EpiH{HID, SSQ, (LAS float*)(ldsl + 131072 + 1024), -1});
#endif
        xcd_barrier(xbar);
#ifndef NO_G4
        gemm_call<pg8::EpiRes>(ldsl, HID, (const bf16_t*)(ws + WS_W2) + (size_t)l * D * FF, D, FF, pg8::EpiRes{p.x, p.out, XB, SSQ, 0});
#endif
        xcd_barrier(xbar);
    }
    { const int tid = threadIdx.x;
      for (size_t i = ((size_t)bx * 512 + tid) * 8; i < (size_t)T * D; i += (size_t)G * 512 * 8) {
          const int r = (int)(i >> 10), c = (int)(i & 1023);
          const float* sp = SSQ + (size_t)r * 16; float s = 0.f;
#pragma unroll
          for (int j = 0; j < 4; ++j) { const f32x4 q = *(const f32x4*)(sp + 4 * j); s += (q[0] + q[1]) + (q[2] + q[3]); }
          const float rs = rsqrtf(s * (1.0f / 1024.0f) + EPS);
          const u32x4 w = *(const u32x4*)(XB + i); const f32x4 g0 = *(const f32x4*)(p.final_norm_g + c), g1 = *(const f32x4*)(p.final_norm_g + c + 4);
          *(f32x4*)(p.out + i) = (f32x4){bflo(w.x), bfhi(w.x), bflo(w.y), bfhi(w.y)} * rs * g0;
          *(f32x4*)(p.out + i + 4) = (f32x4){bflo(w.z), bfhi(w.z), bflo(w.w), bfhi(w.w)} * rs * g1; } }
}

extern "C" void kernel_launch(void* const* d_in, const int* in_sizes, int n_in, void* d_out, int out_size, void* d_ws, size_t ws_size, hipStream_t stream) {
    static int grid = 0;
    if (grid == 0) {
        if (n_in != 16 || out_size != T * D || ws_size < WS_END) { fprintf(stderr, "kernel_launch: unexpected shapes: n_in %d out %d ws %zu (need %zu)\n", n_in, out_size, ws_size, (size_t)WS_END); grid = -1; return; }
        int dev = 0, cus = 0, per_cu = 0;
        (void)hipGetDevice(&dev); (void)hipDeviceGetAttribute(&cus, hipDeviceAttributeMultiprocessorCount, dev);
        if (hipFuncSetAttribute((const void*)fwd_megakernel, hipFuncAttributeMaxDynamicSharedMemorySize, LDS_BYTES) != hipSuccess) { fprintf(stderr, "kernel_launch: hipFuncSetAttribute failed\n"); grid = -1; return; }
        (void)hipOccupancyMaxActiveBlocksPerMultiprocessor(&per_cu, (const void*)fwd_megakernel, 512, LDS_BYTES);
        (void)hipGetLastError();
        if (per_cu < 1) { fprintf(stderr, "kernel_launch: occupancy query says %d blocks per CU\n", per_cu); per_cu = 1; }
        grid = cus;
        if (grid < 256) { fprintf(stderr, "kernel_launch: %d CUs; this kernel's mixer phase needs a grid of at least 256\n", grid); }
    }
    if (grid < 0) return;
    (void)hipMemsetAsync((char*)d_ws + WS_CTL, 0, CTL_BYTES, stream);
    Params p{};
    p.x = (const float*)d_in[0]; p.norm_mix_g = (const float*)d_in[1]; p.w_in = (const float*)d_in[2]; p.w_a2_fwd = (const float*)d_in[3]; p.b_a_fwd = (const float*)d_in[4];
    p.w_a2_bwd = (const float*)d_in[5]; p.b_a_bwd = (const float*)d_in[6]; p.gla_norm_g = (const float*)d_in[7]; p.sgu_norm_g = (const float*)d_in[8]; p.w_s = (const float*)d_in[9];
    p.b_s = (const float*)d_in[10]; p.w_out = (const float*)d_in[11]; p.norm_mlp_g = (const float*)d_in[12]; p.w_mlp1 = (const float*)d_in[13]; p.w_mlp2 = (const float*)d_in[14];
    p.final_norm_g = (const float*)d_in[15]; p.out = (float*)d_out; p.ws = (unsigned char*)d_ws;
    void* args[] = {&p};
    hipError_t e = hipLaunchCooperativeKernel((const void*)fwd_megakernel, dim3(grid), dim3(512), args, LDS_BYTES, stream);
    if (e != hipSuccess) fprintf(stderr, "cooperative launch failed: %s (grid %d)\n", hipGetErrorString(e), grid);
}
```

```cpp
#include <hip/hip_runtime.h>
#include <hip/hip_cooperative_groups.h>
#include <cstdio>
namespace cg = cooperative_groups;

#define LAS __attribute__((address_space(3)))
#ifndef PHASE_FN
#define PHASE_FN __device__ __forceinline__
#endif
typedef unsigned short bf16_t;
typedef short bf16x8 __attribute__((ext_vector_type(8)));
typedef short bf16x4 __attribute__((ext_vector_type(4)));
typedef float f32x4 __attribute__((ext_vector_type(4)));
typedef float f32x2 __attribute__((ext_vector_type(2)));
typedef unsigned u32x4 __attribute__((ext_vector_type(4)));
typedef unsigned u32x2 __attribute__((ext_vector_type(2)));

constexpr int T = 65536, D = 1024, FF = 4096, SEQ = 4096, DEPTH = 4;
constexpr int ZW = 2816;
constexpr int D_IN = 2592;
constexpr float EPS = 1e-6f;
constexpr int ZQ = 0, ZK = 256, ZV = 512, ZG = 1024, ZSU = 1536, ZSV = 2304;
constexpr int ZN_A = 2304;

constexpr size_t MiB = 1u << 20;
constexpr size_t WS_CTL = 0, CTL_BYTES = 1 * MiB;
constexpr size_t WS_WIN = 1 * MiB;
constexpr size_t WS_WOUT = 23 * MiB;
constexpr size_t WS_W1 = 31 * MiB;
constexpr size_t WS_W2 = 63 * MiB;
constexpr size_t WS_WSB = 95 * MiB;
constexpr size_t WS_SSQ = 96 * MiB;
constexpr size_t WS_DEC = 100 * MiB;
constexpr size_t WS_XB = 108 * MiB;
constexpr size_t WS_Z = 236 * MiB;
constexpr size_t WS_MIX = 588 * MiB;
constexpr size_t WS_OX = 716 * MiB;
constexpr size_t WS_HID = 236 * MiB;
constexpr size_t WS_END = 844 * MiB;
constexpr int LDS_BYTES = 147456;

struct Params {
    const float* x; const float* norm_mix_g; const float* w_in; const float* w_a2_fwd; const float* b_a_fwd; const float* w_a2_bwd; const float* b_a_bwd;
    const float* gla_norm_g; const float* sgu_norm_g; const float* w_s; const float* b_s; const float* w_out; const float* norm_mlp_g; const float* w_mlp1;
    const float* w_mlp2; const float* final_norm_g; float* out; unsigned char* ws;
};

__device__ __forceinline__ unsigned cvt_pk_bf16(float lo, float hi) { unsigned r; asm volatile("v_cvt_pk_bf16_f32 %0, %1, %2" : "=v"(r) : "v"(lo), "v"(hi)); return r; }
__device__ __forceinline__ float bf2f(unsigned short b) { return __uint_as_float(((unsigned)b) << 16); }
__device__ __forceinline__ float bflo(unsigned w) { return __uint_as_float(w << 16); }
__device__ __forceinline__ float bfhi(unsigned w) { return __uint_as_float(w & 0xffff0000u); }

__device__ __forceinline__ f32x2 gelu_pk(f32x2 v) {
    const f32x2 av = __builtin_elementwise_abs(v), d = av * 0.2316418882f + 1.0f;
    f32x2 t; t.x = __builtin_amdgcn_rcpf(d.x); t.y = __builtin_amdgcn_rcpf(d.y);
    f32x2 q = t * 0.5307027145f + (-0.7265760135f); q = q * t + 0.7107068705f; q = q * t + (-0.142248368f); q = q * t + 0.127414796f; q = q * t;
    const f32x2 s = (v * v) * (-0.72134752044f);
    f32x2 e; e.x = __builtin_amdgcn_exp2f(s.x); e.y = __builtin_amdgcn_exp2f(s.y);
    const f32x2 m = v * (q * e), r = v - m;
    f32x2 o; o.x = v.x < 0.f ? m.x : r.x; o.y = v.y < 0.f ? m.y : r.y; return o;
}
__device__ __forceinline__ float silu_f(float v) { return v * __builtin_amdgcn_rcpf(1.0f + __expf(-v)); }

namespace pg8 {
constexpr int BM = 256, BK = 64, HALF = 128, HTB = HALF * BK * 2, STAGE_BYTES = 8 * HTB, NXCD = 8, WGM = 8;
__host__ __device__ __forceinline__ int lds_byte(int r, int c) { const int st = (r >> 4) * 2 + (c >> 5), rr = r & 15, cc = c & 31, ob = rr * 64 + cc * 2; return st * 1024 + (ob ^ (((ob >> 9) & 1) << 5)); }
__host__ __device__ __forceinline__ void stage_rc(int b, int& R, int& C) { const int st = b / 1024, sb = b % 1024, swz = sb ^ (((sb >> 9) & 1) << 5); R = (st >> 1) * 16 + swz / 64; C = (st & 1) * 32 + (swz % 64) / 2; }
__host__ __device__ __forceinline__ int perm32(int rho) { const int n = rho >> 4, i = rho & 15; return 8 * (i >> 2) + 4 * n + (i & 3); }
struct Unit { int pm, pn; };
struct Gemm { const bf16_t* A; const bf16_t* Bt; int M, N, K; };
struct StaticOrder {
    int nM, nN, nwg, G, c, mode, base;
    __device__ void init(int M, int N, int G_, int c_) { nM = M / BM; nN = N / BM; nwg = nM * nN; G = G_; c = c_; mode = 0; base = 0; }
    __device__ bool next(int i, Unit& u) const {
        if (mode == 1) { if (i >= 4) return false; u.pm = base + (i >> 1); u.pn = 9 + (i & 1); return true; }
        const long L = (long)i * G + c; if (L >= nwg) return false;
        int wgid = (int)L; { const int q = nwg / NXCD, r = nwg % NXCD, xcd = wgid % NXCD, off = wgid / NXCD; wgid = (xcd < r ? xcd * (q + 1) : r * (q + 1) + (xcd - r) * q) + off; }
        const int nig = WGM * nN, gid = wgid / nig, fm = gid * WGM, gsz = (nM - fm) < WGM ? (nM - fm) : WGM;
        u.pm = fm + ((wgid % nig) % gsz); u.pn = (wgid % nig) / gsz; return true;
    }
    __device__ __forceinline__ void a_ready(const Unit&) const {}
    __device__ __forceinline__ void done(const Unit&) const {}
};

template <class Epi, class Sched, bool ALIGN_EPI = false, bool SP2 = false>
__device__ __forceinline__ void gemm_phase(LAS unsigned char* lds, const Gemm g, const Sched& S, const Epi& E) {
    int tid = threadIdx.x; asm volatile("" : "+v"(tid));
    const int wid = __builtin_amdgcn_readfirstlane(tid >> 6), lane = tid & 63, wr = wid >> 2, wc = wid & 3, fr = lane & 15, fq = lane >> 4;
    const int K = g.K, nt = K / BK;
    unsigned voffA[2], voffB[2];
#pragma unroll
    for (int i = 0; i < 2; ++i) { int R, C; stage_rc(tid * 16 + i * 8192, R, C); const int Rb = Epi::PERM ? ((R & ~31) + perm32(R & 31)) : R;
        voffA[i] = (unsigned)(R * K + C) * 2u; voffB[i] = (unsigned)(Rb * K + C) * 2u; }
    const size_t kstep = (size_t)(BK * 2);
    const size_t hstep = (size_t)HALF * K * 2;
    const size_t tstep = 2 * hstep;
    const unsigned ldsw = (unsigned)wid * 1024u;
    const int aoff = lds_byte(wr * 64 + fr, fq * 8), boff = lds_byte(wc * 32 + fr, fq * 8);
#define PG8_SA(b, h) (((b) * 2 + (h)) * HTB)
#define PG8_SB(b, h) ((4 + (b) * 2 + (h)) * HTB)
#define PG8_STAGE(bufoff, gbase, voff) do { _Pragma("unroll") for (int _i = 0; _i < 2; ++_i) \
        __builtin_amdgcn_global_load_lds((const unsigned*)((const char*)(gbase) + (voff)[_i]), (LAS unsigned*)(lds + (bufoff) + ldsw + _i * 8192), 16, 0, 0); } while (0)
#define PG8_LDA(dst, b, h) do { _Pragma("unroll") for (int m = 0; m < 4; ++m) _Pragma("unroll") for (int k = 0; k < 2; ++k) dst[m][k] = *(const LAS bf16x8*)(lds + PG8_SA(b, h) + aoff + m * 2048 + k * 1024); } while (0)
#define PG8_LDB(dst, b, h) do { _Pragma("unroll") for (int n = 0; n < 2; ++n) _Pragma("unroll") for (int k = 0; k < 2; ++k) dst[n][k] = *(const LAS bf16x8*)(lds + PG8_SB(b, h) + boff + n * 2048 + k * 1024); } while (0)
#define PG8_MMA(ai, bj, At, Bt) do { __builtin_amdgcn_s_setprio(1); _Pragma("unroll") for (int m = 0; m < 4; ++m) _Pragma("unroll") for (int n = 0; n < 2; ++n) _Pragma("unroll") for (int k = 0; k < 2; ++k) \
        acc[ai][bj][m][n] = __builtin_amdgcn_mfma_f32_16x16x32_bf16(Bt[n][k], At[m][k], acc[ai][bj][m][n], 0, 0, 0); __builtin_amdgcn_s_setprio(0); } while (0)
#define PG8_WAIT_V(n) asm volatile("s_waitcnt vmcnt(" #n ")" ::: "memory")
#define PG8_WAIT_L(n) asm volatile("s_waitcnt lgkmcnt(" #n ")" ::: "memory")
#define PG8_BAR __builtin_amdgcn_s_barrier()
#define PG8_SCHED __builtin_amdgcn_sched_barrier(0)
    Unit cur, nxt; int ui = 0;
    if (!S.next(0, cur)) return;
    f32x4 acc[2][2][4][2];
#pragma unroll
    for (int a = 0; a < 2; ++a)
#pragma unroll
        for (int b = 0; b < 2; ++b)
#pragma unroll
            for (int m = 0; m < 4; ++m)
#pragma unroll
                for (int n = 0; n < 2; ++n) acc[a][b][m][n] = (f32x4){0.f, 0.f, 0.f, 0.f};
    bf16x8 At[4][2], B0[2][2], B1[2][2];
    const char* cA = (const char*)g.A + (size_t)cur.pm * tstep; const char* cB = (const char*)g.Bt + (size_t)cur.pn * tstep;
    S.a_ready(cur);
    if constexpr (SP2) {
        PG8_STAGE(PG8_SB(0, 0), cB, voffB); PG8_STAGE(PG8_SB(0, 1), cB + hstep, voffB); PG8_STAGE(PG8_SA(0, 0), cA, voffA); PG8_STAGE(PG8_SA(0, 1), cA + hstep, voffA);
        if (wr == 1) PG8_BAR;
        PG8_WAIT_V(2); PG8_BAR;
        PG8_STAGE(PG8_SB(1, 0), cB + kstep, voffB); PG8_STAGE(PG8_SA(1, 0), cA + kstep, voffA); PG8_STAGE(PG8_SB(1, 1), cB + hstep + kstep, voffB);
        PG8_WAIT_V(6); PG8_BAR;
    } else {
        PG8_STAGE(PG8_SB(0, 0), cB, voffB); PG8_STAGE(PG8_SA(0, 0), cA, voffA); PG8_STAGE(PG8_SB(0, 1), cB + hstep, voffB); PG8_STAGE(PG8_SA(0, 1), cA + hstep, voffA);
        if (wr == 1) PG8_BAR;
        PG8_WAIT_V(4); PG8_BAR;
        PG8_STAGE(PG8_SB(1, 0), cB + kstep, voffB); PG8_STAGE(PG8_SA(1, 0), cA + kstep, voffA); PG8_STAGE(PG8_SB(1, 1), cB + hstep + kstep, voffB);
        PG8_WAIT_V(6); PG8_BAR;
    }
    for (;;) {
        const bool has_next = S.next(ui + 1, nxt);
        const char* nA = has_next ? (const char*)g.A + (size_t)nxt.pm * tstep : cA; const char* nB = has_next ? (const char*)g.Bt + (size_t)nxt.pn * tstep : cB;
        for (int t = 0; t < nt; t += 2) {
            const bool last = (t == nt - 2);
            const char* a1 = cA + (size_t)(t + 1) * kstep;
            const char* a2 = last ? nA : cA + (size_t)(t + 2) * kstep; const char* b2 = last ? nB : cB + (size_t)(t + 2) * kstep;
            const char* a3 = a2 + kstep; const char* b3 = b2 + kstep;
            if (last && has_next) S.a_ready(nxt);
            if constexpr (SP2) {
            PG8_LDB(B0, 0, 0); PG8_LDB(B1, 0, 1); PG8_SCHED; PG8_LDA(At, 0, 0); PG8_STAGE(PG8_SA(1, 1), a1 + hstep, voffA);
            PG8_WAIT_V(8); PG8_WAIT_L(0); PG8_BAR; PG8_MMA(0, 0, At, B0); PG8_MMA(0, 1, At, B1); PG8_BAR; PG8_SCHED;
            PG8_LDA(At, 0, 1); PG8_STAGE(PG8_SB(0, 0), b2, voffB); PG8_STAGE(PG8_SB(0, 1), b2 + hstep, voffB); PG8_STAGE(PG8_SA(0, 0), a2, voffA);
            PG8_WAIT_V(8); PG8_WAIT_L(0); PG8_BAR; PG8_MMA(1, 0, At, B0); PG8_MMA(1, 1, At, B1); PG8_BAR; PG8_SCHED;
            PG8_LDB(B0, 1, 0); PG8_LDB(B1, 1, 1); PG8_SCHED; PG8_LDA(At, 1, 0); PG8_STAGE(PG8_SA(0, 1), a2 + hstep, voffA);
            PG8_WAIT_V(8); PG8_WAIT_L(0); PG8_BAR; PG8_MMA(0, 0, At, B0); PG8_MMA(0, 1, At, B1); PG8_BAR; PG8_SCHED;
            PG8_LDA(At, 1, 1); PG8_STAGE(PG8_SB(1, 0), b3, voffB); PG8_STAGE(PG8_SB(1, 1), b3 + hstep, voffB); PG8_STAGE(PG8_SA(1, 0), a3, voffA);
            PG8_WAIT_V(8); PG8_WAIT_L(0); PG8_BAR; PG8_MMA(1, 0, At, B0); PG8_MMA(1, 1, At, B1); PG8_BAR; PG8_SCHED;
            } else {
            PG8_LDB(B0, 0, 0); PG8_SCHED; PG8_LDA(At, 0, 0); PG8_STAGE(PG8_SA(1, 1), a1 + hstep, voffA);
            PG8_WAIT_L(8); PG8_BAR; PG8_WAIT_L(0); PG8_MMA(0, 0, At, B0); PG8_BAR; PG8_SCHED;
            PG8_LDB(B1, 0, 1); PG8_STAGE(PG8_SB(0, 0), b2, voffB);
            PG8_BAR; PG8_WAIT_L(0); PG8_MMA(0, 1, At, B1); PG8_BAR;
            PG8_LDA(At, 0, 1); PG8_STAGE(PG8_SA(0, 0), a2, voffA);
            PG8_BAR; PG8_WAIT_L(0); PG8_MMA(1, 0, At, B0); PG8_BAR; PG8_SCHED;
            PG8_STAGE(PG8_SB(0, 1), b2 + hstep, voffB);
            PG8_WAIT_V(6); PG8_BAR; PG8_MMA(1, 1, At, B1); PG8_BAR;
            PG8_LDB(B0, 1, 0); PG8_SCHED; PG8_LDA(At, 1, 0); PG8_STAGE(PG8_SA(0, 1), a2 + hstep, voffA);
            PG8_WAIT_L(8); PG8_BAR; PG8_WAIT_L(0); PG8_MMA(0, 0, At, B0); PG8_BAR; PG8_SCHED;
            PG8_LDB(B1, 1, 1); PG8_STAGE(PG8_SB(1, 0), b3, voffB);
            PG8_BAR; PG8_WAIT_L(0); PG8_MMA(0, 1, At, B1); PG8_BAR;
            PG8_LDA(At, 1, 1); PG8_STAGE(PG8_SA(1, 0), a3, voffA);
            PG8_BAR; PG8_WAIT_L(0); PG8_MMA(1, 0, At, B0); PG8_BAR; PG8_SCHED;
            PG8_STAGE(PG8_SB(1, 1), b3 + hstep, voffB);
            PG8_WAIT_V(6); PG8_BAR; PG8_MMA(1, 1, At, B1); PG8_BAR;
            }
        }
        if constexpr (ALIGN_EPI) { if (wr == 0) PG8_BAR; }
        E(acc, cur, wr, wc, fr, fq); S.done(cur);
        if (!has_next) break;
#pragma unroll
        for (int a = 0; a < 2; ++a)
#pragma unroll
            for (int b = 0; b < 2; ++b)
#pragma unroll
                for (int m = 0; m < 4; ++m)
#pragma unroll
                    for (int n = 0; n < 2; ++n) acc[a][b][m][n] = (f32x4){0.f, 0.f, 0.f, 0.f};
        cur = nxt; cA = nA; cB = nB; ++ui;
        if constexpr (ALIGN_EPI) { if (wr == 1) PG8_BAR; }
    }
    PG8_WAIT_V(0);
    if constexpr (!ALIGN_EPI) { if (wr == 0) PG8_BAR; }
    PG8_BAR;
#undef PG8_SA
#undef PG8_SB
#undef PG8_STAGE
#undef PG8_LDA
#undef PG8_LDB
#undef PG8_MMA
#undef PG8_WAIT_V
#undef PG8_WAIT_L
#undef PG8_BAR
#undef PG8_SCHED
}

__device__ __forceinline__ void rows_rstd(const float* __restrict__ ssq, int row0, int fq, float (&rs)[2][4]) {
    f32x4 pp[2][4];
#pragma unroll
    for (int ai = 0; ai < 2; ++ai)
#pragma unroll
        for (int m = 0; m < 4; ++m) pp[ai][m] = *(const f32x4*)(ssq + (size_t)(row0 + ai * HALF + m * 16) * 16 + 4 * fq);
#pragma unroll
    for (int ai = 0; ai < 2; ++ai)
#pragma unroll
        for (int m = 0; m < 4; ++m) { float s = (pp[ai][m][0] + pp[ai][m][1]) + (pp[ai][m][2] + pp[ai][m][3]); s += __shfl_xor(s, 16); s += __shfl_xor(s, 32); rs[ai][m] = rsqrtf(s * (1.0f / 1024.0f) + EPS); }
}
__device__ __forceinline__ void rows_rstd_cached(const float* __restrict__ ssq, int row0, int fq, float (&rs)[2][4], bool hit, LAS float* cache, int lrow0, bool writer) {
    if (hit) {
#pragma unroll
        for (int ai = 0; ai < 2; ++ai)
#pragma unroll
            for (int m = 0; m < 4; ++m) rs[ai][m] = cache[lrow0 + ai * HALF + m * 16];
    } else {
        rows_rstd(ssq, row0, fq, rs);
        if (writer) {
#pragma unroll
            for (int ai = 0; ai < 2; ++ai)
#pragma unroll
                for (int m = 0; m < 4; ++m) cache[lrow0 + ai * HALF + m * 16] = rs[ai][m];
        }
    }
}
struct EpiZ {
    static constexpr bool PERM = true;
    bf16_t* Z; bf16_t* DEC; const float* ssq; LAS float* rsc; mutable int cached_pm;
    __device__ __forceinline__ void operator()(const f32x4 (&acc)[2][2][4][2], const Unit& u, int wr, int wc, int fr, int fq) const {
        const int row0 = u.pm * BM + wr * 64 + fr; const int pn = u.pn;
        float rsv[2][4]; rows_rstd_cached(ssq, row0, fq, rsv, u.pm == cached_pm, rsc, wr * 64 + fr, wc == 0 && fq == 0); cached_pm = u.pm;
#pragma unroll
        for (int ai = 0; ai < 2; ++ai)
#pragma unroll
            for (int m = 0; m < 4; ++m) {
                const int r = row0 + ai * HALF + m * 16; const float rs = rsv[ai][m];
                if (pn == 8) {
                    if (wc == 0) { const f32x4 v0 = acc[ai][0][m][0] * rs, v1 = acc[ai][0][m][1] * rs; u32x4 w; w.x = cvt_pk_bf16(v0[0], v0[1]); w.y = cvt_pk_bf16(v0[2], v0[3]); w.z = cvt_pk_bf16(v1[0], v1[1]); w.w = cvt_pk_bf16(v1[2], v1[3]); *(u32x4*)(DEC + (size_t)r * 32 + 8 * fq) = w; }
                } else {
                    bf16_t* rowp = Z + (size_t)r * ZW + pn * BM + wc * 32 + 8 * fq;
#pragma unroll
                    for (int bj = 0; bj < 2; ++bj) { f32x4 v0 = acc[ai][bj][m][0] * rs, v1 = acc[ai][bj][m][1] * rs;
                        if (pn >= 4 && pn < 6) {
#pragma unroll
                            for (int j = 0; j < 4; ++j) { v0[j] = silu_f(v0[j]); v1[j] = silu_f(v1[j]); } }
                        u32x4 w; w.x = cvt_pk_bf16(v0[0], v0[1]); w.y = cvt_pk_bf16(v0[2], v0[3]); w.z = cvt_pk_bf16(v1[0], v1[1]); w.w = cvt_pk_bf16(v1[2], v1[3]);
                        *(u32x4*)(rowp + bj * HALF) = w; }
                }
            }
    }
};
struct EpiH {
    static constexpr bool PERM = true;
    bf16_t* H; const float* ssq; LAS float* rsc; mutable int cached_pm;
    __device__ __forceinline__ void operator()(const f32x4 (&acc)[2][2][4][2], const Unit& u, int wr, int wc, int fr, int fq) const {
        const int row0 = u.pm * BM + wr * 64 + fr;
        float rsv[2][4]; rows_rstd_cached(ssq, row0, fq, rsv, u.pm == cached_pm, rsc, wr * 64 + fr, wc == 0 && fq == 0); cached_pm = u.pm;
#pragma unroll
        for (int ai = 0; ai < 2; ++ai)
#pragma unroll
            for (int m = 0; m < 4; ++m) {
                const int r = row0 + ai * HALF + m * 16; const float rs = rsv[ai][m];
                bf16_t* rowp = H + (size_t)r * FF + u.pn * BM + wc * 32 + 8 * fq;
#pragma unroll
                for (int bj = 0; bj < 2; ++bj) { f32x4 v0 = acc[ai][bj][m][0] * rs, v1 = acc[ai][bj][m][1] * rs;
#pragma unroll
                    for (int j = 0; j < 4; ++j) { const float a = fmaxf(v0[j], 0.f), b = fmaxf(v1[j], 0.f); v0[j] = a * a; v1[j] = b * b; }
                    u32x4 w; w.x = cvt_pk_bf16(v0[0], v0[1]); w.y = cvt_pk_bf16(v0[2], v0[3]); w.z = cvt_pk_bf16(v1[0], v1[1]); w.w = cvt_pk_bf16(v1[2], v1[3]);
                    *(u32x4*)(rowp + bj * HALF) = w; }
            }
    }
};
template <bool RD32>
__device__ __forceinline__ void res_rows(const float* __restrict__ xold32, const bf16_t* __restrict__ xoldb, bf16_t* __restrict__ xb, float* __restrict__ ssq, const f32x4 (&acc)[2][2][4][2], int row0, int col0, int slot) {
    f32x4 xo[2][2][2];
    float ssv[8];
    auto ld = [&](size_t o, f32x4& a, f32x4& b) { if (RD32) { a = *(const f32x4*)(xold32 + o); b = *(const f32x4*)(xold32 + o + 4); }
        else { const u32x4 w = *(const u32x4*)(xoldb + o); a = (f32x4){bflo(w.x), bfhi(w.x), bflo(w.y), bfhi(w.y)}; b = (f32x4){bflo(w.z), bfhi(w.z), bflo(w.w), bfhi(w.w)}; } };
#pragma unroll
    for (int bj = 0; bj < 2; ++bj) ld((size_t)row0 * D + col0 + bj * HALF, xo[0][bj][0], xo[0][bj][1]);
#pragma unroll
    for (int idx = 0; idx < 8; ++idx) {
        const int ai = idx >> 2, m = idx & 3; const int r = row0 + ai * HALF + m * 16; const size_t off = (size_t)r * D + col0;
        if (idx < 7) { const int ai2 = (idx + 1) >> 2, m2 = (idx + 1) & 3; const size_t off2 = (size_t)(row0 + ai2 * HALF + m2 * 16) * D + col0;
#pragma unroll
            for (int bj = 0; bj < 2; ++bj) ld(off2 + bj * HALF, xo[(idx + 1) & 1][bj][0], xo[(idx + 1) & 1][bj][1]); }
        float ss = 0.f;
#pragma unroll
        for (int bj = 0; bj < 2; ++bj) { const f32x4 x0 = xo[idx & 1][bj][0] + acc[ai][bj][m][0], x1 = xo[idx & 1][bj][1] + acc[ai][bj][m][1];
            u32x4 w; w.x = cvt_pk_bf16(x0[0], x0[1]); w.y = cvt_pk_bf16(x0[2], x0[3]); w.z = cvt_pk_bf16(x1[0], x1[1]); w.w = cvt_pk_bf16(x1[2], x1[3]);
            *(u32x4*)(xb + off + bj * HALF) = w;
            ss += ((x0[0] * x0[0] + x0[1] * x0[1]) + (x0[2] * x0[2] + x0[3] * x0[3])) + ((x1[0] * x1[0] + x1[1] * x1[1]) + (x1[2] * x1[2] + x1[3] * x1[3])); }
        ss += __shfl_xor(ss, 16); ss += __shfl_xor(ss, 32);
        ssv[idx] = ss;
    }
    const int fq = slot >> 6;
#pragma unroll
    for (int j = 0; j < 2; ++j) { const float v = fq == 0 ? ssv[j] : fq == 1 ? ssv[2 + j] : fq == 2 ? ssv[4 + j] : ssv[6 + j]; const int idx = 2 * fq + j;
        ssq[(size_t)(row0 + (idx >> 2) * HALF + (idx & 3) * 16) * 16 + (slot & 15)] = v; }
}
struct EpiRes {
    static constexpr bool PERM = true;
    const float* xold32; float* xout; bf16_t* xb; float* ssq; int mode;
    __device__ __forceinline__ void operator()(const f32x4 (&acc)[2][2][4][2], const Unit& u, int wr, int wc, int fr, int fq) const {
        const int row0 = u.pm * BM + wr * 64 + fr, col0 = u.pn * BM + wc * 32 + 8 * fq, slot = (u.pn * 4 + wc) | (fq << 6);
        if (mode == 0) res_rows<false>(xold32, xb, xb, ssq, acc, row0, col0, slot);
        else res_rows<true>(xold32, xb, xb, ssq, acc, row0, col0, slot);
    }
};
}

struct WTile { const float* src; bf16_t* dst; const float* g; int ldsrc, K, n0, k0, mode; };
__device__ __forceinline__ WTile wtile_desc(const Params& p, int it) {
    unsigned char* ws = p.ws; WTile t; const int l = it / 3008; int r = it % 3008;
    if (r < 704) { t.src = p.w_in + (size_t)l * D * D_IN; t.ldsrc = D_IN; t.dst = (bf16_t*)(ws + WS_WIN) + (size_t)l * ZW * D; t.K = D; t.n0 = (r / 16) * 64; t.k0 = (r % 16) * 64; t.g = p.norm_mix_g + l * D; t.mode = 0; }
    else if (r < 960) { r -= 704; t.src = p.w_out + (size_t)l * D * D; t.ldsrc = D; t.dst = (bf16_t*)(ws + WS_WOUT) + (size_t)l * D * D; t.K = D; t.n0 = (r / 16) * 64; t.k0 = (r % 16) * 64; t.g = nullptr; t.mode = 1; }
    else if (r < 1984) { r -= 960; t.src = p.w_mlp1 + (size_t)l * D * FF; t.ldsrc = FF; t.dst = (bf16_t*)(ws + WS_W1) + (size_t)l * FF * D; t.K = D; t.n0 = (r / 16) * 64; t.k0 = (r % 16) * 64; t.g = p.norm_mlp_g + l * D; t.mode = 1; }
    else { r -= 1984; t.src = p.w_mlp2 + (size_t)l * FF * D; t.ldsrc = D; t.dst = (bf16_t*)(ws + WS_W2) + (size_t)l * D * FF; t.K = FF; t.n0 = (r / 64) * 64; t.k0 = (r % 64) * 64; t.g = nullptr; t.mode = 1; }
    return t;
}
__device__ __forceinline__ void wtile_load(const WTile& w, int t, f32x4& a, f32x4& b, float& rsc) {
    const int kk = t >> 3, ns = (t & 7) * 8; const int nd = w.n0 + ns; int nsrc = nd; bool valid = true; float cs = 1.0f;
    if (w.mode == 0) { if (nd < 1536) nsrc = nd; else if (nd < 2048) nsrc = nd + 32; else if (nd < 2080) nsrc = nd - 512; else if (nd < 2304) valid = false; else nsrc = nd - 224; if (nd < 256) cs = 0.125f; }
    a = (f32x4){0.f, 0.f, 0.f, 0.f}; b = a;
    if (valid) { const float* sp = w.src + (size_t)(w.k0 + kk) * w.ldsrc + nsrc; a = *(const f32x4*)sp; b = *(const f32x4*)(sp + 4); }
    rsc = (w.g ? w.g[w.k0 + kk] : 1.0f) * cs;
}

PHASE_FN void phase_prep(const Params& p, float* ldsf) {
    unsigned char* ws = p.ws;
    const int G = gridDim.x, bx = blockIdx.x; int tid = threadIdx.x; asm volatile("" : "+v"(tid));
    { const int NT = DEPTH * 3008; int it = bx, buf = 0; f32x4 a, b; float rsc;
      WTile cur = wtile_desc(p, it < NT ? it : 0);
      if (it < NT) wtile_load(cur, tid, a, b, rsc);
      for (; it < NT; it += G, buf ^= 1) {
          float* tile = ldsf + buf * (64 * 65);
          { const int kk = tid >> 3, ns = (tid & 7) * 8; float* tp = tile + kk * 65 + ns;
#pragma unroll
            for (int j = 0; j < 4; ++j) { tp[j] = a[j] * rsc; tp[4 + j] = b[j] * rsc; } }
          const WTile w = cur;
          if (it + G < NT) { cur = wtile_desc(p, it + G); wtile_load(cur, tid, a, b, rsc); }
          asm volatile("s_waitcnt lgkmcnt(0)" ::: "memory"); __builtin_amdgcn_s_barrier(); asm volatile("" ::: "memory");
          { const int nn = tid >> 3, ks = (tid & 7) * 8; float v[8];
#pragma unroll
            for (int i = 0; i < 8; ++i) v[i] = tile[(ks + i) * 65 + nn];
            u32x4 o; o.x = cvt_pk_bf16(v[0], v[1]); o.y = cvt_pk_bf16(v[2], v[3]); o.z = cvt_pk_bf16(v[4], v[5]); o.w = cvt_pk_bf16(v[6], v[7]);
            *(u32x4*)(w.dst + (size_t)(w.n0 + nn) * w.K + w.k0 + ks) = o; }
      }
      __syncthreads(); }
    { bf16_t* wsb = (bf16_t*)(ws + WS_WSB);
      for (int i = (bx * 512 + tid) * 4; i < DEPTH * 4 * 128 * 128; i += G * 512 * 4) { const f32x4 v = *(const f32x4*)(p.w_s + i); u32x2 w; w.x = cvt_pk_bf16(v[0], v[1]); w.y = cvt_pk_bf16(v[2], v[3]); *(u32x2*)(wsb + i) = w; } }
    { bf16_t* xb = (bf16_t*)(ws + WS_XB); float* ssq = (float*)(ws + WS_SSQ); const int wid = tid >> 6, lane = tid & 63;
      for (int r = bx * 8 + wid; r < T; r += G * 8) { const float* xr = p.x + (size_t)r * D; float ss = 0.f;
#pragma unroll
          for (int i = 0; i < 4; ++i) { const int c = i * 256 + lane * 4; const f32x4 v = *(const f32x4*)(xr + c); ss += (v[0] * v[0] + v[1] * v[1]) + (v[2] * v[2] + v[3] * v[3]);
              u32x2 w; w.x = cvt_pk_bf16(v[0], v[1]); w.y = cvt_pk_bf16(v[2], v[3]); *(u32x2*)(xb + (size_t)r * D + c) = w; }
#pragma unroll
          for (int o = 32; o >= 1; o >>= 1) ss += __shfl_xor(ss, o);
          if (lane < 16) ssq[(size_t)r * 16 + lane] = lane == 0 ? ss : 0.f; } }
}

constexpr int GP = 72;
constexpr int VP = 132;
#define ROT(row, col) (((col) + 16 * ((row) >> 4)) & 63)
constexpr int L_QIN = 0, L_KIN = 9216, L_QOUT = 18432, L_KOUTT = 27648;
constexpr int L_DEC = 36864;
constexpr int L_RED = L_DEC + 256;
constexpr int L_QRAW = L_RED + 1024;
constexpr int L_KRAW = L_QRAW + 8192;
constexpr int L_ARAW = L_KRAW + 8192;
constexpr int L_VRAW = L_ARAW + 2048;
static_assert(L_VRAW + 64 * VP * 2 <= 131072, "GLA LDS map");

__device__ __forceinline__ float logsig2(float d) {
    const float e = __builtin_amdgcn_exp2f(d * -1.44269504089f);
    return __builtin_amdgcn_logf(1.0f + e) * -0.0625f;
}
#define GLA_BAR() do { asm volatile("s_waitcnt lgkmcnt(0)" ::: "memory"); __builtin_amdgcn_s_barrier(); asm volatile("" ::: "memory"); } while (0)
#define CHUNK(si) (dir ? 63 - (si) : (si))
#define POS(r) (dir ? 63 - (r) : (r))

struct GlaRegs { u32x4 q0, q1, k0, k1, a, v0, v1, v2, v3; };
struct GlaPrepCtx {
    const bf16_t* Z; const bf16_t* DEC; unsigned* myflag; unsigned* paflag;
    bf16_t* qin; bf16_t* kin; bf16_t* qout; bf16_t* koutT; float* decs; bf16_t* qraw; bf16_t* kraw; bf16_t* araw; bf16_t* vraw;
    int tid, wid, lr, q4, b, h, dir, lrow, lcs, vrow, vcs, arow, acs, ch; bf16x8 w2f; float bias;
};
#define ST8_(pp, v) do { *(u32x2*)(pp) = (u32x2){(v).x, (v).y}; *(u32x2*)((pp) + 4) = (u32x2){(v).z, (v).w}; } while (0)
__device__ __forceinline__ void gla_load_qka(const GlaPrepCtx& c, int si, GlaRegs& R) {
    const int dir = c.dir; const size_t t0 = (size_t)(c.b * SEQ + CHUNK(si) * 64); const bf16_t* zr = c.Z + (t0 + c.lrow) * ZW + c.h * 64 + c.lcs;
    R.q0 = *(const u32x4*)(zr + ZQ); R.k0 = *(const u32x4*)(zr + ZK); R.q1 = *(const u32x4*)(zr + (size_t)32 * ZW + ZQ); R.k1 = *(const u32x4*)(zr + (size_t)32 * ZW + ZK);
    if (c.tid < 128) R.a = *(const u32x4*)(c.DEC + (t0 + c.arow) * 32 + dir * 16 + c.acs);
}
__device__ __forceinline__ void gla_load_v(const GlaPrepCtx& c, int si, GlaRegs& R) {
    const int dir = c.dir; const size_t t0 = (size_t)(c.b * SEQ + CHUNK(si) * 64); const bf16_t* vr = c.Z + (t0 + c.vrow) * ZW + ZV + c.h * 128 + c.vcs;
    R.v0 = *(const u32x4*)vr; R.v1 = *(const u32x4*)(vr + (size_t)16 * ZW); R.v2 = *(const u32x4*)(vr + (size_t)32 * ZW); R.v3 = *(const u32x4*)(vr + (size_t)48 * ZW);
}
__device__ __forceinline__ void gla_store_qka(const GlaPrepCtx& c, const GlaRegs& R) {
    const int dir = c.dir; const int r0_ = POS(c.lrow), r1_ = POS(c.lrow + 32);
    *(u32x4*)(c.qraw + r0_ * 64 + ROT(r0_, c.lcs)) = R.q0; *(u32x4*)(c.kraw + r0_ * 64 + ROT(r0_, c.lcs)) = R.k0; *(u32x4*)(c.qraw + r1_ * 64 + ROT(r1_, c.lcs)) = R.q1; *(u32x4*)(c.kraw + r1_ * 64 + ROT(r1_, c.lcs)) = R.k1;
    if (c.tid < 128) *(u32x4*)(c.araw + POS(c.arow) * 16 + c.acs) = R.a;
}
__device__ __forceinline__ void gla_store_v(const GlaPrepCtx& c, const GlaRegs& R) {
    const int dir = c.dir;
    ST8_(c.vraw + POS(c.vrow) * VP + c.vcs, R.v0); ST8_(c.vraw + POS(c.vrow + 16) * VP + c.vcs, R.v1); ST8_(c.vraw + POS(c.vrow + 32) * VP + c.vcs, R.v2); ST8_(c.vraw + POS(c.vrow + 48) * VP + c.vcs, R.v3);
}
__device__ __forceinline__ void gla_prep_step(const GlaPrepCtx& c, int s, GlaRegs& LD, GlaRegs& ST) {
    const int wid = c.wid, lr = c.lr, q4 = c.q4, ch = c.ch, tid = c.tid;
    if (s == 32) {
        if (wid == 0) { while (__hip_atomic_load(c.paflag, __ATOMIC_RELAXED, __HIP_MEMORY_SCOPE_AGENT) == 0u) __builtin_amdgcn_s_sleep(4);
            __builtin_amdgcn_fence(__ATOMIC_ACQUIRE, "agent"); asm volatile("s_waitcnt vmcnt(0)" ::: "memory"); }
        __syncthreads();
    }
    if (s + 3 < 64) gla_load_qka(c, s + 3, LD);
    if (s + 2 < 64) gla_load_v(c, s + 2, LD);
    unsigned rq[8], rk[8], ro[8], rko[8]; float rdec = 0.f;
    if (s < 63) {
        float la[16];
#pragma unroll
        for (int cb = 0; cb < 4; ++cb) { const int pr = 16 * (lr >> 2) + 4 * cb + (lr & 3);
            u32x4 aw = (u32x4){0u, 0u, 0u, 0u}; if (q4 < 2) aw = *(const u32x4*)(c.araw + pr * 16 + 8 * q4);
            f32x4 d = (f32x4){c.bias, c.bias, c.bias, c.bias};
            d = __builtin_amdgcn_mfma_f32_16x16x32_bf16(__builtin_bit_cast(bf16x8, aw), c.w2f, d, 0, 0, 0);
#pragma unroll
            for (int jj = 0; jj < 4; ++jj) la[4 * cb + jj] = logsig2(d[jj]); }
#pragma unroll
        for (int i = 1; i < 16; ++i) la[i] += la[i - 1];
        const float tq = la[15]; float inc = tq;
        { const float t1 = __shfl_up(inc, 16); if (q4 >= 1) inc += t1; const float t2 = __shfl_up(inc, 32); if (q4 >= 2) inc += t2; }
        const float off = inc - tq;
        const float tot = __shfl(inc, lr + 48);
        const float bmid = __shfl(off + la[0], lr + 32);
        const float emid = __builtin_amdgcn_exp2f(bmid), etm = __builtin_amdgcn_exp2f(tot - bmid);
        rdec = __builtin_amdgcn_exp2f(tot);
        typedef short s4v __attribute__((ext_vector_type(4)));
        s4v qt[4], kt[4];
        { const int trow = 16 * q4 + (lr >> 2), tcol = ((16 * wid + 16 * q4) & 63) + 4 * (lr & 3);
#pragma unroll
          for (int t = 0; t < 4; ++t) { qt[t] = __builtin_amdgcn_ds_read_tr16_b64_v4i16((LAS s4v*)(c.qraw + (trow + 4 * t) * 64 + tcol)); kt[t] = __builtin_amdgcn_ds_read_tr16_b64_v4i16((LAS s4v*)(c.kraw + (trow + 4 * t) * 64 + tcol)); } }
#pragma unroll
        for (int i = 0; i < 16; i += 2) {
            const float x0 = off + la[i] - bmid, x1 = off + la[i + 1] - bmid;
            const float e10 = __builtin_amdgcn_exp2f(x0), e20 = __builtin_amdgcn_exp2f(-x0), e11 = __builtin_amdgcn_exp2f(x1), e21 = __builtin_amdgcn_exp2f(-x1);
            const float q0 = bf2f((unsigned short)qt[i >> 2][i & 3]) * e10, q1 = bf2f((unsigned short)qt[i >> 2][(i & 3) + 1]) * e11;
            const float k0 = bf2f((unsigned short)kt[i >> 2][i & 3]) * e20, k1 = bf2f((unsigned short)kt[i >> 2][(i & 3) + 1]) * e21;
            rq[i >> 1] = cvt_pk_bf16(q0, q1); rk[i >> 1] = cvt_pk_bf16(k0, k1); ro[i >> 1] = cvt_pk_bf16(q0 * emid, q1 * emid); rko[i >> 1] = cvt_pk_bf16(k0 * etm, k1 * etm);
        }
    }
    GLA_BAR();
    if (s < 63) {
        const int chr = (ch + 16 * q4) & 63;
#pragma unroll
        for (int i = 0; i < 8; ++i) { const int p0 = 16 * q4 + 2 * i;
            c.qin[p0 * GP + chr] = (bf16_t)(rq[i] & 0xffffu); c.qin[(p0 + 1) * GP + chr] = (bf16_t)(rq[i] >> 16);
            c.kin[p0 * GP + chr] = (bf16_t)(rk[i] & 0xffffu); c.kin[(p0 + 1) * GP + chr] = (bf16_t)(rk[i] >> 16);
            c.qout[p0 * GP + chr] = (bf16_t)(ro[i] & 0xffffu); c.qout[(p0 + 1) * GP + chr] = (bf16_t)(ro[i] >> 16); }
        *(u32x4*)(c.koutT + ch * GP + 16 * q4) = (u32x4){rko[0], rko[1], rko[2], rko[3]}; *(u32x4*)(c.koutT + ch * GP + 16 * q4 + 8) = (u32x4){rko[4], rko[5], rko[6], rko[7]};
        if (q4 == 0) c.decs[ch] = rdec;
    }
    if (s + 2 < 64) gla_store_qka(c, ST);
    if (s + 1 < 64) gla_store_v(c, ST);
    if (s == 31) {
        asm volatile("s_waitcnt vmcnt(0)" ::: "memory"); __syncthreads();
        if (tid == 0) { __builtin_amdgcn_fence(__ATOMIC_RELEASE, "agent"); asm volatile("s_waitcnt vmcnt(0)" ::: "memory"); __hip_atomic_store(c.myflag, 1u, __ATOMIC_RELAXED, __HIP_MEMORY_SCOPE_AGENT); }
    }
    GLA_BAR();
}

__device__ __forceinline__ void gla_prep(const Params& p, unsigned char* lds, int l, int item, int tid) {
    unsigned char* ws = p.ws;
    GlaPrepCtx c;
    c.tid = tid; c.wid = __builtin_amdgcn_readfirstlane(tid >> 6); const int lane = tid & 63; c.lr = lane & 15; c.q4 = lane >> 4;
    c.b = item >> 3; c.h = (item >> 1) & 3; c.dir = item & 1; const int dir = c.dir;
    c.Z = (const bf16_t*)(ws + WS_Z); c.DEC = (const bf16_t*)(ws + WS_DEC);
    unsigned* flags = (unsigned*)(ws + WS_CTL);
    c.myflag = flags + (size_t)(l * 128 + item) * 64; c.paflag = flags + (size_t)(l * 128 + (item ^ 1)) * 64;
    c.qin = (bf16_t*)(lds + L_QIN); c.kin = (bf16_t*)(lds + L_KIN); c.qout = (bf16_t*)(lds + L_QOUT); c.koutT = (bf16_t*)(lds + L_KOUTT);
    c.decs = (float*)(lds + L_DEC);
    c.qraw = (bf16_t*)(lds + L_QRAW); c.kraw = (bf16_t*)(lds + L_KRAW); c.araw = (bf16_t*)(lds + L_ARAW); c.vraw = (bf16_t*)(lds + L_VRAW);
    c.lrow = tid >> 3; c.lcs = (tid & 7) * 8; c.vrow = tid >> 4; c.vcs = (tid & 15) * 8; c.arow = tid >> 1; c.acs = (tid & 1) * 8;
    c.ch = 16 * c.wid + c.lr;
    { const float* w2 = (dir ? p.w_a2_bwd : p.w_a2_fwd) + (size_t)l * 16 * 256 + c.h * 64 + c.ch; u32x4 w = (u32x4){0u, 0u, 0u, 0u};
      if (c.q4 < 2) { float t[8];
#pragma unroll
          for (int i = 0; i < 8; ++i) t[i] = w2[(8 * c.q4 + i) * 256];
          w.x = cvt_pk_bf16(t[0], t[1]); w.y = cvt_pk_bf16(t[2], t[3]); w.z = cvt_pk_bf16(t[4], t[5]); w.w = cvt_pk_bf16(t[6], t[7]); }
      c.w2f = __builtin_bit_cast(bf16x8, w); c.bias = (dir ? p.b_a_bwd : p.b_a_fwd)[l * 256 + c.h * 64 + c.ch]; }
    GlaRegs RA, RB;
    gla_load_qka(c, 0, RA); gla_store_qka(c, RA);
    gla_load_qka(c, 1, RB); gla_load_v(c, 0, RB);
    GLA_BAR();
    for (int s = -1; s < 63; s += 2) { gla_prep_step(c, s, RA, RB); gla_prep_step(c, s + 1, RB, RA); }
    gla_prep_step(c, 63, RA, RB);
}
#undef ST8_

__device__ __forceinline__ void gla_mma(const Params& p, unsigned char* lds, int l, int item, int tid) {
    unsigned char* ws = p.ws;
    const int wid = __builtin_amdgcn_readfirstlane(tid >> 6), lane = tid & 63, lr = lane & 15, q4 = lane >> 4;
    const int b = item >> 3, h = (item >> 1) & 3, dir = item & 1;
    const bf16_t* Z = (const bf16_t*)(ws + WS_Z); bf16_t* OX = (bf16_t*)(ws + WS_OX); bf16_t* MIX = (bf16_t*)(ws + WS_MIX);
    const bf16_t* qin = (const bf16_t*)(lds + L_QIN); const bf16_t* kin = (const bf16_t*)(lds + L_KIN); const bf16_t* qout = (const bf16_t*)(lds + L_QOUT); const bf16_t* koutT = (const bf16_t*)(lds + L_KOUTT);
    const float* decs = (const float*)(lds + L_DEC); float* red = (float*)(lds + L_RED); const bf16_t* vraw = (const bf16_t*)(lds + L_VRAW);
    const int vq = wid & 3;
    const int ocol = h * 128 + 32 * vq + 8 * q4;
    f32x4 ng[2];
#pragma unroll
    for (int vb = 0; vb < 2; ++vb) ng[vb] = *(const f32x4*)(p.gla_norm_g + (size_t)l * 512 + ocol + 4 * vb);
    f32x4 accS[2][4];
#pragma unroll
    for (int vb = 0; vb < 2; ++vb)
#pragma unroll
        for (int i = 0; i < 4; ++i) accS[vb][i] = (f32x4){0.f, 0.f, 0.f, 0.f};
    GLA_BAR();
    for (int s = -1; s < 64; ++s) {
        const int tok0 = b * SEQ + CHUNK(s < 0 ? 0 : s) * 64;
#define TOK(c) (tok0 + (dir ? 63 - (c) : (c)))
        if (s == 32) __syncthreads();
        f32x4 accO[2][4]; u32x4 gw[4];
        if (s >= 0) {
            u32x4 ox[4];
            bf16x8 vfrag[2][2];
#pragma unroll
            for (int vb = 0; vb < 2; ++vb)
#pragma unroll
                for (int pp = 0; pp < 2; ++pp)
#pragma unroll
                    for (int i = 0; i < 8; ++i) { const int pos = 32 * pp + 4 * q4 + (i & 3) + ((i >> 2) << 4); vfrag[vb][pp][i] = (short)vraw[pos * VP + 32 * vq + 8 * (lr >> 2) + 4 * vb + (lr & 3)]; }
            bf16x8 qf[4][2], kf[4][2];
#pragma unroll
            for (int cb = 0; cb < 4; ++cb) { qf[cb][0] = *(const bf16x8*)(qin + (16 * cb + lr) * GP + ((8 * q4 + 16 * cb) & 63)); qf[cb][1] = *(const bf16x8*)(qin + (16 * cb + lr) * GP + ((32 + 8 * q4 + 16 * cb) & 63));
                kf[cb][0] = *(const bf16x8*)(kin + (16 * cb + lr) * GP + ((8 * q4 + 16 * cb) & 63)); kf[cb][1] = *(const bf16x8*)(kin + (16 * cb + lr) * GP + ((32 + 8 * q4 + 16 * cb) & 63)); }
            bf16x8 P0[4], P1[2];
            {
                f32x4 sc[4][4];
#pragma unroll
                for (int cb = 0; cb < 4; ++cb)
#pragma unroll
                    for (int jb = 0; jb < 4; ++jb) {
                        if (jb > cb) { sc[jb][cb] = (f32x4){0.f, 0.f, 0.f, 0.f}; continue; }
                        f32x4 a = (f32x4){0.f, 0.f, 0.f, 0.f};
                        a = __builtin_amdgcn_mfma_f32_16x16x32_bf16(kf[jb][0], qf[cb][0], a, 0, 0, 0);
                        sc[jb][cb] = a;
                    }
#pragma unroll
                for (int cb = 0; cb < 4; ++cb)
#pragma unroll
                    for (int jb = 0; jb <= cb; ++jb) sc[jb][cb] = __builtin_amdgcn_mfma_f32_16x16x32_bf16(kf[jb][1], qf[cb][1], sc[jb][cb], 0, 0, 0);
            __builtin_amdgcn_sched_barrier(0);
            if (s >= 32) {
#pragma unroll
                for (int cb = 0; cb < 4; ++cb) { const size_t tk = (size_t)TOK(16 * cb + lr); ox[cb] = *(const u32x4*)(OX + tk * 512 + ocol); gw[cb] = *(const u32x4*)(Z + tk * ZW + ZG + ocol); }
            }
#pragma unroll
                for (int cb = 0; cb < 4; ++cb) {
#pragma unroll
                    for (int jj = 0; jj < 4; ++jj) { const int j = 4 * q4 + jj; const bool keep = dir ? (lr > j) : (lr >= j); sc[cb][cb][jj] = keep ? sc[cb][cb][jj] : 0.f; }
                    { u32x4 w; w.x = cvt_pk_bf16(sc[0][cb][0], sc[0][cb][1]); w.y = cvt_pk_bf16(sc[0][cb][2], sc[0][cb][3]); w.z = cvt_pk_bf16(sc[1][cb][0], sc[1][cb][1]); w.w = cvt_pk_bf16(sc[1][cb][2], sc[1][cb][3]); P0[cb] = __builtin_bit_cast(bf16x8, w); }
                    if (cb >= 2) { u32x4 w; w.x = cvt_pk_bf16(sc[2][cb][0], sc[2][cb][1]); w.y = cvt_pk_bf16(sc[2][cb][2], sc[2][cb][3]); w.z = cvt_pk_bf16(sc[3][cb][0], sc[3][cb][1]); w.w = cvt_pk_bf16(sc[3][cb][2], sc[3][cb][3]); P1[cb - 2] = __builtin_bit_cast(bf16x8, w); }
                }
            }
            bf16x8 qo[4][2];
#pragma unroll
            for (int cb = 0; cb < 4; ++cb)
#pragma unroll
                for (int pp = 0; pp < 2; ++pp) { const bf16_t* qr = qout + (16 * cb + lr) * GP; const u32x2 lo = *(const u32x2*)(qr + ((32 * pp + 4 * q4 + 16 * cb) & 63)), hi = *(const u32x2*)(qr + ((32 * pp + 4 * q4 + 16 + 16 * cb) & 63)); qo[cb][pp] = __builtin_bit_cast(bf16x8, ((u32x4){lo.x, lo.y, hi.x, hi.y})); }
            bf16x8 Sp[2][2];
#pragma unroll
            for (int vb = 0; vb < 2; ++vb)
#pragma unroll
                for (int pp = 0; pp < 2; ++pp) { u32x4 w; w.x = cvt_pk_bf16(accS[vb][2 * pp][0], accS[vb][2 * pp][1]); w.y = cvt_pk_bf16(accS[vb][2 * pp][2], accS[vb][2 * pp][3]);
                    w.z = cvt_pk_bf16(accS[vb][2 * pp + 1][0], accS[vb][2 * pp + 1][1]); w.w = cvt_pk_bf16(accS[vb][2 * pp + 1][2], accS[vb][2 * pp + 1][3]); Sp[vb][pp] = __builtin_bit_cast(bf16x8, w); }
#pragma unroll
            for (int cb = 0; cb < 4; ++cb)
#pragma unroll
                for (int vb = 0; vb < 2; ++vb) {
                    f32x4 a = (f32x4){0.f, 0.f, 0.f, 0.f};
                    a = __builtin_amdgcn_mfma_f32_16x16x32_bf16(Sp[vb][0], qo[cb][0], a, 0, 0, 0);
                    accO[vb][cb] = a; }
#pragma unroll
            for (int cb = 0; cb < 4; ++cb)
#pragma unroll
                for (int vb = 0; vb < 2; ++vb) accO[vb][cb] = __builtin_amdgcn_mfma_f32_16x16x32_bf16(Sp[vb][1], qo[cb][1], accO[vb][cb], 0, 0, 0);
#pragma unroll
            for (int cb = 0; cb < 4; ++cb)
#pragma unroll
                for (int vb = 0; vb < 2; ++vb) accO[vb][cb] = __builtin_amdgcn_mfma_f32_16x16x32_bf16(vfrag[vb][0], P0[cb], accO[vb][cb], 0, 0, 0);
#pragma unroll
            for (int cb = 2; cb < 4; ++cb)
#pragma unroll
                for (int vb = 0; vb < 2; ++vb) accO[vb][cb] = __builtin_amdgcn_mfma_f32_16x16x32_bf16(vfrag[vb][1], P1[cb - 2], accO[vb][cb], 0, 0, 0);
            __builtin_amdgcn_sched_barrier(0);
            bf16x8 ko[4][2]; f32x4 dv[4];
#pragma unroll
            for (int kb = 0; kb < 4; ++kb) { dv[kb] = *(const f32x4*)(decs + 16 * kb + 4 * q4);
#pragma unroll
                for (int pp = 0; pp < 2; ++pp) { const bf16_t* kp = koutT + (16 * kb + lr) * GP + 32 * pp + 4 * q4; const u32x2 lo = *(const u32x2*)kp, hi = *(const u32x2*)(kp + 16); ko[kb][pp] = __builtin_bit_cast(bf16x8, ((u32x4){lo.x, lo.y, hi.x, hi.y})); } }
#pragma unroll
            for (int kb = 0; kb < 4; ++kb)
#pragma unroll
                for (int vb = 0; vb < 2; ++vb) accS[vb][kb] = __builtin_amdgcn_mfma_f32_16x16x32_bf16(ko[kb][0], vfrag[vb][0], accS[vb][kb] * dv[kb], 0, 0, 0);
#pragma unroll
            for (int kb = 0; kb < 4; ++kb)
#pragma unroll
                for (int vb = 0; vb < 2; ++vb) accS[vb][kb] = __builtin_amdgcn_mfma_f32_16x16x32_bf16(ko[kb][1], vfrag[vb][1], accS[vb][kb], 0, 0, 0);
            if (s < 32) {
#pragma unroll
                for (int cb = 0; cb < 4; ++cb) { const f32x4 o0 = accO[0][cb], o1 = accO[1][cb]; *(u32x4*)(OX + (size_t)TOK(16 * cb + lr) * 512 + ocol) = (u32x4){cvt_pk_bf16(o0[0], o0[1]), cvt_pk_bf16(o0[2], o0[3]), cvt_pk_bf16(o1[0], o1[1]), cvt_pk_bf16(o1[2], o1[3])}; }
            } else {
#pragma unroll
                for (int cb = 0; cb < 4; ++cb) { float ss = 0.f;
#pragma unroll
                    for (int vb = 0; vb < 2; ++vb) { const unsigned xa = vb ? ox[cb].z : ox[cb].x, xb2 = vb ? ox[cb].w : ox[cb].y; accO[vb][cb] += (f32x4){bflo(xa), bfhi(xa), bflo(xb2), bfhi(xb2)}; const f32x4 o = accO[vb][cb]; ss += (o[0] * o[0] + o[1] * o[1]) + (o[2] * o[2] + o[3] * o[3]); }
                    ss += __shfl_xor(ss, 16); ss += __shfl_xor(ss, 32);
                    if (q4 == 0) red[vq * 64 + 16 * cb + lr] = ss; }
            }
        }
        GLA_BAR();
        if (s >= 32) {
#pragma unroll
            for (int cb = 0; cb < 4; ++cb) { const float ss = (red[16 * cb + lr] + red[64 + 16 * cb + lr]) + (red[128 + 16 * cb + lr] + red[192 + 16 * cb + lr]);
                const float rs = rsqrtf(ss * (1.0f / 128.0f) + EPS); const size_t tk = (size_t)TOK(16 * cb + lr);
                const f32x4 o0 = accO[0][cb] * rs * ng[0], o1 = accO[1][cb] * rs * ng[1]; const u32x4 g4 = gw[cb];
                u32x4 w; w.x = cvt_pk_bf16(o0[0] * bflo(g4.x), o0[1] * bfhi(g4.x)); w.y = cvt_pk_bf16(o0[2] * bflo(g4.y), o0[3] * bfhi(g4.y)); w.z = cvt_pk_bf16(o1[0] * bflo(g4.z), o1[1] * bfhi(g4.z)); w.w = cvt_pk_bf16(o1[2] * bflo(g4.w), o1[3] * bfhi(g4.w));
                *(u32x4*)(MIX + tk * D + ocol) = w; }
        }
        if (s == 31) { asm volatile("s_waitcnt vmcnt(0)" ::: "memory"); __syncthreads(); }
        GLA_BAR();
#undef TOK
    }
}
#undef CHUNK
#undef POS

PHASE_FN void gla_item(const Params& p, unsigned char* lds, int l, int item) {
    int tid = threadIdx.x; asm volatile("" : "+v"(tid));
    if (tid < 256) gla_prep(p, lds, l, item, tid); else gla_mma(p, lds, l, item, tid);
    __syncthreads();
}

constexpr int SP = 136;
constexpr int L_SW = 0;
constexpr int L_SV0 = 128 * SP * 2;
constexpr int L_SV1 = 2 * 128 * SP * 2;
PHASE_FN void sgu_block(const Params& p, unsigned char* lds, int l, int g, int ch0, int nch) {
    unsigned char* ws = p.ws;
    int tid = threadIdx.x; asm volatile("" : "+v"(tid));
    const int wid = __builtin_amdgcn_readfirstlane(tid >> 6), lane = tid & 63, lr = lane & 15, q4 = lane >> 4;
    const bf16_t* __restrict__ Z = (const bf16_t*)(ws + WS_Z); bf16_t* __restrict__ MIX = (bf16_t*)(ws + WS_MIX);
    const bf16_t* __restrict__ wsb = (const bf16_t*)(ws + WS_WSB) + (size_t)(l * 4 + g) * 128 * 128;
    bf16_t* wl = (bf16_t*)(lds + L_SW);
    const int lrow = tid >> 4, cs = (tid & 15) * 8;
#pragma unroll
    for (int i = 0; i < 4; ++i) *(u32x4*)(wl + (lrow + 32 * i) * SP + cs) = *(const u32x4*)(wsb + (size_t)(lrow + 32 * i) * 128 + cs);
    const float* ngp = p.sgu_norm_g + (size_t)l * 512 + g * 128 + cs; const f32x4 g0 = *(const f32x4*)ngp, g1 = *(const f32x4*)(ngp + 4);
    float bs[8];
#pragma unroll
    for (int pb = 0; pb < 8; ++pb) bs[pb] = p.b_s[(size_t)l * 512 + g * 128 + 16 * pb + lr];
    const int ocol = g * 128 + 16 * wid + 4 * q4;
    u32x4 pv[4];
#define SGU_LOAD(ch) do { _Pragma("unroll") for (int i = 0; i < 4; ++i) pv[i] = *(const u32x4*)(Z + (size_t)((ch) * 128 + lrow + 32 * i) * ZW + ZSV + g * 128 + cs); } while (0)
    SGU_LOAD(ch0);
    int buf = 0;
    for (int ch = ch0; ch < ch0 + nch; ++ch, buf ^= 1) {
        const int tok0 = ch * 128;
        bf16_t* vt = (bf16_t*)(lds + (buf ? L_SV1 : L_SV0));
#pragma unroll
        for (int i = 0; i < 4; ++i) { const u32x4 w = pv[i];
            float v[8];
            { const f32x2 a = gelu_pk((f32x2){bflo(w.x), bfhi(w.x)}), b2 = gelu_pk((f32x2){bflo(w.y), bfhi(w.y)}), c = gelu_pk((f32x2){bflo(w.z), bfhi(w.z)}), d = gelu_pk((f32x2){bflo(w.w), bfhi(w.w)});
              v[0] = a.x; v[1] = a.y; v[2] = b2.x; v[3] = b2.y; v[4] = c.x; v[5] = c.y; v[6] = d.x; v[7] = d.y; }
            float ss = 0.f;
#pragma unroll
            for (int k = 0; k < 8; ++k) ss += v[k] * v[k];
            ss += __shfl_xor(ss, 1); ss += __shfl_xor(ss, 2); ss += __shfl_xor(ss, 4); ss += __shfl_xor(ss, 8);
            const float rs = rsqrtf(ss * (1.0f / 128.0f) + EPS);
            u32x4 o; o.x = cvt_pk_bf16(v[0] * rs * g0[0], v[1] * rs * g0[1]); o.y = cvt_pk_bf16(v[2] * rs * g0[2], v[3] * rs * g0[3]);
            o.z = cvt_pk_bf16(v[4] * rs * g1[0], v[5] * rs * g1[1]); o.w = cvt_pk_bf16(v[6] * rs * g1[2], v[7] * rs * g1[3]);
            *(u32x4*)(vt + (lrow + 32 * i) * SP + cs) = o; }
        if (ch + 1 < ch0 + nch) SGU_LOAD(ch + 1);
        u32x2 uw[8];
#pragma unroll
        for (int pb = 0; pb < 8; ++pb) uw[pb] = *(const u32x2*)(Z + (size_t)(tok0 + 16 * pb + lr) * ZW + ZSU + ocol);
        asm volatile("s_waitcnt lgkmcnt(0)" ::: "memory"); __builtin_amdgcn_s_barrier(); asm volatile("" ::: "memory");
        bf16x8 af[4];
#pragma unroll
        for (int ks = 0; ks < 4; ++ks)
#pragma unroll
            for (int i = 0; i < 8; ++i) af[ks][i] = (short)vt[(32 * ks + 8 * q4 + i) * SP + 16 * wid + lr];
#pragma unroll
        for (int pb = 0; pb < 8; ++pb) {
            f32x4 a = (f32x4){0.f, 0.f, 0.f, 0.f};
#pragma unroll
            for (int ks = 0; ks < 4; ++ks) { const bf16x8 bf = *(const bf16x8*)(wl + (16 * pb + lr) * SP + 32 * ks + 8 * q4); a = __builtin_amdgcn_mfma_f32_16x16x32_bf16(af[ks], bf, a, 0, 0, 0); }
            const f32x2 u0 = gelu_pk((f32x2){bflo(uw[pb].x), bfhi(uw[pb].x)}), u1 = gelu_pk((f32x2){bflo(uw[pb].y), bfhi(uw[pb].y)});
            u32x2 w; w.x = cvt_pk_bf16((a[0] + bs[pb]) * u0.x, (a[1] + bs[pb]) * u0.y); w.y = cvt_pk_bf16((a[2] + bs[pb]) * u1.x, (a[3] + bs[pb]) * u1.y);
            *(u32x2*)(MIX + (size_t)(tok0 + 16 * pb + lr) * D + 512 + ocol) = w;
        }
    }
#undef SGU_LOAD
    __syncthreads();
}

#define XB_TMO      128
#define XB_XCNT(j)  (256  + 64 * (j))
#define XB_XSUB(j)  (1280 + 64 * (j))
#define XB_XGEN(j)  (2304 + 64 * (j))
#define XB_TOP      3328
#define XB_TOPGEN   3392
#define XCD_BAR_WORDS 3456
#define XB_SPIN_CAP (1u << 18)

__device__ __forceinline__ unsigned xb_ld(unsigned* p)              { return __hip_atomic_load(p, __ATOMIC_RELAXED, __HIP_MEMORY_SCOPE_AGENT); }
__device__ __forceinline__ unsigned xb_add(unsigned* p, unsigned v) { return __hip_atomic_fetch_add(p, v, __ATOMIC_RELAXED, __HIP_MEMORY_SCOPE_AGENT); }
__device__ __forceinline__ unsigned xb_xcc_id() { return (unsigned)__builtin_amdgcn_s_getreg((3 << 11) | 20) & 0xFu; }
#define XB_SPIN(cond, bar) do { unsigned _sp = 0; while (cond) { __builtin_amdgcn_s_sleep(1); \
    if ((++_sp & 255u) == 0u) { if (xb_ld(&(bar)[XB_TMO])) break; if (_sp > XB_SPIN_CAP) { atomicAdd(&(bar)[XB_TMO], 1u); break; } } } } while (0)

struct XcdBarrier {
    unsigned* bar; unsigned x;
    volatile LAS unsigned* st;
};

__device__ __forceinline__ XcdBarrier xcd_barrier_post(unsigned* bar, volatile LAS unsigned* st) {
    XcdBarrier b; b.bar = bar; b.x = xb_xcc_id(); b.st = st;
    if (threadIdx.x == 0) (void)xb_add(&bar[XB_XCNT(b.x)], 1u);
    return b;
}
__device__ __forceinline__ void xcd_barrier_complete(unsigned* bar, unsigned x, unsigned& nloc, unsigned& nx) {
    const unsigned G = gridDim.x * gridDim.y * gridDim.z;
    unsigned sum, cnt, mine, sp = 0u;
    for (;;) {
        sum = 0u; cnt = 0u; mine = 0u;
#pragma unroll
        for (unsigned j = 0; j < 16; ++j) { const unsigned c = xb_ld(&bar[XB_XCNT(j)]); sum += c; cnt += (c > 0u) ? 1u : 0u; mine = (j == x) ? c : mine; }
        if (sum == G) break;
        __builtin_amdgcn_s_sleep(1);
        if ((++sp & 255u) == 0u) { if (xb_ld(&bar[XB_TMO])) break; if (sp > XB_SPIN_CAP) { atomicAdd(&bar[XB_TMO], 1u); break; } }
    }
    nloc = mine > 0u ? mine : 1u; nx = cnt > 0u ? cnt : 1u;
}

__device__ __forceinline__ void xcd_barrier(const XcdBarrier& b) {
    asm volatile("s_waitcnt vmcnt(0)" ::: "memory");
    __syncthreads();
    if (threadIdx.x == 0) {
        unsigned* bar = b.bar;
        __builtin_amdgcn_s_waitcnt(0);
        unsigned nloc = b.st[0], nx = b.st[1];
        if (nloc == 0u) { xcd_barrier_complete(bar, b.x, nloc, nx); b.st[0] = nloc; b.st[1] = nx; }
        const unsigned old = xb_add(&bar[XB_XSUB(b.x)], 1u);
        const unsigned gen = old / nloc;
        if (old + 1u == (gen + 1u) * nloc) {
            __builtin_amdgcn_fence(__ATOMIC_RELEASE, "agent");
            asm volatile("s_waitcnt vmcnt(0)" ::: "memory");
            const unsigned og = xb_add(&bar[XB_TOP], 1u);
            const unsigned tg = og / nx;
            if (og + 1u == (tg + 1u) * nx) xb_add(&bar[XB_TOPGEN], 1u);
            else XB_SPIN(xb_ld(&bar[XB_TOPGEN]) == tg, bar);
            __builtin_amdgcn_fence(__ATOMIC_ACQUIRE, "agent");
            xb_add(&bar[XB_XGEN(b.x)], 1u);
            asm volatile("s_waitcnt vmcnt(0)" ::: "memory");
        } else {
            XB_SPIN(xb_ld(&bar[XB_XGEN(b.x)]) == gen, bar);
            __builtin_amdgcn_fence(__ATOMIC_ACQUIRE, "agent");
            asm volatile("s_waitcnt vmcnt(0)" ::: "memory");
        }
    }
    __syncthreads();
}

template <class Epi>
PHASE_FN void gemm_call(LAS unsigned char* ldsl, const bf16_t* A, const bf16_t* Bt, int N, int K, Epi E, int smode = 0, int sbase = 0) {
    pg8::Gemm g{A, Bt, T, N, K}; pg8::StaticOrder S; S.init(T, N, (int)gridDim.x, (int)blockIdx.x); S.mode = smode; S.base = sbase;
    pg8::gemm_phase<Epi, pg8::StaticOrder, true, true>(ldsl, g, S, E);
}
__global__ void __launch_bounds__(512, 2) fwd_megakernel(Params p) {
    extern __shared__ __attribute__((aligned(16))) unsigned char lds[];
    cg::grid_group grid = cg::this_grid();
    unsigned char* ws = p.ws;
    const int G = gridDim.x, bx = blockIdx.x;
    bf16_t* XB = (bf16_t*)(ws + WS_XB); float* SSQ = (float*)(ws + WS_SSQ); bf16_t* Zb = (bf16_t*)(ws + WS_Z); bf16_t* DECb = (bf16_t*)(ws + WS_DEC);
    bf16_t* MIXb = (bf16_t*)(ws + WS_MIX); bf16_t* HID = (bf16_t*)(ws + WS_HID);
    LAS unsigned char* ldsl = (LAS unsigned char*)lds;
    volatile LAS unsigned* xst = (volatile LAS unsigned*)(ldsl + 131072 + 320);
    if (threadIdx.x < 4) xst[threadIdx.x] = 0u;
    __syncthreads();
    const XcdBarrier xbar = xcd_barrier_post((unsigned*)(ws + WS_CTL + 512 * 1024), xst);

#ifndef NO_PREP
    phase_prep(p, (float*)lds);
#endif
    asm volatile("s_waitcnt vmcnt(0)" ::: "memory"); __syncthreads();
    __threadfence();
    grid.sync();
    for (int l = 0; l < DEPTH; ++l) {
        for (int part = 0; part < 2; ++part) {
            if (part == 1 && bx < 128) break;
            gemm_call<pg8::EpiZ>(ldsl, XB, (const bf16_t*)(ws + WS_WIN) + (size_t)l * ZW * D, part == 0 ? ZN_A : ZW, D, pg8::EpiZ{Zb, DECb, SSQ, (LAS float*)(ldsl + 131072 + 1024), -1}, part, 2 * (bx - 128));
            if (part == 0) xcd_barrier(xbar);
        }
        if (bx < 128) gla_item(p, lds, l, bx);
        else if (bx < 256) {
            __builtin_amdgcn_fence(__ATOMIC_ACQUIRE, "agent"); asm volatile("s_waitcnt vmcnt(0)" ::: "memory"); __syncthreads();
            for (int g = 0; g < 4; ++g) sgu_block(p, lds, l, g, 4 * (bx - 128), 4);
        }
        xcd_barrier(xbar);
#ifndef NO_G2
        gemm_call<pg8::EpiRes>(ldsl, MIXb, (const bf16_t*)(ws + WS_WOUT) + (size_t)l * D * D, D, D, pg8::EpiRes{p.x, p.out, XB, SSQ, l == 0 ? 1 : 0});
#endif
        xcd_barrier(xbar);
#ifndef NO_G3
        gemm_call<pg8::EpiH>(ldsl, XB, (const bf16_t*)(ws + WS_W1) + (size_t)l * FF * D, FF, D, pg8::EpiH{HID, SSQ, (LAS float*)(ldsl + 131072 + 1024), -1});
#endif
        xcd_barrier(xbar);
#ifndef NO_G4
        gemm_call<pg8::EpiRes>(ldsl, HID, (const bf16_t*)(ws + WS_W2) + (size_t)l * D * FF, D, FF, pg8::EpiRes{p.x, p.out, XB, SSQ, 0});
#endif
        xcd_barrier(xbar);
    }
    { const int tid = threadIdx.x;
      for (size_t i = ((size_t)bx * 512 + tid) * 8; i < (size_t)T * D; i += (size_t)G * 512 * 8) {
          const int r = (int)(i >> 10), c = (int)(i & 1023);
          const float* sp = SSQ + (size_t)r * 16; float s = 0.f;
#pragma unroll
          for (int j = 0; j < 4; ++j) { const f32x4 q = *(const f32x4*)(sp + 4 * j); s += (q[0] + q[1]) + (q[2] + q[3]); }
          const float rs = rsqrtf(s * (1.0f / 1024.0f) + EPS);
          const u32x4 w = *(const u32x4*)(XB + i); const f32x4 g0 = *(const f32x4*)(p.final_norm_g + c), g1 = *(const f32x4*)(p.final_norm_g + c + 4);
          *(f32x4*)(p.out + i) = (f32x4){bflo(w.x), bfhi(w.x), bflo(w.y), bfhi(w.y)} * rs * g0;
          *(f32x4*)(p.out + i + 4) = (f32x4){bflo(w.z), bfhi(w.z), bflo(w.w), bfhi(w.w)} * rs * g1; } }
}

extern "C" void kernel_launch(void* const* d_in, const int* in_sizes, int n_in, void* d_out, int out_size, void* d_ws, size_t ws_size, hipStream_t stream) {
    static int grid = 0;
    if (grid == 0) {
        if (n_in != 16 || out_size != T * D || ws_size < WS_END) { fprintf(stderr, "kernel_launch: unexpected shapes: n_in %d out %d ws %zu (need %zu)\n", n_in, out_size, ws_size, (size_t)WS_END); grid = -1; return; }
        int dev = 0, cus = 0, per_cu = 0;
        (void)hipGetDevice(&dev); (void)hipDeviceGetAttribute(&cus, hipDeviceAttributeMultiprocessorCount, dev);
        if (hipFuncSetAttribute((const void*)fwd_megakernel, hipFuncAttributeMaxDynamicSharedMemorySize, LDS_BYTES) != hipSuccess) { fprintf(stderr, "kernel_launch: hipFuncSetAttribute failed\n"); grid = -1; return; }
        (void)hipOccupancyMaxActiveBlocksPerMultiprocessor(&per_cu, (const void*)fwd_megakernel, 512, LDS_BYTES);
        (void)hipGetLastError();
        if (per_cu < 1) { fprintf(stderr, "kernel_launch: occupancy query says %d blocks per CU\n", per_cu); per_cu = 1; }
        grid = cus;
        if (grid < 256) { fprintf(stderr, "kernel_launch: %d CUs; this kernel's mixer phase needs a grid of at least 256\n", grid); }
    }
    if (grid < 0) return;
    (void)hipMemsetAsync((char*)d_ws + WS_CTL, 0, CTL_BYTES, stream);
    Params p{};
    p.x = (const float*)d_in[0]; p.norm_mix_g = (const float*)d_in[1]; p.w_in = (const float*)d_in[2]; p.w_a2_fwd = (const float*)d_in[3]; p.b_a_fwd = (const float*)d_in[4];
    p.w_a2_bwd = (const float*)d_in[5]; p.b_a_bwd = (const float*)d_in[6]; p.gla_norm_g = (const float*)d_in[7]; p.sgu_norm_g = (const float*)d_in[8]; p.w_s = (const float*)d_in[9];
    p.b_s = (const float*)d_in[10]; p.w_out = (const float*)d_in[11]; p.norm_mlp_g = (const float*)d_in[12]; p.w_mlp1 = (const float*)d_in[13]; p.w_mlp2 = (const float*)d_in[14];
    p.final_norm_g = (const float*)d_in[15]; p.out = (float*)d_out; p.ws = (unsigned char*)d_ws;
    void* args[] = {&p};
    hipError_t e = hipLaunchCooperativeKernel((const void*)fwd_megakernel, dim3(grid), dim3(512), args, LDS_BYTES, stream);
    if (e != hipSuccess) fprintf(stderr, "cooperative launch failed: %s (grid %d)\n", hipGetErrorString(e), grid);
}
```

```cpp
#include <hip/hip_runtime.h>
#include <hip/hip_cooperative_groups.h>
#include <cstdio>
namespace cg = cooperative_groups;

#define LAS __attribute__((address_space(3)))
#ifndef PHASE_FN
#define PHASE_FN __device__ __forceinline__
#endif
typedef unsigned short bf16_t;
typedef short bf16x8 __attribute__((ext_vector_type(8)));
typedef short bf16x4 __attribute__((ext_vector_type(4)));
typedef float f32x4 __attribute__((ext_vector_type(4)));
typedef float f32x2 __attribute__((ext_vector_type(2)));
typedef unsigned u32x4 __attribute__((ext_vector_type(4)));
typedef unsigned u32x2 __attribute__((ext_vector_type(2)));

constexpr int T = 65536, D = 1024, FF = 4096, SEQ = 4096, DEPTH = 4;
constexpr int ZW = 2816;
constexpr int D_IN = 2592;
constexpr float EPS = 1e-6f;
constexpr int ZQ = 0, ZK = 256, ZV = 512, ZG = 1024, ZSU = 1536, ZSV = 2304;
constexpr int ZN_A = 2304;

constexpr size_t MiB = 1u << 20;
constexpr size_t WS_CTL = 0, CTL_BYTES = 1 * MiB;
constexpr size_t WS_WIN = 1 * MiB;
constexpr size_t WS_WOUT = 23 * MiB;
constexpr size_t WS_W1 = 31 * MiB;
constexpr size_t WS_W2 = 63 * MiB;
constexpr size_t WS_WSB = 95 * MiB;
constexpr size_t WS_SSQ = 96 * MiB;
constexpr size_t WS_DEC = 100 * MiB;
constexpr size_t WS_XB = 108 * MiB;
constexpr size_t WS_Z = 236 * MiB;
constexpr size_t WS_MIX = 588 * MiB;
constexpr size_t WS_OX = 716 * MiB;
constexpr size_t WS_HID = 236 * MiB;
constexpr size_t WS_END = 844 * MiB;
constexpr int LDS_BYTES = 147456;

struct Params {
    const float* x; const float* norm_mix_g; const float* w_in; const float* w_a2_fwd; const float* b_a_fwd; const float* w_a2_bwd; const float* b_a_bwd;
    const float* gla_norm_g; const float* sgu_norm_g; const float* w_s; const float* b_s; const float* w_out; const float* norm_mlp_g; const float* w_mlp1;
    const float* w_mlp2; const float* final_norm_g; float* out; unsigned char* ws;
};

__device__ __forceinline__ unsigned cvt_pk_bf16(float lo, float hi) { unsigned r; asm volatile("v_cvt_pk_bf16_f32 %0, %1, %2" : "=v"(r) : "v"(lo), "v"(hi)); return r; }
__device__ __forceinline__ float bf2f(unsigned short b) { return __uint_as_float(((unsigned)b) << 16); }
__device__ __forceinline__ float bflo(unsigned w) { return __uint_as_float(w << 16); }
__device__ __forceinline__ float bfhi(unsigned w) { return __uint_as_float(w & 0xffff0000u); }

__device__ __forceinline__ f32x2 gelu_pk(f32x2 v) {
    const f32x2 av = __builtin_elementwise_abs(v), d = av * 0.2316418882f + 1.0f;
    f32x2 t; t.x = __builtin_amdgcn_rcpf(d.x); t.y = __builtin_amdgcn_rcpf(d.y);
    f32x2 q = t * 0.5307027145f + (-0.7265760135f); q = q * t + 0.7107068705f; q = q * t + (-0.142248368f); q = q * t + 0.127414796f; q = q * t;
    const f32x2 s = (v * v) * (-0.72134752044f);
    f32x2 e; e.x = __builtin_amdgcn_exp2f(s.x); e.y = __builtin_amdgcn_exp2f(s.y);
    const f32x2 m = v * (q * e), r = v - m;
    f32x2 o; o.x = v.x < 0.f ? m.x : r.x; o.y = v.y < 0.f ? m.y : r.y; return o;
}
__device__ __forceinline__ float silu_f(float v) { return v * __builtin_amdgcn_rcpf(1.0f + __expf(-v)); }

namespace pg8 {
constexpr int BM = 256, BK = 64, HALF = 128, HTB = HALF * BK * 2, STAGE_BYTES = 8 * HTB, NXCD = 8, WGM = 8;
__host__ __device__ __forceinline__ int lds_byte(int r, int c) { const int st = (r >> 4) * 2 + (c >> 5), rr = r & 15, cc = c & 31, ob = rr * 64 + cc * 2; return st * 1024 + (ob ^ (((ob >> 9) & 1) << 5)); }
__host__ __device__ __forceinline__ void stage_rc(int b, int& R, int& C) { const int st = b / 1024, sb = b % 1024, swz = sb ^ (((sb >> 9) & 1) << 5); R = (st >> 1) * 16 + swz / 64; C = (st & 1) * 32 + (swz % 64) / 2; }
__host__ __device__ __forceinline__ int perm32(int rho) { const int n = rho >> 4, i = rho & 15; return 8 * (i >> 2) + 4 * n + (i & 3); }
struct Unit { int pm, pn; };
struct Gemm { const bf16_t* A; const bf16_t* Bt; int M, N, K; };
struct StaticOrder {
    int nM, nN, nwg, G, c, mode, base;
    __device__ void init(int M, int N, int G_, int c_) { nM = M / BM; nN = N / BM; nwg = nM * nN; G = G_; c = c_; mode = 0; base = 0; }
    __device__ bool next(int i, Unit& u) const {
        if (mode == 1) { if (i >= 4) return false; u.pm = base + (i >> 1); u.pn = 9 + (i & 1); return true; }
        const long L = (long)i * G + c; if (L >= nwg) return false;
        int wgid = (int)L; { const int q = nwg / NXCD, r = nwg % NXCD, xcd = wgid % NXCD, off = wgid / NXCD; wgid = (xcd < r ? xcd * (q + 1) : r * (q + 1) + (xcd - r) * q) + off; }
        const int nig = WGM * nN, gid = wgid / nig, fm = gid * WGM, gsz = (nM - fm) < WGM ? (nM - fm) : WGM;
        u.pm = fm + ((wgid % nig) % gsz); u.pn = (wgid % nig) / gsz; return true;
    }
    __device__ __forceinline__ void a_ready(const Unit&) const {}
    __device__ __forceinline__ void done(const Unit&) const {}
};

template <class Epi, class Sched, bool ALIGN_EPI = false, bool SP2 = false>
__device__ __forceinline__ void gemm_phase(LAS unsigned char* lds, const Gemm g, const Sched& S, const Epi& E) {
    int tid = threadIdx.x; asm volatile("" : "+v"(tid));
    const int wid = __builtin_amdgcn_readfirstlane(tid >> 6), lane = tid & 63, wr = wid >> 2, wc = wid & 3, fr = lane & 15, fq = lane >> 4;
    const int K = g.K, nt = K / BK;
    unsigned voffA[2], voffB[2];
#pragma unroll
    for (int i = 0; i < 2; ++i) { int R, C; stage_rc(tid * 16 + i * 8192, R, C); const int Rb = Epi::PERM ? ((R & ~31) + perm32(R & 31)) : R;
        voffA[i] = (unsigned)(R * K + C) * 2u; voffB[i] = (unsigned)(Rb * K + C) * 2u; }
    const size_t kstep = (size_t)(BK * 2);
    const size_t hstep = (size_t)HALF * K * 2;
    const size_t tstep = 2 * hstep;
    const unsigned ldsw = (unsigned)wid * 1024u;
    const int aoff = lds_byte(wr * 64 + fr, fq * 8), boff = lds_byte(wc * 32 + fr, fq * 8);
#define PG8_SA(b, h) (((b) * 2 + (h)) * HTB)
#define PG8_SB(b, h) ((4 + (b) * 2 + (h)) * HTB)
#define PG8_STAGE(bufoff, gbase, voff) do { _Pragma("unroll") for (int _i = 0; _i < 2; ++_i) \
        __builtin_amdgcn_global_load_lds((const unsigned*)((const char*)(gbase) + (voff)[_i]), (LAS unsigned*)(lds + (bufoff) + ldsw + _i * 8192), 16, 0, 0); } while (0)
#define PG8_LDA(dst, b, h) do { _Pragma("unroll") for (int m = 0; m < 4; ++m) _Pragma("unroll") for (int k = 0; k < 2; ++k) dst[m][k] = *(const LAS bf16x8*)(lds + PG8_SA(b, h) + aoff + m * 2048 + k * 1024); } while (0)
#define PG8_LDB(dst, b, h) do { _Pragma("unroll") for (int n = 0; n < 2; ++n) _Pragma("unroll") for (int k = 0; k < 2; ++k) dst[n][k] = *(const LAS bf16x8*)(lds + PG8_SB(b, h) + boff + n * 2048 + k * 1024); } while (0)
#define PG8_MMA(ai, bj, At, Bt) do { __builtin_amdgcn_s_setprio(1); _Pragma("unroll") for (int m = 0; m < 4; ++m) _Pragma("unroll") for (int n = 0; n < 2; ++n) _Pragma("unroll") for (int k = 0; k < 2; ++k) \
        acc[ai][bj][m][n] = __builtin_amdgcn_mfma_f32_16x16x32_bf16(Bt[n][k], At[m][k], acc[ai][bj][m][n], 0, 0, 0); __builtin_amdgcn_s_setprio(0); } while (0)
#define PG8_WAIT_V(n) asm volatile("s_waitcnt vmcnt(" #n ")" ::: "memory")
#define PG8_WAIT_L(n) asm volatile("s_waitcnt lgkmcnt(" #n ")" ::: "memory")
#define PG8_BAR __builtin_amdgcn_s_barrier()
#define PG8_SCHED __builtin_amdgcn_sched_barrier(0)
    Unit cur, nxt; int ui = 0;
    if (!S.next(0, cur)) return;
    f32x4 acc[2][2][4][2];
#pragma unroll
    for (int a = 0; a < 2; ++a)
#pragma unroll
        for (int b = 0; b < 2; ++b)
#pragma unroll
            for (int m = 0; m < 4; ++m)
#pragma unroll
                for (int n = 0; n < 2; ++n) acc[a][b][m][n] = (f32x4){0.f, 0.f, 0.f, 0.f};
    bf16x8 At[4][2], B0[2][2], B1[2][2];
    const char* cA = (const char*)g.A + (size_t)cur.pm * tstep; const char* cB = (const char*)g.Bt + (size_t)cur.pn * tstep;
    S.a_ready(cur);
    if constexpr (SP2) {
        PG8_STAGE(PG8_SB(0, 0), cB, voffB); PG8_STAGE(PG8_SB(0, 1), cB + hstep, voffB); PG8_STAGE(PG8_SA(0, 0), cA, voffA); PG8_STAGE(PG8_SA(0, 1), cA + hstep, voffA);
        if (wr == 1) PG8_BAR;
        PG8_WAIT_V(2); PG8_BAR;
        PG8_STAGE(PG8_SB(1, 0), cB + kstep, voffB); PG8_STAGE(PG8_SA(1, 0), cA + kstep, voffA); PG8_STAGE(PG8_SB(1, 1), cB + hstep + kstep, voffB);
        PG8_WAIT_V(6); PG8_BAR;
    } else {
        PG8_STAGE(PG8_SB(0, 0), cB, voffB); PG8_STAGE(PG8_SA(0, 0), cA, voffA); PG8_STAGE(PG8_SB(0, 1), cB + hstep, voffB); PG8_STAGE(PG8_SA(0, 1), cA + hstep, voffA);
        if (wr == 1) PG8_BAR;
        PG8_WAIT_V(4); PG8_BAR;
        PG8_STAGE(PG8_SB(1, 0), cB + kstep, voffB); PG8_STAGE(PG8_SA(1, 0), cA + kstep, voffA); PG8_STAGE(PG8_SB(1, 1), cB + hstep + kstep, voffB);
        PG8_WAIT_V(6); PG8_BAR;
    }
    for (;;) {
        const bool has_next = S.next(ui + 1, nxt);
        const char* nA = has_next ? (const char*)g.A + (size_t)nxt.pm * tstep : cA; const char* nB = has_next ? (const char*)g.Bt + (size_t)nxt.pn * tstep : cB;
        for (int t = 0; t < nt; t += 2) {
            const bool last = (t == nt - 2);
            const char* a1 = cA + (size_t)(t + 1) * kstep;
            const char* a2 = last ? nA : cA + (size_t)(t + 2) * kstep; const char* b2 = last ? nB : cB + (size_t)(t + 2) * kstep;
            const char* a3 = a2 + kstep; const char* b3 = b2 + kstep;
            if (last && has_next) S.a_ready(nxt);
            if constexpr (SP2) {
            PG8_LDB(B0, 0, 0); PG8_LDB(B1, 0, 1); PG8_SCHED; PG8_LDA(At, 0, 0); PG8_STAGE(PG8_SA(1, 1), a1 + hstep, voffA);
            PG8_WAIT_V(8); PG8_WAIT_L(0); PG8_BAR; PG8_MMA(0, 0, At, B0); PG8_MMA(0, 1, At, B1); PG8_BAR; PG8_SCHED;
            PG8_LDA(At, 0, 1); PG8_STAGE(PG8_SB(0, 0), b2, voffB); PG8_STAGE(PG8_SB(0, 1), b2 + hstep, voffB); PG8_STAGE(PG8_SA(0, 0), a2, voffA);
            PG8_WAIT_V(8); PG8_WAIT_L(0); PG8_BAR; PG8_MMA(1, 0, At, B0); PG8_MMA(1, 1, At, B1); PG8_BAR; PG8_SCHED;
            PG8_LDB(B0, 1, 0); PG8_LDB(B1, 1, 1); PG8_SCHED; PG8_LDA(At, 1, 0); PG8_STAGE(PG8_SA(0, 1), a2 + hstep, voffA);
            PG8_WAIT_V(8); PG8_WAIT_L(0); PG8_BAR; PG8_MMA(0, 0, At, B0); PG8_MMA(0, 1, At, B1); PG8_BAR; PG8_SCHED;
            PG8_LDA(At, 1, 1); PG8_STAGE(PG8_SB(1, 0), b3, voffB); PG8_STAGE(PG8_SB(1, 1), b3 + hstep, voffB); PG8_STAGE(PG8_SA(1, 0), a3, voffA);
            PG8_WAIT_V(8); PG8_WAIT_L(0); PG8_BAR; PG8_MMA(1, 0, At, B0); PG8_MMA(1, 1, At, B1); PG8_BAR; PG8_SCHED;
            } else {
            PG8_LDB(B0, 0, 0); PG8_SCHED; PG8_LDA(At, 0, 0); PG8_STAGE(PG8_SA(1, 1), a1 + hstep, voffA);
            PG8_WAIT_L(8); PG8_BAR; PG8_WAIT_L(0); PG8_MMA(0, 0, At, B0); PG8_BAR; PG8_SCHED;
            PG8_LDB(B1, 0, 1); PG8_STAGE(PG8_SB(0, 0), b2, voffB);
            PG8_BAR; PG8_WAIT_L(0); PG8_MMA(0, 1, At, B1); PG8_BAR;
            PG8_LDA(At, 0, 1); PG8_STAGE(PG8_SA(0, 0), a2, voffA);
            PG8_BAR; PG8_WAIT_L(0); PG8_MMA(1, 0, At, B0); PG8_BAR; PG8_SCHED;
            PG8_STAGE(PG8_SB(0, 1), b2 + hstep, voffB);
            PG8_WAIT_V(6); PG8_BAR; PG8_MMA(1, 1, At, B1); PG8_BAR;
            PG8_LDB(B0, 1, 0); PG8_SCHED; PG8_LDA(At, 1, 0); PG8_STAGE(PG8_SA(0, 1), a2 + hstep, voffA);
            PG8_WAIT_L(8); PG8_BAR; PG8_WAIT_L(0); PG8_MMA(0, 0, At, B0); PG8_BAR; PG8_SCHED;
            PG8_LDB(B1, 1, 1); PG8_STAGE(PG8_SB(1, 0), b3, voffB);
            PG8_BAR; PG8_WAIT_L(0); PG8_MMA(0, 1, At, B1); PG8_BAR;
            PG8_LDA(At, 1, 1); PG8_STAGE(PG8_SA(1, 0), a3, voffA);
            PG8_BAR; PG8_WAIT_L(0); PG8_MMA(1, 0, At, B0); PG8_BAR; PG8_SCHED;
            PG8_STAGE(PG8_SB(1, 1), b3 + hstep, voffB);
            PG8_WAIT_V(6); PG8_BAR; PG8_MMA(1, 1, At, B1); PG8_BAR;
            }
        }
        if constexpr (ALIGN_EPI) { if (wr == 0) PG8_BAR; }
        E(acc, cur, wr, wc, fr, fq); S.done(cur);
        if (!has_next) break;
#pragma unroll
        for (int a = 0; a < 2; ++a)
#pragma unroll
            for (int b = 0; b < 2; ++b)
#pragma unroll
                for (int m = 0; m < 4; ++m)
#pragma unroll
                    for (int n = 0; n < 2; ++n) acc[a][b][m][n] = (f32x4){0.f, 0.f, 0.f, 0.f};
        cur = nxt; cA = nA; cB = nB; ++ui;
        if constexpr (ALIGN_EPI) { if (wr == 1) PG8_BAR; }
    }
    PG8_WAIT_V(0);
    if constexpr (!ALIGN_EPI) { if (wr == 0) PG8_BAR; }
    PG8_BAR;
#undef PG8_SA
#undef PG8_SB
#undef PG8_STAGE
#undef PG8_LDA
#undef PG8_LDB
#undef PG8_MMA
#undef PG8_WAIT_V
#undef PG8_WAIT_L
#undef PG8_BAR
#undef PG8_SCHED
}

__device__ __forceinline__ void rows_rstd(const float* __restrict__ ssq, int row0, int fq, float (&rs)[2][4]) {
    f32x4 pp[2][4];
#pragma unroll
    for (int ai = 0; ai < 2; ++ai)
#pragma unroll
        for (int m = 0; m < 4; ++m) pp[ai][m] = *(const f32x4*)(ssq + (size_t)(row0 + ai * HALF + m * 16) * 16 + 4 * fq);
#pragma unroll
    for (int ai = 0; ai < 2; ++ai)
#pragma unroll
        for (int m = 0; m < 4; ++m) { float s = (pp[ai][m][0] + pp[ai][m][1]) + (pp[ai][m][2] + pp[ai][m][3]); s += __shfl_xor(s, 16); s += __shfl_xor(s, 32); rs[ai][m] = rsqrtf(s * (1.0f / 1024.0f) + EPS); }
}
__device__ __forceinline__ void rows_rstd_cached(const float* __restrict__ ssq, int row0, int fq, float (&rs)[2][4], bool hit, LAS float* cache, int lrow0, bool writer) {
    if (hit) {
#pragma unroll
        for (int ai = 0; ai < 2; ++ai)
#pragma unroll
            for (int m = 0; m < 4; ++m) rs[ai][m] = cache[lrow0 + ai * HALF + m * 16];
    } else {
        rows_rstd(ssq, row0, fq, rs);
        if (writer) {
#pragma unroll
            for (int ai = 0; ai < 2; ++ai)
#pragma unroll
                for (int m = 0; m < 4; ++m) cache[lrow0 + ai * HALF + m * 16] = rs[ai][m];
        }
    }
}
struct EpiZ {
    static constexpr bool PERM = true;
    bf16_t* Z; bf16_t* DEC; const float* ssq; LAS float* rsc; mutable int cached_pm;
    __device__ __forceinline__ void operator()(const f32x4 (&acc)[2][2][4][2], const Unit& u, int wr, int wc, int fr, int fq) const {
        const int row0 = u.pm * BM + wr * 64 + fr; const int pn = u.pn;
        float rsv[2][4]; rows_rstd_cached(ssq, row0, fq, rsv, u.pm == cached_pm, rsc, wr * 64 + fr, wc == 0 && fq == 0); cached_pm = u.pm;
#pragma unroll
        for (int ai = 0; ai < 2; ++ai)
#pragma unroll
            for (int m = 0; m < 4; ++m) {
                const int r = row0 + ai * HALF + m * 16; const float rs = rsv[ai][m];
                if (pn == 8) {
                    if (wc == 0) { const f32x4 v0 = acc[ai][0][m][0] * rs, v1 = acc[ai][0][m][1] * rs; u32x4 w; w.x = cvt_pk_bf16(v0[0], v0[1]); w.y = cvt_pk_bf16(v0[2], v0[3]); w.z = cvt_pk_bf16(v1[0], v1[1]); w.w = cvt_pk_bf16(v1[2], v1[3]); *(u32x4*)(DEC + (size_t)r * 32 + 8 * fq) = w; }
                } else {
                    bf16_t* rowp = Z + (size_t)r * ZW + pn * BM + wc * 32 + 8 * fq;
#pragma unroll
                    for (int bj = 0; bj < 2; ++bj) { f32x4 v0 = acc[ai][bj][m][0] * rs, v1 = acc[ai][bj][m][1] * rs;
                        if (pn >= 4 && pn < 6) {
#pragma unroll
                            for (int j = 0; j < 4; ++j) { v0[j] = silu_f(v0[j]); v1[j] = silu_f(v1[j]); } }
                        u32x4 w; w.x = cvt_pk_bf16(v0[0], v0[1]); w.y = cvt_pk_bf16(v0[2], v0[3]); w.z = cvt_pk_bf16(v1[0], v1[1]); w.w = cvt_pk_bf16(v1[2], v1[3]);
                        *(u32x4*)(rowp + bj * HALF) = w; }
                }
            }
    }
};
struct EpiH {
    static constexpr bool PERM = true;
    bf16_t* H; const float* ssq; LAS float* rsc; mutable int cached_pm;
    __device__ __forceinline__ void operator()(const f32x4 (&acc)[2][2][4][2], const Unit& u, int wr, int wc, int fr, int fq) const {
        const int row0 = u.pm * BM + wr * 64 + fr;
        float rsv[2][4]; rows_rstd_cached(ssq, row0, fq, rsv, u.pm == cached_pm, rsc, wr * 64 + fr, wc == 0 && fq == 0); cached_pm = u.pm;
#pragma unroll
        for (int ai = 0; ai < 2; ++ai)
#pragma unroll
            for (int m = 0; m < 4; ++m) {
                const int r = row0 + ai * HALF + m * 16; const float rs = rsv[ai][m];
                bf16_t* rowp = H + (size_t)r * FF + u.pn * BM + wc * 32 + 8 * fq;
#pragma unroll
                for (int bj = 0; bj < 2; ++bj) { f32x4 v0 = acc[ai][bj][m][0] * rs, v1 = acc[ai][bj][m][1] * rs;
#pragma unroll
                    for (int j = 0; j < 4; ++j) { const float a = fmaxf(v0[j], 0.f), b = fmaxf(v1[j], 0.f); v0[j] = a * a; v1[j] = b * b; }
                    u32x4 w; w.x = cvt_pk_bf16(v0[0], v0[1]); w.y = cvt_pk_bf16(v0[2], v0[3]); w.z = cvt_pk_bf16(v1[0], v1[1]); w.w = cvt_pk_bf16(v1[2], v1[3]);
                    *(u32x4*)(rowp + bj * HALF) = w; }
            }
    }
};
template <bool RD32>
__device__ __forceinline__ void res_rows(const float* __restrict__ xold32, const bf16_t* __restrict__ xoldb, bf16_t* __restrict__ xb, float* __restrict__ ssq, const f32x4 (&acc)[2][2][4][2], int row0, int col0, int slot) {
    f32x4 xo[2][2][2];
    float ssv[8];
    auto ld = [&](size_t o, f32x4& a, f32x4& b) { if (RD32) { a = *(const f32x4*)(xold32 + o); b = *(const f32x4*)(xold32 + o + 4); }
        else { const u32x4 w = *(const u32x4*)(xoldb + o); a = (f32x4){bflo(w.x), bfhi(w.x), bflo(w.y), bfhi(w.y)}; b = (f32x4){bflo(w.z), bfhi(w.z), bflo(w.w), bfhi(w.w)}; } };
#pragma unroll
    for (int bj = 0; bj < 2; ++bj) ld((size_t)row0 * D + col0 + bj * HALF, xo[0][bj][0], xo[0][bj][1]);
#pragma unroll
    for (int idx = 0; idx < 8; ++idx) {
        const int ai = idx >> 2, m = idx & 3; const int r = row0 + ai * HALF + m * 16; const size_t off = (size_t)r * D + col0;
        if (idx < 7) { const int ai2 = (idx + 1) >> 2, m2 = (idx + 1) & 3; const size_t off2 = (size_t)(row0 + ai2 * HALF + m2 * 16) * D + col0;
#pragma unroll
            for (int bj = 0; bj < 2; ++bj) ld(off2 + bj * HALF, xo[(idx + 1) & 1][bj][0], xo[(idx + 1) & 1][bj][1]); }
        float ss = 0.f;
#pragma unroll
        for (int bj = 0; bj < 2; ++bj) { const f32x4 x0 = xo[idx & 1][bj][0] + acc[ai][bj][m][0], x1 = xo[idx & 1][bj][1] + acc[ai][bj][m][1];
            u32x4 w; w.x = cvt_pk_bf16(x0[0], x0[1]); w.y = cvt_pk_bf16(x0[2], x0[3]); w.z = cvt_pk_bf16(x1[0], x1[1]); w.w = cvt_pk_bf16(x1[2], x1[3]);
            *(u32x4*)(xb + off + bj * HALF) = w;
            ss += ((x0[0] * x0[0] + x0[1] * x0[1]) + (x0[2] * x0[2] + x0[3] * x0[3])) + ((x1[0] * x1[0] + x1[1] * x1[1]) + (x1[2] * x1[2] + x1[3] * x1[3])); }
        ss += __shfl_xor(ss, 16); ss += __shfl_xor(ss, 32);
        ssv[idx] = ss;
    }
    const int fq = slot >> 6;
#pragma unroll
    for (int j = 0; j < 2; ++j) { const float v = fq == 0 ? ssv[j] : fq == 1 ? ssv[2 + j] : fq == 2 ? ssv[4 + j] : ssv[6 + j]; const int idx = 2 * fq + j;
        ssq[(size_t)(row0 + (idx >> 2) * HALF + (idx & 3) * 16) * 16 + (slot & 15)] = v; }
}
struct EpiRes {
    static constexpr bool PERM = true;
    const float* xold32; float* xout; bf16_t* xb; float* ssq; int mode;
    __device__ __forceinline__ void operator()(const f32x4 (&acc)[2][2][4][2], const Unit& u, int wr, int wc, int fr, int fq) const {
        const int row0 = u.pm * BM + wr * 64 + fr, col0 = u.pn * BM + wc * 32 + 8 * fq, slot = (u.pn * 4 + wc) | (fq << 6);
        if (mode == 0) res_rows<false>(xold32, xb, xb, ssq, acc, row0, col0, slot);
        else res_rows<true>(xold32, xb, xb, ssq, acc, row0, col0, slot);
    }
};
}

struct WTile { const float* src; bf16_t* dst; const float* g; int ldsrc, K, n0, k0, mode; };
__device__ __forceinline__ WTile wtile_desc(const Params& p, int it) {
    unsigned char* ws = p.ws; WTile t; const int l = it / 3008; int r = it % 3008;
    if (r < 704) { t.src = p.w_in + (size_t)l * D * D_IN; t.ldsrc = D_IN; t.dst = (bf16_t*)(ws + WS_WIN) + (size_t)l * ZW * D; t.K = D; t.n0 = (r / 16) * 64; t.k0 = (r % 16) * 64; t.g = p.norm_mix_g + l * D; t.mode = 0; }
    else if (r < 960) { r -= 704; t.src = p.w_out + (size_t)l * D * D; t.ldsrc = D; t.dst = (bf16_t*)(ws + WS_WOUT) + (size_t)l * D * D; t.K = D; t.n0 = (r / 16) * 64; t.k0 = (r % 16) * 64; t.g = nullptr; t.mode = 1; }
    else if (r < 1984) { r -= 960; t.src = p.w_mlp1 + (size_t)l * D * FF; t.ldsrc = FF; t.dst = (bf16_t*)(ws + WS_W1) + (size_t)l * FF * D; t.K = D; t.n0 = (r / 16) * 64; t.k0 = (r % 16) * 64; t.g = p.norm_mlp_g + l * D; t.mode = 1; }
    else { r -= 1984; t.src = p.w_mlp2 + (size_t)l * FF * D; t.ldsrc = D; t.dst = (bf16_t*)(ws + WS_W2) + (size_t)l * D * FF; t.K = FF; t.n0 = (r / 64) * 64; t.k0 = (r % 64) * 64; t.g = nullptr; t.mode = 1; }
    return t;
}
__device__ __forceinline__ void wtile_load(const WTile& w, int t, f32x4& a, f32x4& b, float& rsc) {
    const int kk = t >> 3, ns = (t & 7) * 8; const int nd = w.n0 + ns; int nsrc = nd; bool valid = true; float cs = 1.0f;
    if (w.mode == 0) { if (nd < 1536) nsrc = nd; else if (nd < 2048) nsrc = nd + 32; else if (nd < 2080) nsrc = nd - 512; else if (nd < 2304) valid = false; else nsrc = nd - 224; if (nd < 256) cs = 0.125f; }
    a = (f32x4){0.f, 0.f, 0.f, 0.f}; b = a;
    if (valid) { const float* sp = w.src + (size_t)(w.k0 + kk) * w.ldsrc + nsrc; a = *(const f32x4*)sp; b = *(const f32x4*)(sp + 4); }
    rsc = (w.g ? w.g[w.k0 + kk] : 1.0f) * cs;
}

PHASE_FN void phase_prep(const Params& p, float* ldsf) {
    unsigned char* ws = p.ws;
    const int G = gridDim.x, bx = blockIdx.x; int tid = threadIdx.x; asm volatile("" : "+v"(tid));
    { const int NT = DEPTH * 3008; int it = bx, buf = 0; f32x4 a, b; float rsc;
      WTile cur = wtile_desc(p, it < NT ? it : 0);
      if (it < NT) wtile_load(cur, tid, a, b, rsc);
      for (; it < NT; it += G, buf ^= 1) {
          float* tile = ldsf + buf * (64 * 65);
          { const int kk = tid >> 3, ns = (tid & 7) * 8; float* tp = tile + kk * 65 + ns;
#pragma unroll
            for (int j = 0; j < 4; ++j) { tp[j] = a[j] * rsc; tp[4 + j] = b[j] * rsc; } }
          const WTile w = cur;
          if (it + G < NT) { cur = wtile_desc(p, it + G); wtile_load(cur, tid, a, b, rsc); }
          asm volatile("s_waitcnt lgkmcnt(0)" ::: "memory"); __builtin_amdgcn_s_barrier(); asm volatile("" ::: "memory");
          { const int nn = tid >> 3, ks = (tid & 7) * 8; float v[8];
#pragma unroll
            for (int i = 0; i < 8; ++i) v[i] = tile[(ks + i) * 65 + nn];
            u32x4 o; o.x = cvt_pk_bf16(v[0], v[1]); o.y = cvt_pk_bf16(v[2], v[3]); o.z = cvt_pk_bf16(v[4], v[5]); o.w = cvt_pk_bf16(v[6], v[7]);
            *(u32x4*)(w.dst + (size_t)(w.n0 + nn) * w.K + w.k0 + ks) = o; }
      }
      __syncthreads(); }
    { bf16_t* wsb = (bf16_t*)(ws + WS_WSB);
      for (int i = (bx * 512 + tid) * 4; i < DEPTH * 4 * 128 * 128; i += G * 512 * 4) { const f32x4 v = *(const f32x4*)(p.w_s + i); u32x2 w; w.x = cvt_pk_bf16(v[0], v[1]); w.y = cvt_pk_bf16(v[2], v[3]); *(u32x2*)(wsb + i) = w; } }
    { bf16_t* xb = (bf16_t*)(ws + WS_XB); float* ssq = (float*)(ws + WS_SSQ); const int wid = tid >> 6, lane = tid & 63;
      for (int r = bx * 8 + wid; r < T; r += G * 8) { const float* xr = p.x + (size_t)r * D; float ss = 0.f;
#pragma unroll
          for (int i = 0; i < 4; ++i) { const int c = i * 256 + lane * 4; const f32x4 v = *(const f32x4*)(xr + c); ss += (v[0] * v[0] + v[1] * v[1]) + (v[2] * v[2] + v[3] * v[3]);
              u32x2 w; w.x = cvt_pk_bf16(v[0], v[1]); w.y = cvt_pk_bf16(v[2], v[3]); *(u32x2*)(xb + (size_t)r * D + c) = w; }
#pragma unroll
          for (int o = 32; o >= 1; o >>= 1) ss += __shfl_xor(ss, o);
          if (lane < 16) ssq[(size_t)r * 16 + lane] = lane == 0 ? ss : 0.f; } }
}

constexpr int GP = 72;
constexpr int VP = 132;
#define ROT(row, col) (((col) + 16 * ((row) >> 4)) & 63)
constexpr int L_QIN = 0, L_KIN = 9216, L_QOUT = 18432, L_KOUTT = 27648;
constexpr int L_DEC = 36864;
constexpr int L_RED = L_DEC + 256;
constexpr int L_QRAW = L_RED + 1024;
constexpr int L_KRAW = L_QRAW + 8192;
constexpr int L_ARAW = L_KRAW + 8192;
constexpr int L_VRAW = L_ARAW + 2048;
static_assert(L_VRAW + 64 * VP * 2 <= 131072, "GLA LDS map");

__device__ __forceinline__ float logsig2(float d) {
    const float e = __builtin_amdgcn_exp2f(d * -1.44269504089f);
    return __builtin_amdgcn_logf(1.0f + e) * -0.0625f;
}
#define GLA_BAR() do { asm volatile("s_waitcnt lgkmcnt(0)" ::: "memory"); __builtin_amdgcn_s_barrier(); asm volatile("" ::: "memory"); } while (0)
#define CHUNK(si) (dir ? 63 - (si) : (si))
#define POS(r) (dir ? 63 - (r) : (r))

__device__ __forceinline__ bf16x8 gla_tr_frag(const bf16_t* tileT, int chA, int chB, int pos0, int lr) {
    typedef short s4v __attribute__((ext_vector_type(4)));
    const int off = (lr >> 2) * GP + pos0 + 4 * (lr & 3);
    const s4v lo = __builtin_amdgcn_ds_read_tr16_b64_v4i16((LAS s4v*)(tileT + chA * GP + off)), hi = __builtin_amdgcn_ds_read_tr16_b64_v4i16((LAS s4v*)(tileT + chB * GP + off));
    return (bf16x8){lo[0], lo[1], lo[2], lo[3], hi[0], hi[1], hi[2], hi[3]};
}
struct GlaRegs { u32x4 q0, q1, k0, k1, a, v0, v1, v2, v3; };
struct GlaPrepCtx {
    const bf16_t* Z; const bf16_t* DEC; unsigned* myflag; unsigned* paflag;
    bf16_t* qin; bf16_t* kin; bf16_t* qout; bf16_t* koutT; float* decs; bf16_t* qraw; bf16_t* kraw; bf16_t* araw; bf16_t* vraw;
    int tid, wid, lr, q4, b, h, dir, lrow, lcs, vrow, vcs, arow, acs, ch; bf16x8 w2f; float bias;
};
#define ST8_(pp, v) do { *(u32x2*)(pp) = (u32x2){(v).x, (v).y}; *(u32x2*)((pp) + 4) = (u32x2){(v).z, (v).w}; } while (0)
__device__ __forceinline__ void gla_load_qka(const GlaPrepCtx& c, int si, GlaRegs& R) {
    const int dir = c.dir; const size_t t0 = (size_t)(c.b * SEQ + CHUNK(si) * 64); const bf16_t* zr = c.Z + (t0 + c.lrow) * ZW + c.h * 64 + c.lcs;
    R.q0 = *(const u32x4*)(zr + ZQ); R.k0 = *(const u32x4*)(zr + ZK); R.q1 = *(const u32x4*)(zr + (size_t)32 * ZW + ZQ); R.k1 = *(const u32x4*)(zr + (size_t)32 * ZW + ZK);
    if (c.tid < 128) R.a = *(const u32x4*)(c.DEC + (t0 + c.arow) * 32 + dir * 16 + c.acs);
}
__device__ __forceinline__ void gla_load_v(const GlaPrepCtx& c, int si, GlaRegs& R) {
    const int dir = c.dir; const size_t t0 = (size_t)(c.b * SEQ + CHUNK(si) * 64); const bf16_t* vr = c.Z + (t0 + c.vrow) * ZW + ZV + c.h * 128 + c.vcs;
    R.v0 = *(const u32x4*)vr; R.v1 = *(const u32x4*)(vr + (size_t)16 * ZW); R.v2 = *(const u32x4*)(vr + (size_t)32 * ZW); R.v3 = *(const u32x4*)(vr + (size_t)48 * ZW);
}
__device__ __forceinline__ void gla_store_qka(const GlaPrepCtx& c, const GlaRegs& R) {
    const int dir = c.dir; const int r0_ = POS(c.lrow), r1_ = POS(c.lrow + 32);
    *(u32x4*)(c.qraw + r0_ * 64 + ROT(r0_, c.lcs)) = R.q0; *(u32x4*)(c.kraw + r0_ * 64 + ROT(r0_, c.lcs)) = R.k0; *(u32x4*)(c.qraw + r1_ * 64 + ROT(r1_, c.lcs)) = R.q1; *(u32x4*)(c.kraw + r1_ * 64 + ROT(r1_, c.lcs)) = R.k1;
    if (c.tid < 128) *(u32x4*)(c.araw + POS(c.arow) * 16 + c.acs) = R.a;
}
__device__ __forceinline__ void gla_store_v(const GlaPrepCtx& c, const GlaRegs& R) {
    const int dir = c.dir;
    ST8_(c.vraw + POS(c.vrow) * VP + c.vcs, R.v0); ST8_(c.vraw + POS(c.vrow + 16) * VP + c.vcs, R.v1); ST8_(c.vraw + POS(c.vrow + 32) * VP + c.vcs, R.v2); ST8_(c.vraw + POS(c.vrow + 48) * VP + c.vcs, R.v3);
}
__device__ __forceinline__ void gla_prep_step(const GlaPrepCtx& c, int s, GlaRegs& LD, GlaRegs& ST) {
    const int wid = c.wid, lr = c.lr, q4 = c.q4, ch = c.ch, tid = c.tid;
    if (s == 32) {
        if (wid == 0) { while (__hip_atomic_load(c.paflag, __ATOMIC_RELAXED, __HIP_MEMORY_SCOPE_AGENT) == 0u) __builtin_amdgcn_s_sleep(4);
            __builtin_amdgcn_fence(__ATOMIC_ACQUIRE, "agent"); asm volatile("s_waitcnt vmcnt(0)" ::: "memory"); }
        __syncthreads();
    }
    if (s + 3 < 64) gla_load_qka(c, s + 3, LD);
    if (s + 2 < 64) gla_load_v(c, s + 2, LD);
    unsigned rq[8], rk[8], ro[8], rko[8]; float rdec = 0.f;
    if (s < 63) {
        float la[16];
#pragma unroll
        for (int cb = 0; cb < 4; ++cb) { const int pr = 16 * (lr >> 2) + 4 * cb + (lr & 3);
            u32x4 aw = (u32x4){0u, 0u, 0u, 0u}; if (q4 < 2) aw = *(const u32x4*)(c.araw + pr * 16 + 8 * q4);
            f32x4 d = (f32x4){c.bias, c.bias, c.bias, c.bias};
            d = __builtin_amdgcn_mfma_f32_16x16x32_bf16(__builtin_bit_cast(bf16x8, aw), c.w2f, d, 0, 0, 0);
#pragma unroll
            for (int jj = 0; jj < 4; ++jj) la[4 * cb + jj] = logsig2(d[jj]); }
#pragma unroll
        for (int i = 1; i < 16; ++i) la[i] += la[i - 1];
        const float tq = la[15]; float inc = tq;
        { const float t1 = __shfl_up(inc, 16); if (q4 >= 1) inc += t1; const float t2 = __shfl_up(inc, 32); if (q4 >= 2) inc += t2; }
        const float off = inc - tq;
        const float tot = __shfl(inc, lr + 48);
        const float bmid = __shfl(off + la[0], lr + 32);
        const float emid = __builtin_amdgcn_exp2f(bmid), etm = __builtin_amdgcn_exp2f(tot - bmid);
        rdec = __builtin_amdgcn_exp2f(tot);
        typedef short s4v __attribute__((ext_vector_type(4)));
        s4v qt[4], kt[4];
        { const int trow = 16 * q4 + (lr >> 2), tcol = ((16 * wid + 16 * q4) & 63) + 4 * (lr & 3);
#pragma unroll
          for (int t = 0; t < 4; ++t) { qt[t] = __builtin_amdgcn_ds_read_tr16_b64_v4i16((LAS s4v*)(c.qraw + (trow + 4 * t) * 64 + tcol)); kt[t] = __builtin_amdgcn_ds_read_tr16_b64_v4i16((LAS s4v*)(c.kraw + (trow + 4 * t) * 64 + tcol)); } }
#pragma unroll
        for (int i = 0; i < 16; i += 2) {
            const float x0 = off + la[i] - bmid, x1 = off + la[i + 1] - bmid;
            const float e10 = __builtin_amdgcn_exp2f(x0), e20 = __builtin_amdgcn_exp2f(-x0), e11 = __builtin_amdgcn_exp2f(x1), e21 = __builtin_amdgcn_exp2f(-x1);
            const float q0 = bf2f((unsigned short)qt[i >> 2][i & 3]) * e10, q1 = bf2f((unsigned short)qt[i >> 2][(i & 3) + 1]) * e11;
            const float k0 = bf2f((unsigned short)kt[i >> 2][i & 3]) * e20, k1 = bf2f((unsigned short)kt[i >> 2][(i & 3) + 1]) * e21;
            rq[i >> 1] = cvt_pk_bf16(q0, q1); rk[i >> 1] = cvt_pk_bf16(k0, k1); ro[i >> 1] = cvt_pk_bf16(q0 * emid, q1 * emid); rko[i >> 1] = cvt_pk_bf16(k0 * etm, k1 * etm);
        }
    }
    GLA_BAR();
    if (s < 63) {
        *(u32x4*)(c.qin + ch * GP + 16 * q4) = (u32x4){rq[0], rq[1], rq[2], rq[3]}; *(u32x4*)(c.qin + ch * GP + 16 * q4 + 8) = (u32x4){rq[4], rq[5], rq[6], rq[7]};
        *(u32x4*)(c.kin + ch * GP + 16 * q4) = (u32x4){rk[0], rk[1], rk[2], rk[3]}; *(u32x4*)(c.kin + ch * GP + 16 * q4 + 8) = (u32x4){rk[4], rk[5], rk[6], rk[7]};
        *(u32x4*)(c.qout + ch * GP + 16 * q4) = (u32x4){ro[0], ro[1], ro[2], ro[3]}; *(u32x4*)(c.qout + ch * GP + 16 * q4 + 8) = (u32x4){ro[4], ro[5], ro[6], ro[7]};
        *(u32x4*)(c.koutT + ch * GP + 16 * q4) = (u32x4){rko[0], rko[1], rko[2], rko[3]}; *(u32x4*)(c.koutT + ch * GP + 16 * q4 + 8) = (u32x4){rko[4], rko[5], rko[6], rko[7]};
        if (q4 == 0) c.decs[ch] = rdec;
    }
    if (s + 2 < 64) gla_store_qka(c, ST);
    if (s + 1 < 64) gla_store_v(c, ST);
    if (s == 31) {
        asm volatile("s_waitcnt vmcnt(0)" ::: "memory"); __syncthreads();
        if (tid == 0) { __builtin_amdgcn_fence(__ATOMIC_RELEASE, "agent"); asm volatile("s_waitcnt vmcnt(0)" ::: "memory"); __hip_atomic_store(c.myflag, 1u, __ATOMIC_RELAXED, __HIP_MEMORY_SCOPE_AGENT); }
    }
    GLA_BAR();
}

__device__ __forceinline__ void gla_prep(const Params& p, unsigned char* lds, int l, int item, int tid) {
    unsigned char* ws = p.ws;
    GlaPrepCtx c;
    c.tid = tid; c.wid = __builtin_amdgcn_readfirstlane(tid >> 6); const int lane = tid & 63; c.lr = lane & 15; c.q4 = lane >> 4;
    c.b = item >> 3; c.h = (item >> 1) & 3; c.dir = item & 1; const int dir = c.dir;
    c.Z = (const bf16_t*)(ws + WS_Z); c.DEC = (const bf16_t*)(ws + WS_DEC);
    unsigned* flags = (unsigned*)(ws + WS_CTL);
    c.myflag = flags + (size_t)(l * 128 + item) * 64; c.paflag = flags + (size_t)(l * 128 + (item ^ 1)) * 64;
    c.qin = (bf16_t*)(lds + L_QIN); c.kin = (bf16_t*)(lds + L_KIN); c.qout = (bf16_t*)(lds + L_QOUT); c.koutT = (bf16_t*)(lds + L_KOUTT);
    c.decs = (float*)(lds + L_DEC);
    c.qraw = (bf16_t*)(lds + L_QRAW); c.kraw = (bf16_t*)(lds + L_KRAW); c.araw = (bf16_t*)(lds + L_ARAW); c.vraw = (bf16_t*)(lds + L_VRAW);
    c.lrow = tid >> 3; c.lcs = (tid & 7) * 8; c.vrow = tid >> 4; c.vcs = (tid & 15) * 8; c.arow = tid >> 1; c.acs = (tid & 1) * 8;
    c.ch = 16 * c.wid + c.lr;
    { const float* w2 = (dir ? p.w_a2_bwd : p.w_a2_fwd) + (size_t)l * 16 * 256 + c.h * 64 + c.ch; u32x4 w = (u32x4){0u, 0u, 0u, 0u};
      if (c.q4 < 2) { float t[8];
#pragma unroll
          for (int i = 0; i < 8; ++i) t[i] = w2[(8 * c.q4 + i) * 256];
          w.x = cvt_pk_bf16(t[0], t[1]); w.y = cvt_pk_bf16(t[2], t[3]); w.z = cvt_pk_bf16(t[4], t[5]); w.w = cvt_pk_bf16(t[6], t[7]); }
      c.w2f = __builtin_bit_cast(bf16x8, w); c.bias = (dir ? p.b_a_bwd : p.b_a_fwd)[l * 256 + c.h * 64 + c.ch]; }
    GlaRegs RA, RB;
    gla_load_qka(c, 0, RA); gla_store_qka(c, RA);
    gla_load_qka(c, 1, RB); gla_load_v(c, 0, RB);
    GLA_BAR();
    for (int s = -1; s < 63; s += 2) { gla_prep_step(c, s, RA, RB); gla_prep_step(c, s + 1, RB, RA); }
    gla_prep_step(c, 63, RA, RB);
}
#undef ST8_

__device__ __forceinline__ void gla_mma(const Params& p, unsigned char* lds, int l, int item, int tid) {
    unsigned char* ws = p.ws;
    const int wid = __builtin_amdgcn_readfirstlane(tid >> 6), lane = tid & 63, lr = lane & 15, q4 = lane >> 4;
    const int b = item >> 3, h = (item >> 1) & 3, dir = item & 1;
    const bf16_t* Z = (const bf16_t*)(ws + WS_Z); bf16_t* OX = (bf16_t*)(ws + WS_OX); bf16_t* MIX = (bf16_t*)(ws + WS_MIX);
    const bf16_t* qin = (const bf16_t*)(lds + L_QIN); const bf16_t* kin = (const bf16_t*)(lds + L_KIN); const bf16_t* qout = (const bf16_t*)(lds + L_QOUT); const bf16_t* koutT = (const bf16_t*)(lds + L_KOUTT);
    const float* decs = (const float*)(lds + L_DEC); float* red = (float*)(lds + L_RED); const bf16_t* vraw = (const bf16_t*)(lds + L_VRAW);
    const int vq = wid & 3;
    const int ocol = h * 128 + 32 * vq + 8 * q4;
    f32x4 ng[2];
#pragma unroll
    for (int vb = 0; vb < 2; ++vb) ng[vb] = *(const f32x4*)(p.gla_norm_g + (size_t)l * 512 + ocol + 4 * vb);
    f32x4 accS[2][4];
#pragma unroll
    for (int vb = 0; vb < 2; ++vb)
#pragma unroll
        for (int i = 0; i < 4; ++i) accS[vb][i] = (f32x4){0.f, 0.f, 0.f, 0.f};
    GLA_BAR();
    for (int s = -1; s < 64; ++s) {
        const int tok0 = b * SEQ + CHUNK(s < 0 ? 0 : s) * 64;
#define TOK(c) (tok0 + (dir ? 63 - (c) : (c)))
        if (s == 32) __syncthreads();
        f32x4 accO[2][4]; u32x4 gw[4];
        if (s >= 0) {
            u32x4 ox[4];
            bf16x8 vfrag[2][2];
#pragma unroll
            for (int vb = 0; vb < 2; ++vb)
#pragma unroll
                for (int pp = 0; pp < 2; ++pp)
#pragma unroll
                    for (int i = 0; i < 8; ++i) { const int pos = 32 * pp + 4 * q4 + (i & 3) + ((i >> 2) << 4); vfrag[vb][pp][i] = (short)vraw[pos * VP + 32 * vq + 8 * (lr >> 2) + 4 * vb + (lr & 3)]; }
            bf16x8 qf[4][2], kf[4][2];
#pragma unroll
            for (int cb = 0; cb < 4; ++cb) { qf[cb][0] = gla_tr_frag(qin, 8 * q4, 8 * q4 + 4, 16 * cb, lr); qf[cb][1] = gla_tr_frag(qin, 32 + 8 * q4, 36 + 8 * q4, 16 * cb, lr);
                kf[cb][0] = gla_tr_frag(kin, 8 * q4, 8 * q4 + 4, 16 * cb, lr); kf[cb][1] = gla_tr_frag(kin, 32 + 8 * q4, 36 + 8 * q4, 16 * cb, lr); }
            bf16x8 P0[4], P1[2];
            {
                f32x4 sc[4][4];
#pragma unroll
                for (int cb = 0; cb < 4; ++cb)
#pragma unroll
                    for (int jb = 0; jb < 4; ++jb) {
                        if (jb > cb) { sc[jb][cb] = (f32x4){0.f, 0.f, 0.f, 0.f}; continue; }
                        f32x4 a = (f32x4){0.f, 0.f, 0.f, 0.f};
                        a = __builtin_amdgcn_mfma_f32_16x16x32_bf16(kf[jb][0], qf[cb][0], a, 0, 0, 0);
                        sc[jb][cb] = a;
                    }
#pragma unroll
                for (int cb = 0; cb < 4; ++cb)
#pragma unroll
                    for (int jb = 0; jb <= cb; ++jb) sc[jb][cb] = __builtin_amdgcn_mfma_f32_16x16x32_bf16(kf[jb][1], qf[cb][1], sc[jb][cb], 0, 0, 0);
            __builtin_amdgcn_sched_barrier(0);
            if (s >= 32) {
#pragma unroll
                for (int cb = 0; cb < 4; ++cb) { const size_t tk = (size_t)TOK(16 * cb + lr); ox[cb] = *(const u32x4*)(OX + tk * 512 + ocol); gw[cb] = *(const u32x4*)(Z + tk * ZW + ZG + ocol); }
            }
#pragma unroll
                for (int cb = 0; cb < 4; ++cb) {
#pragma unroll
                    for (int jj = 0; jj < 4; ++jj) { const int j = 4 * q4 + jj; const bool keep = dir ? (lr > j) : (lr >= j); sc[cb][cb][jj] = keep ? sc[cb][cb][jj] : 0.f; }
                    { u32x4 w; w.x = cvt_pk_bf16(sc[0][cb][0], sc[0][cb][1]); w.y = cvt_pk_bf16(sc[0][cb][2], sc[0][cb][3]); w.z = cvt_pk_bf16(sc[1][cb][0], sc[1][cb][1]); w.w = cvt_pk_bf16(sc[1][cb][2], sc[1][cb][3]); P0[cb] = __builtin_bit_cast(bf16x8, w); }
                    if (cb >= 2) { u32x4 w; w.x = cvt_pk_bf16(sc[2][cb][0], sc[2][cb][1]); w.y = cvt_pk_bf16(sc[2][cb][2], sc[2][cb][3]); w.z = cvt_pk_bf16(sc[3][cb][0], sc[3][cb][1]); w.w = cvt_pk_bf16(sc[3][cb][2], sc[3][cb][3]); P1[cb - 2] = __builtin_bit_cast(bf16x8, w); }
                }
            }
            bf16x8 qo[4][2];
#pragma unroll
            for (int cb = 0; cb < 4; ++cb)
#pragma unroll
                for (int pp = 0; pp < 2; ++pp) qo[cb][pp] = gla_tr_frag(qout, 32 * pp + 4 * q4, 32 * pp + 16 + 4 * q4, 16 * cb, lr);
            bf16x8 Sp[2][2];
#pragma unroll
            for (int vb = 0; vb < 2; ++vb)
#pragma unroll
                for (int pp = 0; pp < 2; ++pp) { u32x4 w; w.x = cvt_pk_bf16(accS[vb][2 * pp][0], accS[vb][2 * pp][1]); w.y = cvt_pk_bf16(accS[vb][2 * pp][2], accS[vb][2 * pp][3]);
                    w.z = cvt_pk_bf16(accS[vb][2 * pp + 1][0], accS[vb][2 * pp + 1][1]); w.w = cvt_pk_bf16(accS[vb][2 * pp + 1][2], accS[vb][2 * pp + 1][3]); Sp[vb][pp] = __builtin_bit_cast(bf16x8, w); }
#pragma unroll
            for (int cb = 0; cb < 4; ++cb)
#pragma unroll
                for (int vb = 0; vb < 2; ++vb) {
                    f32x4 a = (f32x4){0.f, 0.f, 0.f, 0.f};
                    a = __builtin_amdgcn_mfma_f32_16x16x32_bf16(Sp[vb][0], qo[cb][0], a, 0, 0, 0);
                    accO[vb][cb] = a; }
#pragma unroll
            for (int cb = 0; cb < 4; ++cb)
#pragma unroll
                for (int vb = 0; vb < 2; ++vb) accO[vb][cb] = __builtin_amdgcn_mfma_f32_16x16x32_bf16(Sp[vb][1], qo[cb][1], accO[vb][cb], 0, 0, 0);
#pragma unroll
            for (int cb = 0; cb < 4; ++cb)
#pragma unroll
                for (int vb = 0; vb < 2; ++vb) accO[vb][cb] = __builtin_amdgcn_mfma_f32_16x16x32_bf16(vfrag[vb][0], P0[cb], accO[vb][cb], 0, 0, 0);
#pragma unroll
            for (int cb = 2; cb < 4; ++cb)
#pragma unroll
                for (int vb = 0; vb < 2; ++vb) accO[vb][cb] = __builtin_amdgcn_mfma_f32_16x16x32_bf16(vfrag[vb][1], P1[cb - 2], accO[vb][cb], 0, 0, 0);
            __builtin_amdgcn_sched_barrier(0);
            bf16x8 ko[4][2]; f32x4 dv[4];
#pragma unroll
            for (int kb = 0; kb < 4; ++kb) { dv[kb] = *(const f32x4*)(decs + 16 * kb + 4 * q4);
#pragma unroll
                for (int pp = 0; pp < 2; ++pp) { const bf16_t* kp = koutT + (16 * kb + lr) * GP + 32 * pp + 4 * q4; const u32x2 lo = *(const u32x2*)kp, hi = *(const u32x2*)(kp + 16); ko[kb][pp] = __builtin_bit_cast(bf16x8, ((u32x4){lo.x, lo.y, hi.x, hi.y})); } }
#pragma unroll
            for (int kb = 0; kb < 4; ++kb)
#pragma unroll
                for (int vb = 0; vb < 2; ++vb) accS[vb][kb] = __builtin_amdgcn_mfma_f32_16x16x32_bf16(ko[kb][0], vfrag[vb][0], accS[vb][kb] * dv[kb], 0, 0, 0);
#pragma unroll
            for (int kb = 0; kb < 4; ++kb)
#pragma unroll
                for (int vb = 0; vb < 2; ++vb) accS[vb][kb] = __builtin_amdgcn_mfma_f32_16x16x32_bf16(ko[kb][1], vfrag[vb][1], accS[vb][kb], 0, 0, 0);
            if (s < 32) {
#pragma unroll
                for (int cb = 0; cb < 4; ++cb) { const f32x4 o0 = accO[0][cb], o1 = accO[1][cb]; *(u32x4*)(OX + (size_t)TOK(16 * cb + lr) * 512 + ocol) = (u32x4){cvt_pk_bf16(o0[0], o0[1]), cvt_pk_bf16(o0[2], o0[3]), cvt_pk_bf16(o1[0], o1[1]), cvt_pk_bf16(o1[2], o1[3])}; }
            } else {
#pragma unroll
                for (int cb = 0; cb < 4; ++cb) { float ss = 0.f;
#pragma unroll
                    for (int vb = 0; vb < 2; ++vb) { const unsigned xa = vb ? ox[cb].z : ox[cb].x, xb2 = vb ? ox[cb].w : ox[cb].y; accO[vb][cb] += (f32x4){bflo(xa), bfhi(xa), bflo(xb2), bfhi(xb2)}; const f32x4 o = accO[vb][cb]; ss += (o[0] * o[0] + o[1] * o[1]) + (o[2] * o[2] + o[3] * o[3]); }
                    ss += __shfl_xor(ss, 16); ss += __shfl_xor(ss, 32);
                    if (q4 == 0) red[vq * 64 + 16 * cb + lr] = ss; }
            }
        }
        GLA_BAR();
        if (s >= 32) {
#pragma unroll
            for (int cb = 0; cb < 4; ++cb) { const float ss = (red[16 * cb + lr] + red[64 + 16 * cb + lr]) + (red[128 + 16 * cb + lr] + red[192 + 16 * cb + lr]);
                const float rs = rsqrtf(ss * (1.0f / 128.0f) + EPS); const size_t tk = (size_t)TOK(16 * cb + lr);
                const f32x4 o0 = accO[0][cb] * rs * ng[0], o1 = accO[1][cb] * rs * ng[1]; const u32x4 g4 = gw[cb];
                u32x4 w; w.x = cvt_pk_bf16(o0[0] * bflo(g4.x), o0[1] * bfhi(g4.x)); w.y = cvt_pk_bf16(o0[2] * bflo(g4.y), o0[3] * bfhi(g4.y)); w.z = cvt_pk_bf16(o1[0] * bflo(g4.z), o1[1] * bfhi(g4.z)); w.w = cvt_pk_bf16(o1[2] * bflo(g4.w), o1[3] * bfhi(g4.w));
                *(u32x4*)(MIX + tk * D + ocol) = w; }
        }
        if (s == 31) { asm volatile("s_waitcnt vmcnt(0)" ::: "memory"); __syncthreads(); }
        GLA_BAR();
#undef TOK
    }
}
#undef CHUNK
#undef POS

PHASE_FN void gla_item(const Params& p, unsigned char* lds, int l, int item) {
    int tid = threadIdx.x; asm volatile("" : "+v"(tid));
    if (tid < 256) gla_prep(p, lds, l, item, tid); else gla_mma(p, lds, l, item, tid);
    __syncthreads();
}

constexpr int SP = 136;
constexpr int L_SW = 0;
constexpr int L_SV0 = 128 * SP * 2;
constexpr int L_SV1 = 2 * 128 * SP * 2;
PHASE_FN void sgu_block(const Params& p, unsigned char* lds, int l, int g, int ch0, int nch) {
    unsigned char* ws = p.ws;
    int tid = threadIdx.x; asm volatile("" : "+v"(tid));
    const int wid = __builtin_amdgcn_readfirstlane(tid >> 6), lane = tid & 63, lr = lane & 15, q4 = lane >> 4;
    const bf16_t* __restrict__ Z = (const bf16_t*)(ws + WS_Z); bf16_t* __restrict__ MIX = (bf16_t*)(ws + WS_MIX);
    const bf16_t* __restrict__ wsb = (const bf16_t*)(ws + WS_WSB) + (size_t)(l * 4 + g) * 128 * 128;
    bf16_t* wl = (bf16_t*)(lds + L_SW);
    const int lrow = tid >> 4, cs = (tid & 15) * 8;
#pragma unroll
    for (int i = 0; i < 4; ++i) *(u32x4*)(wl + (lrow + 32 * i) * SP + cs) = *(const u32x4*)(wsb + (size_t)(lrow + 32 * i) * 128 + cs);
    const float* ngp = p.sgu_norm_g + (size_t)l * 512 + g * 128 + cs; const f32x4 g0 = *(const f32x4*)ngp, g1 = *(const f32x4*)(ngp + 4);
    float bs[8];
#pragma unroll
    for (int pb = 0; pb < 8; ++pb) bs[pb] = p.b_s[(size_t)l * 512 + g * 128 + 16 * pb + lr];
    const int ocol = g * 128 + 16 * wid + 4 * q4;
    u32x4 pv[4];
#define SGU_LOAD(ch) do { _Pragma("unroll") for (int i = 0; i < 4; ++i) pv[i] = *(const u32x4*)(Z + (size_t)((ch) * 128 + lrow + 32 * i) * ZW + ZSV + g * 128 + cs); } while (0)
    SGU_LOAD(ch0);
    int buf = 0;
    for (int ch = ch0; ch < ch0 + nch; ++ch, buf ^= 1) {
        const int tok0 = ch * 128;
        bf16_t* vt = (bf16_t*)(lds + (buf ? L_SV1 : L_SV0));
#pragma unroll
        for (int i = 0; i < 4; ++i) { const u32x4 w = pv[i];
            float v[8];
            { const f32x2 a = gelu_pk((f32x2){bflo(w.x), bfhi(w.x)}), b2 = gelu_pk((f32x2){bflo(w.y), bfhi(w.y)}), c = gelu_pk((f32x2){bflo(w.z), bfhi(w.z)}), d = gelu_pk((f32x2){bflo(w.w), bfhi(w.w)});
              v[0] = a.x; v[1] = a.y; v[2] = b2.x; v[3] = b2.y; v[4] = c.x; v[5] = c.y; v[6] = d.x; v[7] = d.y; }
            float ss = 0.f;
#pragma unroll
            for (int k = 0; k < 8; ++k) ss += v[k] * v[k];
            ss += __shfl_xor(ss, 1); ss += __shfl_xor(ss, 2); ss += __shfl_xor(ss, 4); ss += __shfl_xor(ss, 8);
            const float rs = rsqrtf(ss * (1.0f / 128.0f) + EPS);
            u32x4 o; o.x = cvt_pk_bf16(v[0] * rs * g0[0], v[1] * rs * g0[1]); o.y = cvt_pk_bf16(v[2] * rs * g0[2], v[3] * rs * g0[3]);
            o.z = cvt_pk_bf16(v[4] * rs * g1[0], v[5] * rs * g1[1]); o.w = cvt_pk_bf16(v[6] * rs * g1[2], v[7] * rs * g1[3]);
            *(u32x4*)(vt + (lrow + 32 * i) * SP + cs) = o; }
        if (ch + 1 < ch0 + nch) SGU_LOAD(ch + 1);
        u32x2 uw[8];
#pragma unroll
        for (int pb = 0; pb < 8; ++pb) uw[pb] = *(const u32x2*)(Z + (size_t)(tok0 + 16 * pb + lr) * ZW + ZSU + ocol);
        asm volatile("s_waitcnt lgkmcnt(0)" ::: "memory"); __builtin_amdgcn_s_barrier(); asm volatile("" ::: "memory");
        bf16x8 af[4];
#pragma unroll
        for (int ks = 0; ks < 4; ++ks)
#pragma unroll
            for (int i = 0; i < 8; ++i) af[ks][i] = (short)vt[(32 * ks + 8 * q4 + i) * SP + 16 * wid + lr];
#pragma unroll
        for (int pb = 0; pb < 8; ++pb) {
            f32x4 a = (f32x4){0.f, 0.f, 0.f, 0.f};
#pragma unroll
            for (int ks = 0; ks < 4; ++ks) { const bf16x8 bf = *(const bf16x8*)(wl + (16 * pb + lr) * SP + 32 * ks + 8 * q4); a = __builtin_amdgcn_mfma_f32_16x16x32_bf16(af[ks], bf, a, 0, 0, 0); }
            const f32x2 u0 = gelu_pk((f32x2){bflo(uw[pb].x), bfhi(uw[pb].x)}), u1 = gelu_pk((f32x2){bflo(uw[pb].y), bfhi(uw[pb].y)});
            u32x2 w; w.x = cvt_pk_bf16((a[0] + bs[pb]) * u0.x, (a[1] + bs[pb]) * u0.y); w.y = cvt_pk_bf16((a[2] + bs[pb]) * u1.x, (a[3] + bs[pb]) * u1.y);
            *(u32x2*)(MIX + (size_t)(tok0 + 16 * pb + lr) * D + 512 + ocol) = w;
        }
    }
#undef SGU_LOAD
    __syncthreads();
}

#define XB_TMO      128
#define XB_XCNT(j)  (256  + 64 * (j))
#define XB_XSUB(j)  (1280 + 64 * (j))
#define XB_XGEN(j)  (2304 + 64 * (j))
#define XB_TOP      3328
#define XB_TOPGEN   3392
#define XCD_BAR_WORDS 3456
#define XB_SPIN_CAP (1u << 18)

__device__ __forceinline__ unsigned xb_ld(unsigned* p)              { return __hip_atomic_load(p, __ATOMIC_RELAXED, __HIP_MEMORY_SCOPE_AGENT); }
__device__ __forceinline__ unsigned xb_add(unsigned* p, unsigned v) { return __hip_atomic_fetch_add(p, v, __ATOMIC_RELAXED, __HIP_MEMORY_SCOPE_AGENT); }
__device__ __forceinline__ unsigned xb_xcc_id() { return (unsigned)__builtin_amdgcn_s_getreg((3 << 11) | 20) & 0xFu; }
#define XB_SPIN(cond, bar) do { unsigned _sp = 0; while (cond) { __builtin_amdgcn_s_sleep(1); \
    if ((++_sp & 255u) == 0u) { if (xb_ld(&(bar)[XB_TMO])) break; if (_sp > XB_SPIN_CAP) { atomicAdd(&(bar)[XB_TMO], 1u); break; } } } } while (0)

struct XcdBarrier {
    unsigned* bar; unsigned x;
    volatile LAS unsigned* st;
};

__device__ __forceinline__ XcdBarrier xcd_barrier_post(unsigned* bar, volatile LAS unsigned* st) {
    XcdBarrier b; b.bar = bar; b.x = xb_xcc_id(); b.st = st;
    if (threadIdx.x == 0) (void)xb_add(&bar[XB_XCNT(b.x)], 1u);
    return b;
}
__device__ __forceinline__ void xcd_barrier_complete(unsigned* bar, unsigned x, unsigned& nloc, unsigned& nx) {
    const unsigned G = gridDim.x * gridDim.y * gridDim.z;
    unsigned sum, cnt, mine, sp = 0u;
    for (;;) {
        sum = 0u; cnt = 0u; mine = 0u;
#pragma unroll
        for (unsigned j = 0; j < 16; ++j) { const unsigned c = xb_ld(&bar[XB_XCNT(j)]); sum += c; cnt += (c > 0u) ? 1u : 0u; mine = (j == x) ? c : mine; }
        if (sum == G) break;
        __builtin_amdgcn_s_sleep(1);
        if ((++sp & 255u) == 0u) { if (xb_ld(&bar[XB_TMO])) break; if (sp > XB_SPIN_CAP) { atomicAdd(&bar[XB_TMO], 1u); break; } }
    }
    nloc = mine > 0u ? mine : 1u; nx = cnt > 0u ? cnt : 1u;
}

__device__ __forceinline__ void xcd_barrier(const XcdBarrier& b) {
    asm volatile("s_waitcnt vmcnt(0)" ::: "memory");
    __syncthreads();
    if (threadIdx.x == 0) {
        unsigned* bar = b.bar;
        __builtin_amdgcn_s_waitcnt(0);
        unsigned nloc = b.st[0], nx = b.st[1];
        if (nloc == 0u) { xcd_barrier_complete(bar, b.x, nloc, nx); b.st[0] = nloc; b.st[1] = nx; }
        const unsigned old = xb_add(&bar[XB_XSUB(b.x)], 1u);
        const unsigned gen = old / nloc;
        if (old + 1u == (gen + 1u) * nloc) {
            __builtin_amdgcn_fence(__ATOMIC_RELEASE, "agent");
            asm volatile("s_waitcnt vmcnt(0)" ::: "memory");
            const unsigned og = xb_add(&bar[XB_TOP], 1u);
            const unsigned tg = og / nx;
            if (og + 1u == (tg + 1u) * nx) xb_add(&bar[XB_TOPGEN], 1u);
            else XB_SPIN(xb_ld(&bar[XB_TOPGEN]) == tg, bar);
            __builtin_amdgcn_fence(__ATOMIC_ACQUIRE, "agent");
            xb_add(&bar[XB_XGEN(b.x)], 1u);
            asm volatile("s_waitcnt vmcnt(0)" ::: "memory");
        } else {
            XB_SPIN(xb_ld(&bar[XB_XGEN(b.x)]) == gen, bar);
            __builtin_amdgcn_fence(__ATOMIC_ACQUIRE, "agent");
            asm volatile("s_waitcnt vmcnt(0)" ::: "memory");
        }
    }
    __syncthreads();
}

template <class Epi>
PHASE_FN void gemm_call(LAS unsigned char* ldsl, const bf16_t* A, const bf16_t* Bt, int N, int K, Epi E, int smode = 0, int sbase = 0) {
    pg8::Gemm g{A, Bt, T, N, K}; pg8::StaticOrder S; S.init(T, N, (int)gridDim.x, (int)blockIdx.x); S.mode = smode; S.base = sbase;
    pg8::gemm_phase<Epi, pg8::StaticOrder, true, true>(ldsl, g, S, E);
}
__global__ void __launch_bounds__(512, 2) fwd_megakernel(Params p) {
    extern __shared__ __attribute__((aligned(16))) unsigned char lds[];
    cg::grid_group grid = cg::this_grid();
    unsigned char* ws = p.ws;
    const int G = gridDim.x, bx = blockIdx.x;
    bf16_t* XB = (bf16_t*)(ws + WS_XB); float* SSQ = (float*)(ws + WS_SSQ); bf16_t* Zb = (bf16_t*)(ws + WS_Z); bf16_t* DECb = (bf16_t*)(ws + WS_DEC);
    bf16_t* MIXb = (bf16_t*)(ws + WS_MIX); bf16_t* HID = (bf16_t*)(ws + WS_HID);
    LAS unsigned char* ldsl = (LAS unsigned char*)lds;
    volatile LAS unsigned* xst = (volatile LAS unsigned*)(ldsl + 131072 + 320);
    if (threadIdx.x < 4) xst[threadIdx.x] = 0u;
    __syncthreads();
    const XcdBarrier xbar = xcd_barrier_post((unsigned*)(ws + WS_CTL + 512 * 1024), xst);

#ifndef NO_PREP
    phase_prep(p, (float*)lds);
#endif
    asm volatile("s_waitcnt vmcnt(0)" ::: "memory"); __syncthreads();
    __threadfence();
    grid.sync();
    for (int l = 0; l < DEPTH; ++l) {
        for (int part = 0; part < 2; ++part) {
            if (part == 1 && bx < 128) break;
            gemm_call<pg8::EpiZ>(ldsl, XB, (const bf16_t*)(ws + WS_WIN) + (size_t)l * ZW * D, part == 0 ? ZN_A : ZW, D, pg8::EpiZ{Zb, DECb, SSQ, (LAS float*)(ldsl + 131072 + 1024), -1}, part, 2 * (bx - 128));
            if (part == 0) xcd_barrier(xbar);
        }
        if (bx < 128) gla_item(p, lds, l, bx);
        else if (bx < 256) {
            __builtin_amdgcn_fence(__ATOMIC_ACQUIRE, "agent"); asm volatile("s_waitcnt vmcnt(0)" ::: "memory"); __syncthreads();
            for (int g = 0; g < 4; ++g) sgu_block(p, lds, l, g, 4 * (bx - 128), 4);
        }
        xcd_barrier(xbar);
#ifndef NO_G2
        gemm_call<pg8::EpiRes>(ldsl, MIXb, (const bf16_t*)(ws + WS_WOUT) + (size_t)l * D * D, D, D, pg8::EpiRes{p.x, p.out, XB, SSQ, l == 0 ? 1 : 0});
#endif
        xcd_barrier(xbar);
#ifndef NO_G3
        gemm_call<pg8::EpiH>(ldsl, XB, (const bf16_t*)(ws + WS_W1) + (size_t)l * FF * D, FF, D, pg8::EpiH{HID, SSQ, (LAS float*)(ldsl + 131072 + 1024), -1});
#endif
        xcd_barrier(xbar);
#ifndef NO_G4
        gemm_call<pg8::EpiRes>(ldsl, HID, (const bf16_t*)(ws + WS_W2) + (size_t)l * D * FF, D, FF, pg8::EpiRes{p.x, p.out, XB, SSQ, 0});
#endif
        xcd_barrier(xbar);
    }
    { const int tid = threadIdx.x;
      for (size_t i = ((size_t)bx * 512 + tid) * 8; i < (size_t)T * D; i += (size_t)G * 512 * 8) {
          const int r = (int)(i >> 10), c = (int)(i & 1023);
          const float* sp = SSQ + (size_t)r * 16; float s = 0.f;
#pragma unroll
          for (int j = 0; j < 4; ++j) { const f32x4 q = *(const f32x4*)(sp + 4 * j); s += (q[0] + q[1]) + (q[2] + q[3]); }
          const float rs = rsqrtf(s * (1.0f / 1024.0f) + EPS);
          const u32x4 w = *(const u32x4*)(XB + i); const f32x4 g0 = *(const f32x4*)(p.final_norm_g + c), g1 = *(const f32x4*)(p.final_norm_g + c + 4);
          *(f32x4*)(p.out + i) = (f32x4){bflo(w.x), bfhi(w.x), bflo(w.y), bfhi(w.y)} * rs * g0;
          *(f32x4*)(p.out + i + 4) = (f32x4){bflo(w.z), bfhi(w.z), bflo(w.w), bfhi(w.w)} * rs * g1; } }
}

extern "C" void kernel_launch(void* const* d_in, const int* in_sizes, int n_in, void* d_out, int out_size, void* d_ws, size_t ws_size, hipStream_t stream) {
    static int grid = 0;
    if (grid == 0) {
        if (n_in != 16 || out_size != T * D || ws_size < WS_END) { fprintf(stderr, "kernel_launch: unexpected shapes: n_in %d out %d ws %zu (need %zu)\n", n_in, out_size, ws_size, (size_t)WS_END); grid = -1; return; }
        int dev = 0, cus = 0, per_cu = 0;
        (void)hipGetDevice(&dev); (void)hipDeviceGetAttribute(&cus, hipDeviceAttributeMultiprocessorCount, dev);
        if (hipFuncSetAttribute((const void*)fwd_megakernel, hipFuncAttributeMaxDynamicSharedMemorySize, LDS_BYTES) != hipSuccess) { fprintf(stderr, "kernel_launch: hipFuncSetAttribute failed\n"); grid = -1; return; }
        (void)hipOccupancyMaxActiveBlocksPerMultiprocessor(&per_cu, (const void*)fwd_megakernel, 512, LDS_BYTES);
        (void)hipGetLastError();
        if (per_cu < 1) { fprintf(stderr, "kernel_launch: occupancy query says %d blocks per CU\n", per_cu); per_cu = 1; }
        grid = cus;
        if (grid < 256) { fprintf(stderr, "kernel_launch: %d CUs; this kernel's mixer phase needs a grid of at least 256\n", grid); }
    }
    if (grid < 0) return;
    (void)hipMemsetAsync((char*)d_ws + WS_CTL, 0, CTL_BYTES, stream);
    Params p{};
    p.x = (const float*)d_in[0]; p.norm_mix_g = (const float*)d_in[1]; p.w_in = (const float*)d_in[2]; p.w_a2_fwd = (const float*)d_in[3]; p.b_a_fwd = (const float*)d_in[4];
    p.w_a2_bwd = (const float*)d_in[5]; p.b_a_bwd = (const float*)d_in[6]; p.gla_norm_g = (const float*)d_in[7]; p.sgu_norm_g = (const float*)d_in[8]; p.w_s = (const float*)d_in[9];
    p.b_s = (const float*)d_in[10]; p.w_out = (const float*)d_in[11]; p.norm_mlp_g = (const float*)d_in[12]; p.w_mlp1 = (const float*)d_in[13]; p.w_mlp2 = (const float*)d_in[14];
    p.final_norm_g = (const float*)d_in[15]; p.out = (float*)d_out; p.ws = (unsigned char*)d_ws;
    void* args[] = {&p};
    hipError_t e = hipLaunchCooperativeKernel((const void*)fwd_megakernel, dim3(grid), dim3(512), args, LDS_BYTES, stream);
    if (e != hipSuccess) fprintf(stderr, "cooperative launch failed: %s (grid %d)\n", hipGetErrorString(e), grid);
}
```

```cpp
#include <hip/hip_runtime.h>
#include <hip/hip_cooperative_groups.h>
#include <cstdio>
namespace cg = cooperative_groups;

#define LAS __attribute__((address_space(3)))
#ifndef PHASE_FN
#define PHASE_FN __device__ __forceinline__
#endif
typedef unsigned short bf16_t;
typedef short bf16x8 __attribute__((ext_vector_type(8)));
typedef short bf16x4 __attribute__((ext_vector_type(4)));
typedef float f32x4 __attribute__((ext_vector_type(4)));
typedef float f32x2 __attribute__((ext_vector_type(2)));
typedef unsigned u32x4 __attribute__((ext_vector_type(4)));
typedef unsigned u32x2 __attribute__((ext_vector_type(2)));

constexpr int T = 65536, D = 1024, FF = 4096, SEQ = 4096, DEPTH = 4;
constexpr int ZW = 2816;
constexpr int D_IN = 2592;
constexpr float EPS = 1e-6f;
constexpr int ZQ = 0, ZK = 256, ZV = 512, ZG = 1024, ZSU = 1536, ZSV = 2304;
constexpr int ZN_A = 2304;

constexpr size_t MiB = 1u << 20;
constexpr size_t WS_CTL = 0, CTL_BYTES = 1 * MiB;
constexpr size_t WS_WIN = 1 * MiB;
constexpr size_t WS_WOUT = 23 * MiB;
constexpr size_t WS_W1 = 31 * MiB;
constexpr size_t WS_W2 = 63 * MiB;
constexpr size_t WS_WSB = 95 * MiB;
constexpr size_t WS_SSQ = 96 * MiB;
constexpr size_t WS_DEC = 100 * MiB;
constexpr size_t WS_XB = 108 * MiB;
constexpr size_t WS_Z = 236 * MiB;
constexpr size_t WS_MIX = 588 * MiB;
constexpr size_t WS_OX = 716 * MiB;
constexpr size_t WS_HID = 236 * MiB;
constexpr size_t WS_END = 844 * MiB;
constexpr int LDS_BYTES = 147456;

struct Params {
    const float* x; const float* norm_mix_g; const float* w_in; const float* w_a2_fwd; const float* b_a_fwd; const float* w_a2_bwd; const float* b_a_bwd;
    const float* gla_norm_g; const float* sgu_norm_g; const float* w_s; const float* b_s; const float* w_out; const float* norm_mlp_g; const float* w_mlp1;
    const float* w_mlp2; const float* final_norm_g; float* out; unsigned char* ws;
};

__device__ __forceinline__ unsigned cvt_pk_bf16(float lo, float hi) { unsigned r; asm volatile("v_cvt_pk_bf16_f32 %0, %1, %2" : "=v"(r) : "v"(lo), "v"(hi)); return r; }
__device__ __forceinline__ float bf2f(unsigned short b) { return __uint_as_float(((unsigned)b) << 16); }
__device__ __forceinline__ float bflo(unsigned w) { return __uint_as_float(w << 16); }
__device__ __forceinline__ float bfhi(unsigned w) { return __uint_as_float(w & 0xffff0000u); }

__device__ __forceinline__ f32x2 gelu_pk(f32x2 v) {
    const f32x2 av = __builtin_elementwise_abs(v), d = av * 0.2316418882f + 1.0f;
    f32x2 t; t.x = __builtin_amdgcn_rcpf(d.x); t.y = __builtin_amdgcn_rcpf(d.y);
    f32x2 q = t * 0.5307027145f + (-0.7265760135f); q = q * t + 0.7107068705f; q = q * t + (-0.142248368f); q = q * t + 0.127414796f; q = q * t;
    const f32x2 s = (v * v) * (-0.72134752044f);
    f32x2 e; e.x = __builtin_amdgcn_exp2f(s.x); e.y = __builtin_amdgcn_exp2f(s.y);
    const f32x2 m = v * (q * e), r = v - m;
    f32x2 o; o.x = v.x < 0.f ? m.x : r.x; o.y = v.y < 0.f ? m.y : r.y; return o;
}
__device__ __forceinline__ float silu_f(float v) { return v * __builtin_amdgcn_rcpf(1.0f + __expf(-v)); }

namespace pg8 {
constexpr int BM = 256, BK = 64, HALF = 128, HTB = HALF * BK * 2, STAGE_BYTES = 8 * HTB, NXCD = 8, WGM = 8;
__host__ __device__ __forceinline__ int lds_byte(int r, int c) { const int st = (r >> 4) * 2 + (c >> 5), rr = r & 15, cc = c & 31, ob = rr * 64 + cc * 2; return st * 1024 + (ob ^ (((ob >> 9) & 1) << 5)); }
__host__ __device__ __forceinline__ void stage_rc(int b, int& R, int& C) { const int st = b / 1024, sb = b % 1024, swz = sb ^ (((sb >> 9) & 1) << 5); R = (st >> 1) * 16 + swz / 64; C = (st & 1) * 32 + (swz % 64) / 2; }
__host__ __device__ __forceinline__ int perm32(int rho) { const int n = rho >> 4, i = rho & 15; return 8 * (i >> 2) + 4 * n + (i & 3); }
struct Unit { int pm, pn; };
struct Gemm { const bf16_t* A; const bf16_t* Bt; int M, N, K; };
struct StaticOrder {
    int nM, nN, nwg, G, c, mode, base;
    __device__ void init(int M, int N, int G_, int c_) { nM = M / BM; nN = N / BM; nwg = nM * nN; G = G_; c = c_; mode = 0; base = 0; }
    __device__ bool next(int i, Unit& u) const {
        if (mode == 1) { if (i >= 4) return false; u.pm = base + (i >> 1); u.pn = 9 + (i & 1); return true; }
        const long L = (long)i * G + c; if (L >= nwg) return false;
        int wgid = (int)L; { const int q = nwg / NXCD, r = nwg % NXCD, xcd = wgid % NXCD, off = wgid / NXCD; wgid = (xcd < r ? xcd * (q + 1) : r * (q + 1) + (xcd - r) * q) + off; }
        const int nig = WGM * nN, gid = wgid / nig, fm = gid * WGM, gsz = (nM - fm) < WGM ? (nM - fm) : WGM;
        u.pm = fm + ((wgid % nig) % gsz); u.pn = (wgid % nig) / gsz; return true;
    }
    __device__ __forceinline__ void a_ready(const Unit&) const {}
    __device__ __forceinline__ void done(const Unit&) const {}
};

template <class Epi, class Sched, bool ALIGN_EPI = false, bool SP2 = false>
__device__ __forceinline__ void gemm_phase(LAS unsigned char* lds, const Gemm g, const Sched& S, const Epi& E) {
    int tid = threadIdx.x; asm volatile("" : "+v"(tid));
    const int wid = __builtin_amdgcn_readfirstlane(tid >> 6), lane = tid & 63, wr = wid >> 2, wc = wid & 3, fr = lane & 15, fq = lane >> 4;
    const int K = g.K, nt = K / BK;
    unsigned voffA[2], voffB[2];
#pragma unroll
    for (int i = 0; i < 2; ++i) { int R, C; stage_rc(tid * 16 + i * 8192, R, C); const int Rb = Epi::PERM ? ((R & ~31) + perm32(R & 31)) : R;
        voffA[i] = (unsigned)(R * K + C) * 2u; voffB[i] = (unsigned)(Rb * K + C) * 2u; }
    const size_t kstep = (size_t)(BK * 2);
    const size_t hstep = (size_t)HALF * K * 2;
    const size_t tstep = 2 * hstep;
    const unsigned ldsw = (unsigned)wid * 1024u;
    const int aoff = lds_byte(wr * 64 + fr, fq * 8), boff = lds_byte(wc * 32 + fr, fq * 8);
#define PG8_SA(b, h) (((b) * 2 + (h)) * HTB)
#define PG8_SB(b, h) ((4 + (b) * 2 + (h)) * HTB)
#define PG8_STAGE(bufoff, gbase, voff) do { _Pragma("unroll") for (int _i = 0; _i < 2; ++_i) \
        __builtin_amdgcn_global_load_lds((const unsigned*)((const char*)(gbase) + (voff)[_i]), (LAS unsigned*)(lds + (bufoff) + ldsw + _i * 8192), 16, 0, 0); } while (0)
#define PG8_LDA(dst, b, h) do { _Pragma("unroll") for (int m = 0; m < 4; ++m) _Pragma("unroll") for (int k = 0; k < 2; ++k) dst[m][k] = *(const LAS bf16x8*)(lds + PG8_SA(b, h) + aoff + m * 2048 + k * 1024); } while (0)
#define PG8_LDB(dst, b, h) do { _Pragma("unroll") for (int n = 0; n < 2; ++n) _Pragma("unroll") for (int k = 0; k < 2; ++k) dst[n][k] = *(const LAS bf16x8*)(lds + PG8_SB(b, h) + boff + n * 2048 + k * 1024); } while (0)
#define PG8_MMA(ai, bj, At, Bt) do { __builtin_amdgcn_s_setprio(1); _Pragma("unroll") for (int m = 0; m < 4; ++m) _Pragma("unroll") for (int n = 0; n < 2; ++n) _Pragma("unroll") for (int k = 0; k < 2; ++k) \
        acc[ai][bj][m][n] = __builtin_amdgcn_mfma_f32_16x16x32_bf16(Bt[n][k], At[m][k], acc[ai][bj][m][n], 0, 0, 0); __builtin_amdgcn_s_setprio(0); } while (0)
#define PG8_WAIT_V(n) asm volatile("s_waitcnt vmcnt(" #n ")" ::: "memory")
#define PG8_WAIT_L(n) asm volatile("s_waitcnt lgkmcnt(" #n ")" ::: "memory")
#define PG8_BAR __builtin_amdgcn_s_barrier()
#define PG8_SCHED __builtin_amdgcn_sched_barrier(0)
    Unit cur, nxt; int ui = 0;
    if (!S.next(0, cur)) return;
    f32x4 acc[2][2][4][2];
#pragma unroll
    for (int a = 0; a < 2; ++a)
#pragma unroll
        for (int b = 0; b < 2; ++b)
#pragma unroll
            for (int m = 0; m < 4; ++m)
#pragma unroll
                for (int n = 0; n < 2; ++n) acc[a][b][m][n] = (f32x4){0.f, 0.f, 0.f, 0.f};
    bf16x8 At[4][2], B0[2][2], B1[2][2];
    const char* cA = (const char*)g.A + (size_t)cur.pm * tstep; const char* cB = (const char*)g.Bt + (size_t)cur.pn * tstep;
    S.a_ready(cur);
    if constexpr (SP2) {
        PG8_STAGE(PG8_SB(0, 0), cB, voffB); PG8_STAGE(PG8_SB(0, 1), cB + hstep, voffB); PG8_STAGE(PG8_SA(0, 0), cA, voffA); PG8_STAGE(PG8_SA(0, 1), cA + hstep, voffA);
        if (wr == 1) PG8_BAR;
        PG8_WAIT_V(2); PG8_BAR;
        PG8_STAGE(PG8_SB(1, 0), cB + kstep, voffB); PG8_STAGE(PG8_SA(1, 0), cA + kstep, voffA); PG8_STAGE(PG8_SB(1, 1), cB + hstep + kstep, voffB);
        PG8_WAIT_V(6); PG8_BAR;
    } else {
        PG8_STAGE(PG8_SB(0, 0), cB, voffB); PG8_STAGE(PG8_SA(0, 0), cA, voffA); PG8_STAGE(PG8_SB(0, 1), cB + hstep, voffB); PG8_STAGE(PG8_SA(0, 1), cA + hstep, voffA);
        if (wr == 1) PG8_BAR;
        PG8_WAIT_V(4); PG8_BAR;
        PG8_STAGE(PG8_SB(1, 0), cB + kstep, voffB); PG8_STAGE(PG8_SA(1, 0), cA + kstep, voffA); PG8_STAGE(PG8_SB(1, 1), cB + hstep + kstep, voffB);
        PG8_WAIT_V(6); PG8_BAR;
    }
    for (;;) {
        const bool has_next = S.next(ui + 1, nxt);
        const char* nA = has_next ? (const char*)g.A + (size_t)nxt.pm * tstep : cA; const char* nB = has_next ? (const char*)g.Bt + (size_t)nxt.pn * tstep : cB;
        for (int t = 0; t < nt; t += 2) {
            const bool last = (t == nt - 2);
            const char* a1 = cA + (size_t)(t + 1) * kstep;
            const char* a2 = last ? nA : cA + (size_t)(t + 2) * kstep; const char* b2 = last ? nB : cB + (size_t)(t + 2) * kstep;
            const char* a3 = a2 + kstep; const char* b3 = b2 + kstep;
            if (last && has_next) S.a_ready(nxt);
            if constexpr (SP2) {
            PG8_LDB(B0, 0, 0); PG8_LDB(B1, 0, 1); PG8_SCHED; PG8_LDA(At, 0, 0); PG8_STAGE(PG8_SA(1, 1), a1 + hstep, voffA);
            PG8_WAIT_V(8); PG8_WAIT_L(0); PG8_BAR; PG8_MMA(0, 0, At, B0); PG8_MMA(0, 1, At, B1); PG8_BAR; PG8_SCHED;
            PG8_LDA(At, 0, 1); PG8_STAGE(PG8_SB(0, 0), b2, voffB); PG8_STAGE(PG8_SB(0, 1), b2 + hstep, voffB); PG8_STAGE(PG8_SA(0, 0), a2, voffA);
            PG8_WAIT_V(8); PG8_WAIT_L(0); PG8_BAR; PG8_MMA(1, 0, At, B0); PG8_MMA(1, 1, At, B1); PG8_BAR; PG8_SCHED;
            PG8_LDB(B0, 1, 0); PG8_LDB(B1, 1, 1); PG8_SCHED; PG8_LDA(At, 1, 0); PG8_STAGE(PG8_SA(0, 1), a2 + hstep, voffA);
            PG8_WAIT_V(8); PG8_WAIT_L(0); PG8_BAR; PG8_MMA(0, 0, At, B0); PG8_MMA(0, 1, At, B1); PG8_BAR; PG8_SCHED;
            PG8_LDA(At, 1, 1); PG8_STAGE(PG8_SB(1, 0), b3, voffB); PG8_STAGE(PG8_SB(1, 1), b3 + hstep, voffB); PG8_STAGE(PG8_SA(1, 0), a3, voffA);
            PG8_WAIT_V(8); PG8_WAIT_L(0); PG8_BAR; PG8_MMA(1, 0, At, B0); PG8_MMA(1, 1, At, B1); PG8_BAR; PG8_SCHED;
            } else {
            PG8_LDB(B0, 0, 0); PG8_SCHED; PG8_LDA(At, 0, 0); PG8_STAGE(PG8_SA(1, 1), a1 + hstep, voffA);
            PG8_WAIT_L(8); PG8_BAR; PG8_WAIT_L(0); PG8_MMA(0, 0, At, B0); PG8_BAR; PG8_SCHED;
            PG8_LDB(B1, 0, 1); PG8_STAGE(PG8_SB(0, 0), b2, voffB);
            PG8_BAR; PG8_WAIT_L(0); PG8_MMA(0, 1, At, B1); PG8_BAR;
            PG8_LDA(At, 0, 1); PG8_STAGE(PG8_SA(0, 0), a2, voffA);
            PG8_BAR; PG8_WAIT_L(0); PG8_MMA(1, 0, At, B0); PG8_BAR; PG8_SCHED;
            PG8_STAGE(PG8_SB(0, 1), b2 + hstep, voffB);
            PG8_WAIT_V(6); PG8_BAR; PG8_MMA(1, 1, At, B1); PG8_BAR;
            PG8_LDB(B0, 1, 0); PG8_SCHED; PG8_LDA(At, 1, 0); PG8_STAGE(PG8_SA(0, 1), a2 + hstep, voffA);
            PG8_WAIT_L(8); PG8_BAR; PG8_WAIT_L(0); PG8_MMA(0, 0, At, B0); PG8_BAR; PG8_SCHED;
            PG8_LDB(B1, 1, 1); PG8_STAGE(PG8_SB(1, 0), b3, voffB);
            PG8_BAR; PG8_WAIT_L(0); PG8_MMA(0, 1, At, B1); PG8_BAR;
            PG8_LDA(At, 1, 1); PG8_STAGE(PG8_SA(1, 0), a3, voffA);
            PG8_BAR; PG8_WAIT_L(0); PG8_MMA(1, 0, At, B0); PG8_BAR; PG8_SCHED;
            PG8_STAGE(PG8_SB(1, 1), b3 + hstep, voffB);
            PG8_WAIT_V(6); PG8_BAR; PG8_MMA(1, 1, At, B1); PG8_BAR;
            }
        }
        if constexpr (ALIGN_EPI) { if (wr == 0) PG8_BAR; }
        E(acc, cur, wr, wc, fr, fq); S.done(cur);
        if (!has_next) break;
#pragma unroll
        for (int a = 0; a < 2; ++a)
#pragma unroll
            for (int b = 0; b < 2; ++b)
#pragma unroll
                for (int m = 0; m < 4; ++m)
#pragma unroll
                    for (int n = 0; n < 2; ++n) acc[a][b][m][n] = (f32x4){0.f, 0.f, 0.f, 0.f};
        cur = nxt; cA = nA; cB = nB; ++ui;
        if constexpr (ALIGN_EPI) { if (wr == 1) PG8_BAR; }
    }
    PG8_WAIT_V(0);
    if constexpr (!ALIGN_EPI) { if (wr == 0) PG8_BAR; }
    PG8_BAR;
#undef PG8_SA
#undef PG8_SB
#undef PG8_STAGE
#undef PG8_LDA
#undef PG8_LDB
#undef PG8_MMA
#undef PG8_WAIT_V
#undef PG8_WAIT_L
#undef PG8_BAR
#undef PG8_SCHED
}

__device__ __forceinline__ void rows_rstd(const float* __restrict__ ssq, int row0, int fq, float (&rs)[2][4]) {
    f32x4 pp[2][4];
#pragma unroll
    for (int ai = 0; ai < 2; ++ai)
#pragma unroll
        for (int m = 0; m < 4; ++m) pp[ai][m] = *(const f32x4*)(ssq + (size_t)(row0 + ai * HALF + m * 16) * 16 + 4 * fq);
#pragma unroll
    for (int ai = 0; ai < 2; ++ai)
#pragma unroll
        for (int m = 0; m < 4; ++m) { float s = (pp[ai][m][0] + pp[ai][m][1]) + (pp[ai][m][2] + pp[ai][m][3]); s += __shfl_xor(s, 16); s += __shfl_xor(s, 32); rs[ai][m] = rsqrtf(s * (1.0f / 1024.0f) + EPS); }
}
__device__ __forceinline__ void rows_rstd_cached(const float* __restrict__ ssq, int row0, int fq, float (&rs)[2][4], bool hit, LAS float* cache, int lrow0, bool writer) {
    if (hit) {
#pragma unroll
        for (int ai = 0; ai < 2; ++ai)
#pragma unroll
            for (int m = 0; m < 4; ++m) rs[ai][m] = cache[lrow0 + ai * HALF + m * 16];
    } else {
        rows_rstd(ssq, row0, fq, rs);
        if (writer) {
#pragma unroll
            for (int ai = 0; ai < 2; ++ai)
#pragma unroll
                for (int m = 0; m < 4; ++m) cache[lrow0 + ai * HALF + m * 16] = rs[ai][m];
        }
    }
}
struct EpiZ {
    static constexpr bool PERM = true;
    bf16_t* Z; bf16_t* DEC; const float* ssq; LAS float* rsc; mutable int cached_pm;
    __device__ __forceinline__ void operator()(const f32x4 (&acc)[2][2][4][2], const Unit& u, int wr, int wc, int fr, int fq) const {
        const int row0 = u.pm * BM + wr * 64 + fr; const int pn = u.pn;
        float rsv[2][4]; rows_rstd_cached(ssq, row0, fq, rsv, u.pm == cached_pm, rsc, wr * 64 + fr, wc == 0 && fq == 0); cached_pm = u.pm;
#pragma unroll
        for (int ai = 0; ai < 2; ++ai)
#pragma unroll
            for (int m = 0; m < 4; ++m) {
                const int r = row0 + ai * HALF + m * 16; const float rs = rsv[ai][m];
                if (pn == 8) {
                    if (wc == 0) { const f32x4 v0 = acc[ai][0][m][0] * rs, v1 = acc[ai][0][m][1] * rs; u32x4 w; w.x = cvt_pk_bf16(v0[0], v0[1]); w.y = cvt_pk_bf16(v0[2], v0[3]); w.z = cvt_pk_bf16(v1[0], v1[1]); w.w = cvt_pk_bf16(v1[2], v1[3]); *(u32x4*)(DEC + (size_t)r * 32 + 8 * fq) = w; }
                } else {
                    bf16_t* rowp = Z + (size_t)r * ZW + pn * BM + wc * 32 + 8 * fq;
#pragma unroll
                    for (int bj = 0; bj < 2; ++bj) { f32x4 v0 = acc[ai][bj][m][0] * rs, v1 = acc[ai][bj][m][1] * rs;
                        if (pn >= 4 && pn < 6) {
#pragma unroll
                            for (int j = 0; j < 4; ++j) { v0[j] = silu_f(v0[j]); v1[j] = silu_f(v1[j]); } }
                        u32x4 w; w.x = cvt_pk_bf16(v0[0], v0[1]); w.y = cvt_pk_bf16(v0[2], v0[3]); w.z = cvt_pk_bf16(v1[0], v1[1]); w.w = cvt_pk_bf16(v1[2], v1[3]);
                        *(u32x4*)(rowp + bj * HALF) = w; }
                }
            }
    }
};
struct EpiH {
    static constexpr bool PERM = true;
    bf16_t* H; const float* ssq; LAS float* rsc; mutable int cached_pm;
    __device__ __forceinline__ void operator()(const f32x4 (&acc)[2][2][4][2], const Unit& u, int wr, int wc, int fr, int fq) const {
        const int row0 = u.pm * BM + wr * 64 + fr;
        float rsv[2][4]; rows_rstd_cached(ssq, row0, fq, rsv, u.pm == cached_pm, rsc, wr * 64 + fr, wc == 0 && fq == 0); cached_pm = u.pm;
#pragma unroll
        for (int ai = 0; ai < 2; ++ai)
#pragma unroll
            for (int m = 0; m < 4; ++m) {
                const int r = row0 + ai * HALF + m * 16; const float rs = rsv[ai][m];
                bf16_t* rowp = H + (size_t)r * FF + u.pn * BM + wc * 32 + 8 * fq;
#pragma unroll
                for (int bj = 0; bj < 2; ++bj) { f32x4 v0 = acc[ai][bj][m][0] * rs, v1 = acc[ai][bj][m][1] * rs;
#pragma unroll
                    for (int j = 0; j < 4; ++j) { const float a = fmaxf(v0[j], 0.f), b = fmaxf(v1[j], 0.f); v0[j] = a * a; v1[j] = b * b; }
                    u32x4 w; w.x = cvt_pk_bf16(v0[0], v0[1]); w.y = cvt_pk_bf16(v0[2], v0[3]); w.z = cvt_pk_bf16(v1[0], v1[1]); w.w = cvt_pk_bf16(v1[2], v1[3]);
                    *(u32x4*)(rowp + bj * HALF) = w; }
            }
    }
};
template <bool RD32>
__device__ __forceinline__ void res_rows(const float* __restrict__ xold32, const bf16_t* __restrict__ xoldb, bf16_t* __restrict__ xb, float* __restrict__ ssq, const f32x4 (&acc)[2][2][4][2], int row0, int col0, int slot) {
    f32x4 xo[2][2][2];
    float ssv[8];
    auto ld = [&](size_t o, f32x4& a, f32x4& b) { if (RD32) { a = *(const f32x4*)(xold32 + o); b = *(const f32x4*)(xold32 + o + 4); }
        else { const u32x4 w = *(const u32x4*)(xoldb + o); a = (f32x4){bflo(w.x), bfhi(w.x), bflo(w.y), bfhi(w.y)}; b = (f32x4){bflo(w.z), bfhi(w.z), bflo(w.w), bfhi(w.w)}; } };
#pragma unroll
    for (int bj = 0; bj < 2; ++bj) ld((size_t)row0 * D + col0 + bj * HALF, xo[0][bj][0], xo[0][bj][1]);
#pragma unroll
    for (int idx = 0; idx < 8; ++idx) {
        const int ai = idx >> 2, m = idx & 3; const int r = row0 + ai * HALF + m * 16; const size_t off = (size_t)r * D + col0;
        if (idx < 7) { const int ai2 = (idx + 1) >> 2, m2 = (idx + 1) & 3; const size_t off2 = (size_t)(row0 + ai2 * HALF + m2 * 16) * D + col0;
#pragma unroll
            for (int bj = 0; bj < 2; ++bj) ld(off2 + bj * HALF, xo[(idx + 1) & 1][bj][0], xo[(idx + 1) & 1][bj][1]); }
        float ss = 0.f;
#pragma unroll
        for (int bj = 0; bj < 2; ++bj) { const f32x4 x0 = xo[idx & 1][bj][0] + acc[ai][bj][m][0], x1 = xo[idx & 1][bj][1] + acc[ai][bj][m][1];
            u32x4 w; w.x = cvt_pk_bf16(x0[0], x0[1]); w.y = cvt_pk_bf16(x0[2], x0[3]); w.z = cvt_pk_bf16(x1[0], x1[1]); w.w = cvt_pk_bf16(x1[2], x1[3]);
            *(u32x4*)(xb + off + bj * HALF) = w;
            ss += ((x0[0] * x0[0] + x0[1] * x0[1]) + (x0[2] * x0[2] + x0[3] * x0[3])) + ((x1[0] * x1[0] + x1[1] * x1[1]) + (x1[2] * x1[2] + x1[3] * x1[3])); }
        ss += __shfl_xor(ss, 16); ss += __shfl_xor(ss, 32);
        ssv[idx] = ss;
    }
    const int fq = slot >> 6;
#pragma unroll
    for (int j = 0; j < 2; ++j) { const float v = fq == 0 ? ssv[j] : fq == 1 ? ssv[2 + j] : fq == 2 ? ssv[4 + j] : ssv[6 + j]; const int idx = 2 * fq + j;
        ssq[(size_t)(row0 + (idx >> 2) * HALF + (idx & 3) * 16) * 16 + (slot & 15)] = v; }
}
struct EpiRes {
    static constexpr bool PERM = true;
    const float* xold32; float* xout; bf16_t* xb; float* ssq; int mode;
    __device__ __forceinline__ void operator()(const f32x4 (&acc)[2][2][4][2], const Unit& u, int wr, int wc, int fr, int fq) const {
        const int row0 = u.pm * BM + wr * 64 + fr, col0 = u.pn * BM + wc * 32 + 8 * fq, slot = (u.pn * 4 + wc) | (fq << 6);
        if (mode == 0) res_rows<false>(xold32, xb, xb, ssq, acc, row0, col0, slot);
        else res_rows<true>(xold32, xb, xb, ssq, acc, row0, col0, slot);
    }
};
}

struct WTile { const float* src; bf16_t* dst; const float* g; int ldsrc, K, n0, k0, mode; };
__device__ __forceinline__ WTile wtile_desc(const Params& p, int it) {
    unsigned char* ws = p.ws; WTile t; const int l = it / 3008; int r = it % 3008;
    if (r < 704) { t.src = p.w_in + (size_t)l * D * D_IN; t.ldsrc = D_IN; t.dst = (bf16_t*)(ws + WS_WIN) + (size_t)l * ZW * D; t.K = D; t.n0 = (r / 16) * 64; t.k0 = (r % 16) * 64; t.g = p.norm_mix_g + l * D; t.mode = 0; }
    else if (r < 960) { r -= 704; t.src = p.w_out + (size_t)l * D * D; t.ldsrc = D; t.dst = (bf16_t*)(ws + WS_WOUT) + (size_t)l * D * D; t.K = D; t.n0 = (r / 16) * 64; t.k0 = (r % 16) * 64; t.g = nullptr; t.mode = 1; }
    else if (r < 1984) { r -= 960; t.src = p.w_mlp1 + (size_t)l * D * FF; t.ldsrc = FF; t.dst = (bf16_t*)(ws + WS_W1) + (size_t)l * FF * D; t.K = D; t.n0 = (r / 16) * 64; t.k0 = (r % 16) * 64; t.g = p.norm_mlp_g + l * D; t.mode = 1; }
    else { r -= 1984; t.src = p.w_mlp2 + (size_t)l * FF * D; t.ldsrc = D; t.dst = (bf16_t*)(ws + WS_W2) + (size_t)l * D * FF; t.K = FF; t.n0 = (r / 64) * 64; t.k0 = (r % 64) * 64; t.g = nullptr; t.mode = 1; }
    return t;
}
__device__ __forceinline__ void wtile_load(const WTile& w, int t, f32x4& a, f32x4& b, float& rsc) {
    const int kk = t >> 3, ns = (t & 7) * 8; const int nd = w.n0 + ns; int nsrc = nd; bool valid = true; float cs = 1.0f;
    if (w.mode == 0) { if (nd < 1536) nsrc = nd; else if (nd < 2048) nsrc = nd + 32; else if (nd < 2080) nsrc = nd - 512; else if (nd < 2304) valid = false; else nsrc = nd - 224; if (nd < 256) cs = 0.125f; }
    a = (f32x4){0.f, 0.f, 0.f, 0.f}; b = a;
    if (valid) { const float* sp = w.src + (size_t)(w.k0 + kk) * w.ldsrc + nsrc; a = *(const f32x4*)sp; b = *(const f32x4*)(sp + 4); }
    rsc = (w.g ? w.g[w.k0 + kk] : 1.0f) * cs;
}

PHASE_FN void phase_prep(const Params& p, float* ldsf) {
    unsigned char* ws = p.ws;
    const int G = gridDim.x, bx = blockIdx.x; int tid = threadIdx.x; asm volatile("" : "+v"(tid));
    { const int NT = DEPTH * 3008; int it = bx, buf = 0; f32x4 a, b; float rsc;
      WTile cur = wtile_desc(p, it < NT ? it : 0);
      if (it < NT) wtile_load(cur, tid, a, b, rsc);
      for (; it < NT; it += G, buf ^= 1) {
          float* tile = ldsf + buf * (64 * 65);
          { const int kk = tid >> 3, ns = (tid & 7) * 8; float* tp = tile + kk * 65 + ns;
#pragma unroll
            for (int j = 0; j < 4; ++j) { tp[j] = a[j] * rsc; tp[4 + j] = b[j] * rsc; } }
          const WTile w = cur;
          if (it + G < NT) { cur = wtile_desc(p, it + G); wtile_load(cur, tid, a, b, rsc); }
          asm volatile("s_waitcnt lgkmcnt(0)" ::: "memory"); __builtin_amdgcn_s_barrier(); asm volatile("" ::: "memory");
          { const int nn = tid >> 3, ks = (tid & 7) * 8; float v[8];
#pragma unroll
            for (int i = 0; i < 8; ++i) v[i] = tile[(ks + i) * 65 + nn];
            u32x4 o; o.x = cvt_pk_bf16(v[0], v[1]); o.y = cvt_pk_bf16(v[2], v[3]); o.z = cvt_pk_bf16(v[4], v[5]); o.w = cvt_pk_bf16(v[6], v[7]);
            *(u32x4*)(w.dst + (size_t)(w.n0 + nn) * w.K + w.k0 + ks) = o; }
      }
      __syncthreads(); }
    { bf16_t* wsb = (bf16_t*)(ws + WS_WSB);
      for (int i = (bx * 512 + tid) * 4; i < DEPTH * 4 * 128 * 128; i += G * 512 * 4) { const f32x4 v = *(const f32x4*)(p.w_s + i); u32x2 w; w.x = cvt_pk_bf16(v[0], v[1]); w.y = cvt_pk_bf16(v[2], v[3]); *(u32x2*)(wsb + i) = w; } }
    { bf16_t* xb = (bf16_t*)(ws + WS_XB); float* ssq = (float*)(ws + WS_SSQ); const int wid = tid >> 6, lane = tid & 63;
      for (int r = bx * 8 + wid; r < T; r += G * 8) { const float* xr = p.x + (size_t)r * D; float ss = 0.f;
#pragma unroll
          for (int i = 0; i < 4; ++i) { const int c = i * 256 + lane * 4; const f32x4 v = *(const f32x4*)(xr + c); ss += (v[0] * v[0] + v[1] * v[1]) + (v[2] * v[2] + v[3] * v[3]);
              u32x2 w; w.x = cvt_pk_bf16(v[0], v[1]); w.y = cvt_pk_bf16(v[2], v[3]); *(u32x2*)(xb + (size_t)r * D + c) = w; }
#pragma unroll
          for (int o = 32; o >= 1; o >>= 1) ss += __shfl_xor(ss, o);
          if (lane < 16) ssq[(size_t)r * 16 + lane] = lane == 0 ? ss : 0.f; } }
}

constexpr int GP = 72;
constexpr int VP = 132;
#define ROT(row, col) (((col) + 16 * ((row) >> 4)) & 63)
constexpr int L_QIN = 0, L_KIN = 9216, L_QOUT = 18432, L_KOUTT = 27648;
constexpr int L_DEC = 36864;
constexpr int L_RED = L_DEC + 256;
constexpr int L_QRAW = L_RED + 1024;
constexpr int L_KRAW = L_QRAW + 8192;
constexpr int L_ARAW = L_KRAW + 8192;
constexpr int L_VRAW = L_ARAW + 2048;
static_assert(L_VRAW + 64 * VP * 2 <= 131072, "GLA LDS map");

__device__ __forceinline__ float logsig2(float d) {
    const float e = __builtin_amdgcn_exp2f(d * -1.44269504089f);
    return __builtin_amdgcn_logf(1.0f + e) * -0.0625f;
}
#define GLA_BAR() do { asm volatile("s_waitcnt lgkmcnt(0)" ::: "memory"); __builtin_amdgcn_s_barrier(); asm volatile("" ::: "memory"); } while (0)
#define CHUNK(si) (dir ? 63 - (si) : (si))
#define POS(r) (dir ? 63 - (r) : (r))

__device__ __forceinline__ bf16x8 gla_tr_frag(const bf16_t* tileT, int chA, int chB, int pos0, int lr) {
    typedef short s4v __attribute__((ext_vector_type(4)));
    const int off = (lr >> 2) * GP + pos0 + 4 * (lr & 3);
    const s4v lo = __builtin_amdgcn_ds_read_tr16_b64_v4i16((LAS s4v*)(tileT + chA * GP + off)), hi = __builtin_amdgcn_ds_read_tr16_b64_v4i16((LAS s4v*)(tileT + chB * GP + off));
    return (bf16x8){lo[0], lo[1], lo[2], lo[3], hi[0], hi[1], hi[2], hi[3]};
}
struct GlaRegs { u32x4 q0, q1, k0, k1, a, v0, v1, v2, v3; };
struct GlaPrepCtx {
    const bf16_t* Z; const bf16_t* DEC; unsigned* myflag; unsigned* paflag;
    bf16_t* qin; bf16_t* kin; bf16_t* qout; bf16_t* koutT; float* decs; bf16_t* qraw; bf16_t* kraw; bf16_t* araw; bf16_t* vraw;
    int tid, wid, lr, q4, b, h, dir, lrow, lcs, vrow, vcs, arow, acs, ch; bf16x8 w2f; float bias;
};
#define ST8_(pp, v) do { *(u32x2*)(pp) = (u32x2){(v).x, (v).y}; *(u32x2*)((pp) + 4) = (u32x2){(v).z, (v).w}; } while (0)
__device__ __forceinline__ void gla_load_qka(const GlaPrepCtx& c, int si, GlaRegs& R) {
    const int dir = c.dir; const size_t t0 = (size_t)(c.b * SEQ + CHUNK(si) * 64); const bf16_t* zr = c.Z + (t0 + c.lrow) * ZW + c.h * 64 + c.lcs;
    R.q0 = *(const u32x4*)(zr + ZQ); R.k0 = *(const u32x4*)(zr + ZK); R.q1 = *(const u32x4*)(zr + (size_t)32 * ZW + ZQ); R.k1 = *(const u32x4*)(zr + (size_t)32 * ZW + ZK);
    if (c.tid < 128) R.a = *(const u32x4*)(c.DEC + (t0 + c.arow) * 32 + dir * 16 + c.acs);
}
__device__ __forceinline__ void gla_load_v(const GlaPrepCtx& c, int si, GlaRegs& R) {
    const int dir = c.dir; const size_t t0 = (size_t)(c.b * SEQ + CHUNK(si) * 64); const bf16_t* vr = c.Z + (t0 + c.vrow) * ZW + ZV + c.h * 128 + c.vcs;
    R.v0 = *(const u32x4*)vr; R.v1 = *(const u32x4*)(vr + (size_t)16 * ZW); R.v2 = *(const u32x4*)(vr + (size_t)32 * ZW); R.v3 = *(const u32x4*)(vr + (size_t)48 * ZW);
}
__device__ __forceinline__ void gla_store_qka(const GlaPrepCtx& c, const GlaRegs& R) {
    const int dir = c.dir; const int r0_ = POS(c.lrow), r1_ = POS(c.lrow + 32);
    *(u32x4*)(c.qraw + r0_ * 64 + ROT(r0_, c.lcs)) = R.q0; *(u32x4*)(c.kraw + r0_ * 64 + ROT(r0_, c.lcs)) = R.k0; *(u32x4*)(c.qraw + r1_ * 64 + ROT(r1_, c.lcs)) = R.q1; *(u32x4*)(c.kraw + r1_ * 64 + ROT(r1_, c.lcs)) = R.k1;
    if (c.tid < 128) *(u32x4*)(c.araw + POS(c.arow) * 16 + c.acs) = R.a;
}
__device__ __forceinline__ void gla_store_v(const GlaPrepCtx& c, const GlaRegs& R) {
    const int dir = c.dir;
    ST8_(c.vraw + POS(c.vrow) * VP + c.vcs, R.v0); ST8_(c.vraw + POS(c.vrow + 16) * VP + c.vcs, R.v1); ST8_(c.vraw + POS(c.vrow + 32) * VP + c.vcs, R.v2); ST8_(c.vraw + POS(c.vrow + 48) * VP + c.vcs, R.v3);
}
__device__ __forceinline__ void gla_prep_step(const GlaPrepCtx& c, int s, GlaRegs& LD, GlaRegs& ST) {
    const int wid = c.wid, lr = c.lr, q4 = c.q4, ch = c.ch, tid = c.tid;
    if (s == 32) {
        if (wid == 0) { while (__hip_atomic_load(c.paflag, __ATOMIC_RELAXED, __HIP_MEMORY_SCOPE_AGENT) == 0u) __builtin_amdgcn_s_sleep(4);
            __builtin_amdgcn_fence(__ATOMIC_ACQUIRE, "agent"); asm volatile("s_waitcnt vmcnt(0)" ::: "memory"); }
        __syncthreads();
    }
    if (s + 3 < 64) gla_load_qka(c, s + 3, LD);
    if (s + 2 < 64) gla_load_v(c, s + 2, LD);
    unsigned rq[8], rk[8], ro[8], rko[8]; float rdec = 0.f;
    if (s < 63) {
        float la[16];
#pragma unroll
        for (int cb = 0; cb < 4; ++cb) { const int pr = 16 * (lr >> 2) + 4 * cb + (lr & 3);
            u32x4 aw = (u32x4){0u, 0u, 0u, 0u}; if (q4 < 2) aw = *(const u32x4*)(c.araw + pr * 16 + 8 * q4);
            f32x4 d = (f32x4){c.bias, c.bias, c.bias, c.bias};
            d = __builtin_amdgcn_mfma_f32_16x16x32_bf16(__builtin_bit_cast(bf16x8, aw), c.w2f, d, 0, 0, 0);
#pragma unroll
            for (int jj = 0; jj < 4; ++jj) la[4 * cb + jj] = logsig2(d[jj]); }
#pragma unroll
        for (int i = 1; i < 16; ++i) la[i] += la[i - 1];
        const float tq = la[15]; float inc = tq;
        { const float t1 = __shfl_up(inc, 16); if (q4 >= 1) inc += t1; const float t2 = __shfl_up(inc, 32); if (q4 >= 2) inc += t2; }
        const float off = inc - tq;
        const float tot = __shfl(inc, lr + 48);
        const float bmid = __shfl(off + la[0], lr + 32);
        const float emid = __builtin_amdgcn_exp2f(bmid), etm = __builtin_amdgcn_exp2f(tot - bmid);
        rdec = __builtin_amdgcn_exp2f(tot);
        typedef short s4v __attribute__((ext_vector_type(4)));
        s4v qt[4], kt[4];
        { const int trow = 16 * q4 + (lr >> 2), tcol = ((16 * wid + 16 * q4) & 63) + 4 * (lr & 3);
#pragma unroll
          for (int t = 0; t < 4; ++t) { qt[t] = __builtin_amdgcn_ds_read_tr16_b64_v4i16((LAS s4v*)(c.qraw + (trow + 4 * t) * 64 + tcol)); kt[t] = __builtin_amdgcn_ds_read_tr16_b64_v4i16((LAS s4v*)(c.kraw + (trow + 4 * t) * 64 + tcol)); } }
#pragma unroll
        for (int i = 0; i < 16; i += 2) {
            const float x0 = off + la[i] - bmid, x1 = off + la[i + 1] - bmid;
            const float e10 = __builtin_amdgcn_exp2f(x0), e20 = __builtin_amdgcn_exp2f(-x0), e11 = __builtin_amdgcn_exp2f(x1), e21 = __builtin_amdgcn_exp2f(-x1);
            const float q0 = bf2f((unsigned short)qt[i >> 2][i & 3]) * e10, q1 = bf2f((unsigned short)qt[i >> 2][(i & 3) + 1]) * e11;
            const float k0 = bf2f((unsigned short)kt[i >> 2][i & 3]) * e20, k1 = bf2f((unsigned short)kt[i >> 2][(i & 3) + 1]) * e21;
            rq[i >> 1] = cvt_pk_bf16(q0, q1); rk[i >> 1] = cvt_pk_bf16(k0, k1); ro[i >> 1] = cvt_pk_bf16(q0 * emid, q1 * emid); rko[i >> 1] = cvt_pk_bf16(k0 * etm, k1 * etm);
        }
    }
    GLA_BAR();
    if (s < 63) {
        *(u32x4*)(c.qin + ch * GP + 16 * q4) = (u32x4){rq[0], rq[1], rq[2], rq[3]}; *(u32x4*)(c.qin + ch * GP + 16 * q4 + 8) = (u32x4){rq[4], rq[5], rq[6], rq[7]};
        *(u32x4*)(c.kin + ch * GP + 16 * q4) = (u32x4){rk[0], rk[1], rk[2], rk[3]}; *(u32x4*)(c.kin + ch * GP + 16 * q4 + 8) = (u32x4){rk[4], rk[5], rk[6], rk[7]};
        *(u32x4*)(c.qout + ch * GP + 16 * q4) = (u32x4){ro[0], ro[1], ro[2], ro[3]}; *(u32x4*)(c.qout + ch * GP + 16 * q4 + 8) = (u32x4){ro[4], ro[5], ro[6], ro[7]};
        *(u32x4*)(c.koutT + ch * GP + 16 * q4) = (u32x4){rko[0], rko[1], rko[2], rko[3]}; *(u32x4*)(c.koutT + ch * GP + 16 * q4 + 8) = (u32x4){rko[4], rko[5], rko[6], rko[7]};
        if (q4 == 0) c.decs[ch] = rdec;
    }
    if (s + 2 < 64) gla_store_qka(c, ST);
    if (s + 1 < 64) gla_store_v(c, ST);
    if (s == 31) {
        asm volatile("s_waitcnt vmcnt(0)" ::: "memory"); __syncthreads();
        if (tid == 0) { __builtin_amdgcn_fence(__ATOMIC_RELEASE, "agent"); asm volatile("s_waitcnt vmcnt(0)" ::: "memory"); __hip_atomic_store(c.myflag, 1u, __ATOMIC_RELAXED, __HIP_MEMORY_SCOPE_AGENT); }
    }
    GLA_BAR();
}

__device__ __forceinline__ void gla_prep(const Params& p, unsigned char* lds, int l, int item, int tid) {
    unsigned char* ws = p.ws;
    GlaPrepCtx c;
    c.tid = tid; c.wid = __builtin_amdgcn_readfirstlane(tid >> 6); const int lane = tid & 63; c.lr = lane & 15; c.q4 = lane >> 4;
    c.b = item >> 3; c.h = (item >> 1) & 3; c.dir = item & 1; const int dir = c.dir;
    c.Z = (const bf16_t*)(ws + WS_Z); c.DEC = (const bf16_t*)(ws + WS_DEC);
    unsigned* flags = (unsigned*)(ws + WS_CTL);
    c.myflag = flags + (size_t)(l * 128 + item) * 64; c.paflag = flags + (size_t)(l * 128 + (item ^ 1)) * 64;
    c.qin = (bf16_t*)(lds + L_QIN); c.kin = (bf16_t*)(lds + L_KIN); c.qout = (bf16_t*)(lds + L_QOUT); c.koutT = (bf16_t*)(lds + L_KOUTT);
    c.decs = (float*)(lds + L_DEC);
    c.qraw = (bf16_t*)(lds + L_QRAW); c.kraw = (bf16_t*)(lds + L_KRAW); c.araw = (bf16_t*)(lds + L_ARAW); c.vraw = (bf16_t*)(lds + L_VRAW);
    c.lrow = tid >> 3; c.lcs = (tid & 7) * 8; c.vrow = tid >> 4; c.vcs = (tid & 15) * 8; c.arow = tid >> 1; c.acs = (tid & 1) * 8;
    c.ch = 16 * c.wid + c.lr;
    { const float* w2 = (dir ? p.w_a2_bwd : p.w_a2_fwd) + (size_t)l * 16 * 256 + c.h * 64 + c.ch; u32x4 w = (u32x4){0u, 0u, 0u, 0u};
      if (c.q4 < 2) { float t[8];
#pragma unroll
          for (int i = 0; i < 8; ++i) t[i] = w2[(8 * c.q4 + i) * 256];
          w.x = cvt_pk_bf16(t[0], t[1]); w.y = cvt_pk_bf16(t[2], t[3]); w.z = cvt_pk_bf16(t[4], t[5]); w.w = cvt_pk_bf16(t[6], t[7]); }
      c.w2f = __builtin_bit_cast(bf16x8, w); c.bias = (dir ? p.b_a_bwd : p.b_a_fwd)[l * 256 + c.h * 64 + c.ch]; }
    GlaRegs RA, RB;
    gla_load_qka(c, 0, RA); gla_store_qka(c, RA);
    gla_load_qka(c, 1, RB); gla_load_v(c, 0, RB);
    GLA_BAR();
    for (int s = -1; s < 63; s += 2) { gla_prep_step(c, s, RA, RB); gla_prep_step(c, s + 1, RB, RA); }
    gla_prep_step(c, 63, RA, RB);
}
#undef ST8_

__device__ __forceinline__ void gla_mma(const Params& p, unsigned char* lds, int l, int item, int tid) {
    unsigned char* ws = p.ws;
    const int wid = __builtin_amdgcn_readfirstlane(tid >> 6), lane = tid & 63, lr = lane & 15, q4 = lane >> 4;
    const int b = item >> 3, h = (item >> 1) & 3, dir = item & 1;
    const bf16_t* Z = (const bf16_t*)(ws + WS_Z); bf16_t* OX = (bf16_t*)(ws + WS_OX); bf16_t* MIX = (bf16_t*)(ws + WS_MIX);
    const bf16_t* qin = (const bf16_t*)(lds + L_QIN); const bf16_t* kin = (const bf16_t*)(lds + L_KIN); const bf16_t* qout = (const bf16_t*)(lds + L_QOUT); const bf16_t* koutT = (const bf16_t*)(lds + L_KOUTT);
    const float* decs = (const float*)(lds + L_DEC); float* red = (float*)(lds + L_RED); const bf16_t* vraw = (const bf16_t*)(lds + L_VRAW);
    const int vq = wid & 3;
    const int ocol = h * 128 + 32 * vq + 8 * q4;
    f32x4 ng[2];
#pragma unroll
    for (int vb = 0; vb < 2; ++vb) ng[vb] = *(const f32x4*)(p.gla_norm_g + (size_t)l * 512 + ocol + 4 * vb);
    f32x4 accS[2][4];
#pragma unroll
    for (int vb = 0; vb < 2; ++vb)
#pragma unroll
        for (int i = 0; i < 4; ++i) accS[vb][i] = (f32x4){0.f, 0.f, 0.f, 0.f};
    GLA_BAR();
    for (int s = -1; s < 64; ++s) {
        const int tok0 = b * SEQ + CHUNK(s < 0 ? 0 : s) * 64;
#define TOK(c) (tok0 + (dir ? 63 - (c) : (c)))
        if (s == 32) __syncthreads();
        f32x4 accO[2][4]; u32x4 gw[4];
        if (s >= 0) {
            u32x4 ox[4];
            bf16x8 vfrag[2][2];
#pragma unroll
            for (int vb = 0; vb < 2; ++vb)
#pragma unroll
                for (int pp = 0; pp < 2; ++pp) {
                    typedef short s4v __attribute__((ext_vector_type(4)));
                    const bf16_t* vp = vraw + (32 * pp + 4 * q4 + (lr >> 2)) * VP + 32 * vq + 8 * (lr & 3) + 4 * vb;
                    const s4v lo = __builtin_amdgcn_ds_read_tr16_b64_v4i16((LAS s4v*)vp), hi = __builtin_amdgcn_ds_read_tr16_b64_v4i16((LAS s4v*)(vp + 16 * VP));
                    vfrag[vb][pp] = (bf16x8){lo[0], lo[1], lo[2], lo[3], hi[0], hi[1], hi[2], hi[3]}; }
            bf16x8 qf[4][2], kf[4][2];
#pragma unroll
            for (int cb = 0; cb < 4; ++cb) { qf[cb][0] = gla_tr_frag(qin, 8 * q4, 8 * q4 + 4, 16 * cb, lr); qf[cb][1] = gla_tr_frag(qin, 32 + 8 * q4, 36 + 8 * q4, 16 * cb, lr);
                kf[cb][0] = gla_tr_frag(kin, 8 * q4, 8 * q4 + 4, 16 * cb, lr); kf[cb][1] = gla_tr_frag(kin, 32 + 8 * q4, 36 + 8 * q4, 16 * cb, lr); }
            bf16x8 P0[4], P1[2];
            {
                f32x4 sc[4][4];
#pragma unroll
                for (int cb = 0; cb < 4; ++cb)
#pragma unroll
                    for (int jb = 0; jb < 4; ++jb) {
                        if (jb > cb) { sc[jb][cb] = (f32x4){0.f, 0.f, 0.f, 0.f}; continue; }
                        f32x4 a = (f32x4){0.f, 0.f, 0.f, 0.f};
                        a = __builtin_amdgcn_mfma_f32_16x16x32_bf16(kf[jb][0], qf[cb][0], a, 0, 0, 0);
                        sc[jb][cb] = a;
                    }
#pragma unroll
                for (int cb = 0; cb < 4; ++cb)
#pragma unroll
                    for (int jb = 0; jb <= cb; ++jb) sc[jb][cb] = __builtin_amdgcn_mfma_f32_16x16x32_bf16(kf[jb][1], qf[cb][1], sc[jb][cb], 0, 0, 0);
            __builtin_amdgcn_sched_barrier(0);
            if (s >= 32) {
#pragma unroll
                for (int cb = 0; cb < 4; ++cb) { const size_t tk = (size_t)TOK(16 * cb + lr); ox[cb] = *(const u32x4*)(OX + tk * 512 + ocol); gw[cb] = *(const u32x4*)(Z + tk * ZW + ZG + ocol); }
            }
#pragma unroll
                for (int cb = 0; cb < 4; ++cb) {
#pragma unroll
                    for (int jj = 0; jj < 4; ++jj) { const int j = 4 * q4 + jj; const bool keep = dir ? (lr > j) : (lr >= j); sc[cb][cb][jj] = keep ? sc[cb][cb][jj] : 0.f; }
                    { u32x4 w; w.x = cvt_pk_bf16(sc[0][cb][0], sc[0][cb][1]); w.y = cvt_pk_bf16(sc[0][cb][2], sc[0][cb][3]); w.z = cvt_pk_bf16(sc[1][cb][0], sc[1][cb][1]); w.w = cvt_pk_bf16(sc[1][cb][2], sc[1][cb][3]); P0[cb] = __builtin_bit_cast(bf16x8, w); }
                    if (cb >= 2) { u32x4 w; w.x = cvt_pk_bf16(sc[2][cb][0], sc[2][cb][1]); w.y = cvt_pk_bf16(sc[2][cb][2], sc[2][cb][3]); w.z = cvt_pk_bf16(sc[3][cb][0], sc[3][cb][1]); w.w = cvt_pk_bf16(sc[3][cb][2], sc[3][cb][3]); P1[cb - 2] = __builtin_bit_cast(bf16x8, w); }
                }
            }
            bf16x8 qo[4][2];
#pragma unroll
            for (int cb = 0; cb < 4; ++cb)
#pragma unroll
                for (int pp = 0; pp < 2; ++pp) qo[cb][pp] = gla_tr_frag(qout, 32 * pp + 4 * q4, 32 * pp + 16 + 4 * q4, 16 * cb, lr);
            bf16x8 Sp[2][2];
#pragma unroll
            for (int vb = 0; vb < 2; ++vb)
#pragma unroll
                for (int pp = 0; pp < 2; ++pp) { u32x4 w; w.x = cvt_pk_bf16(accS[vb][2 * pp][0], accS[vb][2 * pp][1]); w.y = cvt_pk_bf16(accS[vb][2 * pp][2], accS[vb][2 * pp][3]);
                    w.z = cvt_pk_bf16(accS[vb][2 * pp + 1][0], accS[vb][2 * pp + 1][1]); w.w = cvt_pk_bf16(accS[vb][2 * pp + 1][2], accS[vb][2 * pp + 1][3]); Sp[vb][pp] = __builtin_bit_cast(bf16x8, w); }
#pragma unroll
            for (int cb = 0; cb < 4; ++cb)
#pragma unroll
                for (int vb = 0; vb < 2; ++vb) {
                    f32x4 a = (f32x4){0.f, 0.f, 0.f, 0.f};
                    a = __builtin_amdgcn_mfma_f32_16x16x32_bf16(Sp[vb][0], qo[cb][0], a, 0, 0, 0);
                    accO[vb][cb] = a; }
#pragma unroll
            for (int cb = 0; cb < 4; ++cb)
#pragma unroll
                for (int vb = 0; vb < 2; ++vb) accO[vb][cb] = __builtin_amdgcn_mfma_f32_16x16x32_bf16(Sp[vb][1], qo[cb][1], accO[vb][cb], 0, 0, 0);
#pragma unroll
            for (int cb = 0; cb < 4; ++cb)
#pragma unroll
                for (int vb = 0; vb < 2; ++vb) accO[vb][cb] = __builtin_amdgcn_mfma_f32_16x16x32_bf16(vfrag[vb][0], P0[cb], accO[vb][cb], 0, 0, 0);
#pragma unroll
            for (int cb = 2; cb < 4; ++cb)
#pragma unroll
                for (int vb = 0; vb < 2; ++vb) accO[vb][cb] = __builtin_amdgcn_mfma_f32_16x16x32_bf16(vfrag[vb][1], P1[cb - 2], accO[vb][cb], 0, 0, 0);
            __builtin_amdgcn_sched_barrier(0);
            bf16x8 ko[4][2]; f32x4 dv[4];
#pragma unroll
            for (int kb = 0; kb < 4; ++kb) { dv[kb] = *(const f32x4*)(decs + 16 * kb + 4 * q4);
#pragma unroll
                for (int pp = 0; pp < 2; ++pp) { const bf16_t* kp = koutT + (16 * kb + lr) * GP + 32 * pp + 4 * q4; const u32x2 lo = *(const u32x2*)kp, hi = *(const u32x2*)(kp + 16); ko[kb][pp] = __builtin_bit_cast(bf16x8, ((u32x4){lo.x, lo.y, hi.x, hi.y})); } }
#pragma unroll
            for (int kb = 0; kb < 4; ++kb)
#pragma unroll
                for (int vb = 0; vb < 2; ++vb) accS[vb][kb] = __builtin_amdgcn_mfma_f32_16x16x32_bf16(ko[kb][0], vfrag[vb][0], accS[vb][kb] * dv[kb], 0, 0, 0);
#pragma unroll
            for (int kb = 0; kb < 4; ++kb)
#pragma unroll
                for (int vb = 0; vb < 2; ++vb) accS[vb][kb] = __builtin_amdgcn_mfma_f32_16x16x32_bf16(ko[kb][1], vfrag[vb][1], accS[vb][kb], 0, 0, 0);
            if (s < 32) {
#pragma unroll
                for (int cb = 0; cb < 4; ++cb) { const f32x4 o0 = accO[0][cb], o1 = accO[1][cb]; *(u32x4*)(OX + (size_t)TOK(16 * cb + lr) * 512 + ocol) = (u32x4){cvt_pk_bf16(o0[0], o0[1]), cvt_pk_bf16(o0[2], o0[3]), cvt_pk_bf16(o1[0], o1[1]), cvt_pk_bf16(o1[2], o1[3])}; }
            } else {
#pragma unroll
                for (int cb = 0; cb < 4; ++cb) { float ss = 0.f;
#pragma unroll
                    for (int vb = 0; vb < 2; ++vb) { const unsigned xa = vb ? ox[cb].z : ox[cb].x, xb2 = vb ? ox[cb].w : ox[cb].y; accO[vb][cb] += (f32x4){bflo(xa), bfhi(xa), bflo(xb2), bfhi(xb2)}; const f32x4 o = accO[vb][cb]; ss += (o[0] * o[0] + o[1] * o[1]) + (o[2] * o[2] + o[3] * o[3]); }
                    ss += __shfl_xor(ss, 16); ss += __shfl_xor(ss, 32);
                    if (q4 == 0) red[vq * 64 + 16 * cb + lr] = ss; }
            }
        }
        GLA_BAR();
        if (s >= 32) {
#pragma unroll
            for (int cb = 0; cb < 4; ++cb) { const float ss = (red[16 * cb + lr] + red[64 + 16 * cb + lr]) + (red[128 + 16 * cb + lr] + red[192 + 16 * cb + lr]);
                const float rs = rsqrtf(ss * (1.0f / 128.0f) + EPS); const size_t tk = (size_t)TOK(16 * cb + lr);
                const f32x4 o0 = accO[0][cb] * rs * ng[0], o1 = accO[1][cb] * rs * ng[1]; const u32x4 g4 = gw[cb];
                u32x4 w; w.x = cvt_pk_bf16(o0[0] * bflo(g4.x), o0[1] * bfhi(g4.x)); w.y = cvt_pk_bf16(o0[2] * bflo(g4.y), o0[3] * bfhi(g4.y)); w.z = cvt_pk_bf16(o1[0] * bflo(g4.z), o1[1] * bfhi(g4.z)); w.w = cvt_pk_bf16(o1[2] * bflo(g4.w), o1[3] * bfhi(g4.w));
                *(u32x4*)(MIX + tk * D + ocol) = w; }
        }
        if (s == 31) { asm volatile("s_waitcnt vmcnt(0)" ::: "memory"); __syncthreads(); }
        GLA_BAR();
#undef TOK
    }
}
#undef CHUNK
#undef POS

PHASE_FN void gla_item(const Params& p, unsigned char* lds, int l, int item) {
    int tid = threadIdx.x; asm volatile("" : "+v"(tid));
    if (tid < 256) gla_prep(p, lds, l, item, tid); else gla_mma(p, lds, l, item, tid);
    __syncthreads();
}

constexpr int SP = 136;
constexpr int L_SW = 0;
constexpr int L_SV0 = 128 * SP * 2;
constexpr int L_SV1 = 2 * 128 * SP * 2;
PHASE_FN void sgu_block(const Params& p, unsigned char* lds, int l, int g, int ch0, int nch) {
    unsigned char* ws = p.ws;
    int tid = threadIdx.x; asm volatile("" : "+v"(tid));
    const int wid = __builtin_amdgcn_readfirstlane(tid >> 6), lane = tid & 63, lr = lane & 15, q4 = lane >> 4;
    const bf16_t* __restrict__ Z = (const bf16_t*)(ws + WS_Z); bf16_t* __restrict__ MIX = (bf16_t*)(ws + WS_MIX);
    const bf16_t* __restrict__ wsb = (const bf16_t*)(ws + WS_WSB) + (size_t)(l * 4 + g) * 128 * 128;
    bf16_t* wl = (bf16_t*)(lds + L_SW);
    const int lrow = tid >> 4, cs = (tid & 15) * 8;
#pragma unroll
    for (int i = 0; i < 4; ++i) *(u32x4*)(wl + (lrow + 32 * i) * SP + cs) = *(const u32x4*)(wsb + (size_t)(lrow + 32 * i) * 128 + cs);
    const float* ngp = p.sgu_norm_g + (size_t)l * 512 + g * 128 + cs; const f32x4 g0 = *(const f32x4*)ngp, g1 = *(const f32x4*)(ngp + 4);
    float bs[8];
#pragma unroll
    for (int pb = 0; pb < 8; ++pb) bs[pb] = p.b_s[(size_t)l * 512 + g * 128 + 16 * pb + lr];
    const int ocol = g * 128 + 16 * wid + 4 * q4;
    u32x4 pv[4];
#define SGU_LOAD(ch) do { _Pragma("unroll") for (int i = 0; i < 4; ++i) pv[i] = *(const u32x4*)(Z + (size_t)((ch) * 128 + lrow + 32 * i) * ZW + ZSV + g * 128 + cs); } while (0)
    SGU_LOAD(ch0);
    int buf = 0;
    for (int ch = ch0; ch < ch0 + nch; ++ch, buf ^= 1) {
        const int tok0 = ch * 128;
        bf16_t* vt = (bf16_t*)(lds + (buf ? L_SV1 : L_SV0));
#pragma unroll
        for (int i = 0; i < 4; ++i) { const u32x4 w = pv[i];
            float v[8];
            { const f32x2 a = gelu_pk((f32x2){bflo(w.x), bfhi(w.x)}), b2 = gelu_pk((f32x2){bflo(w.y), bfhi(w.y)}), c = gelu_pk((f32x2){bflo(w.z), bfhi(w.z)}), d = gelu_pk((f32x2){bflo(w.w), bfhi(w.w)});
              v[0] = a.x; v[1] = a.y; v[2] = b2.x; v[3] = b2.y; v[4] = c.x; v[5] = c.y; v[6] = d.x; v[7] = d.y; }
            float ss = 0.f;
#pragma unroll
            for (int k = 0; k < 8; ++k) ss += v[k] * v[k];
            ss += __shfl_xor(ss, 1); ss += __shfl_xor(ss, 2); ss += __shfl_xor(ss, 4); ss += __shfl_xor(ss, 8);
            const float rs = rsqrtf(ss * (1.0f / 128.0f) + EPS);
            u32x4 o; o.x = cvt_pk_bf16(v[0] * rs * g0[0], v[1] * rs * g0[1]); o.y = cvt_pk_bf16(v[2] * rs * g0[2], v[3] * rs * g0[3]);
            o.z = cvt_pk_bf16(v[4] * rs * g1[0], v[5] * rs * g1[1]); o.w = cvt_pk_bf16(v[6] * rs * g1[2], v[7] * rs * g1[3]);
            *(u32x4*)(vt + (lrow + 32 * i) * SP + cs) = o; }
        if (ch + 1 < ch0 + nch) SGU_LOAD(ch + 1);
        u32x2 uw[8];
#pragma unroll
        for (int pb = 0; pb < 8; ++pb) uw[pb] = *(const u32x2*)(Z + (size_t)(tok0 + 16 * pb + lr) * ZW + ZSU + ocol);
        asm volatile("s_waitcnt lgkmcnt(0)" ::: "memory"); __builtin_amdgcn_s_barrier(); asm volatile("" ::: "memory");
        bf16x8 af[4];
#pragma unroll
        for (int ks = 0; ks < 4; ++ks)
#pragma unroll
            for (int i = 0; i < 8; ++i) af[ks][i] = (short)vt[(32 * ks + 8 * q4 + i) * SP + 16 * wid + lr];
#pragma unroll
        for (int pb = 0; pb < 8; ++pb) {
            f32x4 a = (f32x4){0.f, 0.f, 0.f, 0.f};
#pragma unroll
            for (int ks = 0; ks < 4; ++ks) { const bf16x8 bf = *(const bf16x8*)(wl + (16 * pb + lr) * SP + 32 * ks + 8 * q4); a = __builtin_amdgcn_mfma_f32_16x16x32_bf16(af[ks], bf, a, 0, 0, 0); }
            const f32x2 u0 = gelu_pk((f32x2){bflo(uw[pb].x), bfhi(uw[pb].x)}), u1 = gelu_pk((f32x2){bflo(uw[pb].y), bfhi(uw[pb].y)});
            u32x2 w; w.x = cvt_pk_bf16((a[0] + bs[pb]) * u0.x, (a[1] + bs[pb]) * u0.y); w.y = cvt_pk_bf16((a[2] + bs[pb]) * u1.x, (a[3] + bs[pb]) * u1.y);
            *(u32x2*)(MIX + (size_t)(tok0 + 16 * pb + lr) * D + 512 + ocol) = w;
        }
    }
#undef SGU_LOAD
    __syncthreads();
}

#define XB_TMO      128
#define XB_XCNT(j)  (256  + 64 * (j))
#define XB_XSUB(j)  (1280 + 64 * (j))
#define XB_XGEN(j)  (2304 + 64 * (j))
#define XB_TOP      3328
#define XB_TOPGEN   3392
#define XCD_BAR_WORDS 3456
#define XB_SPIN_CAP (1u << 18)

__device__ __forceinline__ unsigned xb_ld(unsigned* p)              { return __hip_atomic_load(p, __ATOMIC_RELAXED, __HIP_MEMORY_SCOPE_AGENT); }
__device__ __forceinline__ unsigned xb_add(unsigned* p, unsigned v) { return __hip_atomic_fetch_add(p, v, __ATOMIC_RELAXED, __HIP_MEMORY_SCOPE_AGENT); }
__device__ __forceinline__ unsigned xb_xcc_id() { return (unsigned)__builtin_amdgcn_s_getreg((3 << 11) | 20) & 0xFu; }
#define XB_SPIN(cond, bar) do { unsigned _sp = 0; while (cond) { __builtin_amdgcn_s_sleep(1); \
    if ((++_sp & 255u) == 0u) { if (xb_ld(&(bar)[XB_TMO])) break; if (_sp > XB_SPIN_CAP) { atomicAdd(&(bar)[XB_TMO], 1u); break; } } } } while (0)

struct XcdBarrier {
    unsigned* bar; unsigned x;
    volatile LAS unsigned* st;
};

__device__ __forceinline__ XcdBarrier xcd_barrier_post(unsigned* bar, volatile LAS unsigned* st) {
    XcdBarrier b; b.bar = bar; b.x = xb_xcc_id(); b.st = st;
    if (threadIdx.x == 0) (void)xb_add(&bar[XB_XCNT(b.x)], 1u);
    return b;
}
__device__ __forceinline__ void xcd_barrier_complete(unsigned* bar, unsigned x, unsigned& nloc, unsigned& nx) {
    const unsigned G = gridDim.x * gridDim.y * gridDim.z;
    unsigned sum, cnt, mine, sp = 0u;
    for (;;) {
        sum = 0u; cnt = 0u; mine = 0u;
#pragma unroll
        for (unsigned j = 0; j < 16; ++j) { const unsigned c = xb_ld(&bar[XB_XCNT(j)]); sum += c; cnt += (c > 0u) ? 1u : 0u; mine = (j == x) ? c : mine; }
        if (sum == G) break;
        __builtin_amdgcn_s_sleep(1);
        if ((++sp & 255u) == 0u) { if (xb_ld(&bar[XB_TMO])) break; if (sp > XB_SPIN_CAP) { atomicAdd(&bar[XB_TMO], 1u); break; } }
    }
    nloc = mine > 0u ? mine : 1u; nx = cnt > 0u ? cnt : 1u;
}

__device__ __forceinline__ void xcd_barrier(const XcdBarrier& b) {
    asm volatile("s_waitcnt vmcnt(0)" ::: "memory");
    __syncthreads();
    if (threadIdx.x == 0) {
        unsigned* bar = b.bar;
        __builtin_amdgcn_s_waitcnt(0);
        unsigned nloc = b.st[0], nx = b.st[1];
        if (nloc == 0u) { xcd_barrier_complete(bar, b.x, nloc, nx); b.st[0] = nloc; b.st[1] = nx; }
        const unsigned old = xb_add(&bar[XB_XSUB(b.x)], 1u);
        const unsigned gen = old / nloc;
        if (old + 1u == (gen + 1u) * nloc) {
            __builtin_amdgcn_fence(__ATOMIC_RELEASE, "agent");
            asm volatile("s_waitcnt vmcnt(0)" ::: "memory");
            const unsigned og = xb_add(&bar[XB_TOP], 1u);
            const unsigned tg = og / nx;
            if (og + 1u == (tg + 1u) * nx) xb_add(&bar[XB_TOPGEN], 1u);
            else XB_SPIN(xb_ld(&bar[XB_TOPGEN]) == tg, bar);
            __builtin_amdgcn_fence(__ATOMIC_ACQUIRE, "agent");
            xb_add(&bar[XB_XGEN(b.x)], 1u);
            asm volatile("s_waitcnt vmcnt(0)" ::: "memory");
        } else {
            XB_SPIN(xb_ld(&bar[XB_XGEN(b.x)]) == gen, bar);
            __builtin_amdgcn_fence(__ATOMIC_ACQUIRE, "agent");
            asm volatile("s_waitcnt vmcnt(0)" ::: "memory");
        }
    }
    __syncthreads();
}

template <class Epi>
PHASE_FN void gemm_call(LAS unsigned char* ldsl, const bf16_t* A, const bf16_t* Bt, int N, int K, Epi E, int smode = 0, int sbase = 0) {
    pg8::Gemm g{A, Bt, T, N, K}; pg8::StaticOrder S; S.init(T, N, (int)gridDim.x, (int)blockIdx.x); S.mode = smode; S.base = sbase;
    pg8::gemm_phase<Epi, pg8::StaticOrder, true, true>(ldsl, g, S, E);
}
__global__ void __launch_bounds__(512, 2) fwd_megakernel(Params p) {
    extern __shared__ __attribute__((aligned(16))) unsigned char lds[];
    cg::grid_group grid = cg::this_grid();
    unsigned char* ws = p.ws;
    const int G = gridDim.x, bx = blockIdx.x;
    bf16_t* XB = (bf16_t*)(ws + WS_XB); float* SSQ = (float*)(ws + WS_SSQ); bf16_t* Zb = (bf16_t*)(ws + WS_Z); bf16_t* DECb = (bf16_t*)(ws + WS_DEC);
    bf16_t* MIXb = (bf16_t*)(ws + WS_MIX); bf16_t* HID = (bf16_t*)(ws + WS_HID);
    LAS unsigned char* ldsl = (LAS unsigned char*)lds;
    volatile LAS unsigned* xst = (volatile LAS unsigned*)(ldsl + 131072 + 320);
    if (threadIdx.x < 4) xst[threadIdx.x] = 0u;
    __syncthreads();
    const XcdBarrier xbar = xcd_barrier_post((unsigned*)(ws + WS_CTL + 512 * 1024), xst);

#ifndef NO_PREP
    phase_prep(p, (float*)lds);
#endif
    asm volatile("s_waitcnt vmcnt(0)" ::: "memory"); __syncthreads();
    __threadfence();
    grid.sync();
    for (int l = 0; l < DEPTH; ++l) {
        for (int part = 0; part < 2; ++part) {
            if (part == 1 && bx < 128) break;
            gemm_call<pg8::EpiZ>(ldsl, XB, (const bf16_t*)(ws + WS_WIN) + (size_t)l * ZW * D, part == 0 ? ZN_A : ZW, D, pg8::EpiZ{Zb, DECb, SSQ, (LAS float*)(ldsl + 131072 + 1024), -1}, part, 2 * (bx - 128));
            if (part == 0) xcd_barrier(xbar);
        }
        if (bx < 128) gla_item(p, lds, l, bx);
        else if (bx < 256) {
            __builtin_amdgcn_fence(__ATOMIC_ACQUIRE, "agent"); asm volatile("s_waitcnt vmcnt(0)" ::: "memory"); __syncthreads();
            for (int g = 0; g < 4; ++g) sgu_block(p, lds, l, g, 4 * (bx - 128), 4);
        }
        xcd_barrier(xbar);
#ifndef NO_G2
        gemm_call<pg8::EpiRes>(ldsl, MIXb, (const bf16_t*)(ws + WS_WOUT) + (size_t)l * D * D, D, D, pg8::EpiRes{p.x, p.out, XB, SSQ, l == 0 ? 1 : 0});
#endif
        xcd_barrier(xbar);
#ifndef NO_G3
        gemm_call<pg8::EpiH>(ldsl, XB, (const bf16_t*)(ws + WS_W1) + (size_t)l * FF * D, FF, D, pg8::EpiH{HID, SSQ, (LAS float*)(ldsl + 131072 + 1024), -1});
#endif
        xcd_barrier(xbar);
#ifndef NO_G4
        gemm_call<pg8::EpiRes>(ldsl, HID, (const bf16_t*)(ws + WS_W2) + (size_t)l * D * FF, D, FF, pg8::EpiRes{p.x, p.out, XB, SSQ, 0});
#endif
        xcd_barrier(xbar);
    }
    { const int tid = threadIdx.x;
      for (size_t i = ((size_t)bx * 512 + tid) * 8; i < (size_t)T * D; i += (size_t)G * 512 * 8) {
          const int r = (int)(i >> 10), c = (int)(i & 1023);
          const float* sp = SSQ + (size_t)r * 16; float s = 0.f;
#pragma unroll
          for (int j = 0; j < 4; ++j) { const f32x4 q = *(const f32x4*)(sp + 4 * j); s += (q[0] + q[1]) + (q[2] + q[3]); }
          const float rs = rsqrtf(s * (1.0f / 1024.0f) + EPS);
          const u32x4 w = *(const u32x4*)(XB + i); const f32x4 g0 = *(const f32x4*)(p.final_norm_g + c), g1 = *(const f32x4*)(p.final_norm_g + c + 4);
          *(f32x4*)(p.out + i) = (f32x4){bflo(w.x), bfhi(w.x), bflo(w.y), bfhi(w.y)} * rs * g0;
          *(f32x4*)(p.out + i + 4) = (f32x4){bflo(w.z), bfhi(w.z), bflo(w.w), bfhi(w.w)} * rs * g1; } }
}

extern "C" void kernel_launch(void* const* d_in, const int* in_sizes, int n_in, void* d_out, int out_size, void* d_ws, size_t ws_size, hipStream_t stream) {
    static int grid = 0;
    if (grid == 0) {
        if (n_in != 16 || out_size != T * D || ws_size < WS_END) { fprintf(stderr, "kernel_launch: unexpected shapes: n_in %d out %d ws %zu (need %zu)\n", n_in, out_size, ws_size, (size_t)WS_END); grid = -1; return; }
        int dev = 0, cus = 0, per_cu = 0;
        (void)hipGetDevice(&dev); (void)hipDeviceGetAttribute(&cus, hipDeviceAttributeMultiprocessorCount, dev);
        if (hipFuncSetAttribute((const void*)fwd_megakernel, hipFuncAttributeMaxDynamicSharedMemorySize, LDS_BYTES) != hipSuccess) { fprintf(stderr, "kernel_launch: hipFuncSetAttribute failed\n"); grid = -1; return; }
        (void)hipOccupancyMaxActiveBlocksPerMultiprocessor(&per_cu, (const void*)fwd_megakernel, 512, LDS_BYTES);
        (void)hipGetLastError();
        if (per_cu < 1) { fprintf(stderr, "kernel_launch: occupancy query says %d blocks per CU\n", per_cu); per_cu = 1; }
        grid = cus;
        if (grid < 256) { fprintf(stderr, "kernel_launch: %d CUs; this kernel's mixer phase needs a grid of at least 256\n", grid); }
    }
    if (grid < 0) return;
    (void)hipMemsetAsync((char*)d_ws + WS_CTL, 0, CTL_BYTES, stream);
    Params p{};
    p.x = (const float*)d_in[0]; p.norm_mix_g = (const float*)d_in[1]; p.w_in = (const float*)d_in[2]; p.w_a2_fwd = (const float*)d_in[3]; p.b_a_fwd = (const float*)d_in[4];
    p.w_a2_bwd = (const float*)d_in[5]; p.b_a_bwd = (const float*)d_in[6]; p.gla_norm_g = (const float*)d_in[7]; p.sgu_norm_g = (const float*)d_in[8]; p.w_s = (const float*)d_in[9];
    p.b_s = (const float*)d_in[10]; p.w_out = (const float*)d_in[11]; p.norm_mlp_g = (const float*)d_in[12]; p.w_mlp1 = (const float*)d_in[13]; p.w_mlp2 = (const float*)d_in[14];
    p.final_norm_g = (const float*)d_in[15]; p.out = (float*)d_out; p.ws = (unsigned char*)d_ws;
    void* args[] = {&p};
    hipError_t e = hipLaunchCooperativeKernel((const void*)fwd_megakernel, dim3(grid), dim3(512), args, LDS_BYTES, stream);
    if (e != hipSuccess) fprintf(stderr, "cooperative launch failed: %s (grid %d)\n", hipGetErrorString(e), grid);
}
```
